# Optimizing an MI355X kernel written in HIP

```python
import jax, jax.numpy as jnp
from jax import lax
import numpy as np

D_MODEL = 2048
BATCH = 2
SEQ = 16384
DEPTH = 2

GRID_W = 64
CTX_LEN = 256
N_MIXERS = 2
N_A = (DEPTH + 1) // 2
N_B = DEPTH // 2
N_MOD = 9
D_FF = 5632
EPS = 1e-6
CHUNK = 128
GM_INNER = D_MODEL
GM_GROUPS = 8
GM_GDIM = GM_INNER // GM_GROUPS
MLA_HEADS = D_MODEL // 128
Q_LORA = 448
KV_LORA = 160
QK_NOPE = 128
QK_ROPE = 64
V_DIM = 128
QK_DIM = QK_NOPE + QK_ROPE
MLA_SCALE = QK_DIM ** -0.5
ROPE_AXIS = QK_ROPE // 2
ROPE_THETA = 10000.0
Q_BLOCK = 128

kernel_name = "hybrid_chunkgmlp_mla_macaron_dit"


def rms_norm(x, g):
    xf = x.astype(jnp.float32)
    y = xf * lax.rsqrt(jnp.mean(xf * xf, axis=-1, keepdims=True) + EPS)
    return y.astype(x.dtype) * g


def layer_norm(x, g, b):
    xf = x.astype(jnp.float32)
    mu = jnp.mean(xf, axis=-1, keepdims=True)
    var = jnp.mean(jnp.square(xf - mu), axis=-1, keepdims=True)
    return ((xf - mu) * lax.rsqrt(var + EPS)).astype(x.dtype) * g + b


def adaln(cond, w, b):
    m = jax.nn.silu(cond) @ w + b
    return m.reshape(m.shape[0], 1, N_MOD, D_MODEL)


def pre_mod(x, m, k, g):
    return rms_norm(x, g) * (1.0 + m[:, :, 3 * k + 1]) + m[:, :, 3 * k]


def swiglu(h, w_gate, w_up, w_down):
    return (jax.nn.silu(h @ w_gate) * (h @ w_up)) @ w_down


def ffn_sublayer(x, m, k, g, w_gate, w_up, w_down):
    h = pre_mod(x, m, k, g)
    return x + 0.5 * m[:, :, 3 * k + 2] * swiglu(h, w_gate, w_up, w_down)


def chunk_gmlp(h, w_in, ln_g, ln_b, w_s, b_s, w_out):
    bsz, n, _ = h.shape
    z = jax.nn.gelu(h @ w_in)
    u, v = jnp.split(z, 2, axis=-1)
    v = layer_norm(v, ln_g, ln_b)
    v = v.reshape(bsz, n // CHUNK, CHUNK, GM_GROUPS, GM_GDIM)
    v = jnp.einsum('gpq,bcqgd->bcpgd', w_s, v) + b_s.T[None, None, :, :, None]
    return (u * v.reshape(bsz, n, GM_INNER)) @ w_out


def axial_rope_tables(n, dtype):
    n_rows = n // GRID_W
    row = jnp.broadcast_to(jnp.arange(n_rows)[:, None], (n_rows, GRID_W)).reshape(n).astype(jnp.float32)
    col = jnp.broadcast_to(jnp.arange(GRID_W)[None, :], (n_rows, GRID_W)).reshape(n).astype(jnp.float32)
    half = ROPE_AXIS // 2
    inv = ROPE_THETA ** (-jnp.arange(half, dtype=jnp.float32) / half)
    ang_r = row[:, None] * inv
    ang_c = col[:, None] * inv
    ang = jnp.concatenate([ang_r, ang_r, ang_c, ang_c], axis=-1)
    return jnp.cos(ang).astype(dtype), jnp.sin(ang).astype(dtype)


def rope_2d(x, cos, sin):
    xs = x.reshape(*x.shape[:-1], 2, 2, ROPE_AXIS // 2)
    rot = jnp.stack([-xs[..., 1, :], xs[..., 0, :]], axis=-2).reshape(x.shape)
    return x * cos[None, :, None, :] + rot * sin[None, :, None, :]


def mla_queries(h, w_dq, q_norm, w_uq, rope):
    bsz, n, _ = h.shape
    q = (rms_norm(h @ w_dq, q_norm) @ w_uq).reshape(bsz, n, MLA_HEADS, QK_DIM)
    q_nope, q_pe = q[..., :QK_NOPE], q[..., QK_NOPE:]
    if rope is not None:
        q_pe = rope_2d(q_pe, *rope)
    return jnp.concatenate([q_nope, q_pe], axis=-1)


def mla_keys_values(h, w_dkv, kv_norm, w_ukv, rope):
    bsz, n, _ = h.shape
    kv = h @ w_dkv
    c_kv = rms_norm(kv[..., :KV_LORA], kv_norm)
    k_pe = kv[..., None, KV_LORA:]
    if rope is not None:
        k_pe = rope_2d(k_pe, *rope)
    kv_up = (c_kv @ w_ukv).reshape(bsz, n, MLA_HEADS, QK_NOPE + V_DIM)
    k_nope, v = kv_up[..., :QK_NOPE], kv_up[..., QK_NOPE:]
    k = jnp.concatenate([k_nope, jnp.broadcast_to(k_pe, (bsz, n, MLA_HEADS, QK_ROPE))], axis=-1)
    return k, v


def softmax_attend(q, k, v):
    s = jnp.einsum('bqhd,bkhd->bhqk', q, k).astype(jnp.float32) * MLA_SCALE
    p = jax.nn.softmax(s, axis=-1).astype(v.dtype)
    return jnp.einsum('bhqk,bkhd->bqhd', p, v)


def mla(hx, hy, w_dq, q_norm, w_uq, w_dkv, kv_norm, w_ukv, w_o, rope, with_ctx_out):
    bsz, n, _ = hx.shape
    ky, vy = mla_keys_values(hy, w_dkv, kv_norm, w_ukv, None)
    kx, vx = mla_keys_values(hx, w_dkv, kv_norm, w_ukv, rope)
    qx = mla_queries(hx, w_dq, q_norm, w_uq, rope)
    k_all = jnp.concatenate([ky, kx], axis=1)
    v_all = jnp.concatenate([vy, vx], axis=1)
    qb = qx.reshape(bsz, n // Q_BLOCK, Q_BLOCK, MLA_HEADS, QK_DIM).swapaxes(0, 1)
    ox = lax.map(lambda q_blk: softmax_attend(q_blk, k_all, v_all), qb)
    ox = ox.swapaxes(0, 1).reshape(bsz, n, MLA_HEADS * V_DIM) @ w_o
    if not with_ctx_out:
        return ox, None
    qy = mla_queries(hy, w_dq, q_norm, w_uq, None)
    oy = softmax_attend(qy, ky, vy).reshape(bsz, hy.shape[1], MLA_HEADS * V_DIM) @ w_o
    return ox, oy


def setup_inputs(seed: int = 0) -> dict:
    key = jax.random.key(seed)
    ks = iter(jax.random.split(key, 32))
    D = D_MODEL

    def nrm(shape, fan_in, mult=1.0):
        return jax.random.normal(next(ks), shape, jnp.float32) * (mult * fan_in ** -0.5)

    def gain(shape):
        return 1.0 + 0.05 * jax.random.normal(next(ks), shape, jnp.float32)

    def bias(shape):
        return 0.02 * jax.random.normal(next(ks), shape, jnp.float32)

    return {
        "x": jax.random.normal(next(ks), (BATCH, SEQ, D), jnp.float32),
        "c": jax.random.normal(next(ks), (BATCH, D), jnp.float32),
        "ctx": jax.random.normal(next(ks), (BATCH, CTX_LEN, D), jnp.float32),
        "c_ctx": jax.random.normal(next(ks), (D,), jnp.float32),
        "mod_w": nrm((DEPTH, D, N_MOD * D), D, 0.5),
        "mod_b": bias((DEPTH, N_MOD * D)),
        "norm_g": gain((DEPTH, 3, D)),
        "ffn_w_gate": nrm((DEPTH, 2, D, D_FF), D),
        "ffn_w_up": nrm((DEPTH, 2, D, D_FF), D),
        "ffn_w_down": nrm((DEPTH, 2, D_FF, D), D_FF),
        "gm_w_in": nrm((N_A, D, 2 * GM_INNER), D),
        "gm_ln_g": gain((N_A, GM_INNER)),
        "gm_ln_b": bias((N_A, GM_INNER)),
        "gm_w_s": nrm((N_A, GM_GROUPS, CHUNK, CHUNK), CHUNK),
        "gm_b_s": bias((N_A, GM_GROUPS, CHUNK)),
        "gm_w_out": nrm((N_A, GM_INNER, D), GM_INNER),
        "mla_w_dq": nrm((N_B, D, Q_LORA), D),
        "mla_q_norm": gain((N_B, Q_LORA)),
        "mla_w_uq": nrm((N_B, Q_LORA, MLA_HEADS * QK_DIM), Q_LORA),
        "mla_w_dkv": nrm((N_B, D, KV_LORA + QK_ROPE), D),
        "mla_kv_norm": gain((N_B, KV_LORA)),
        "mla_w_ukv": nrm((N_B, KV_LORA, MLA_HEADS * (QK_NOPE + V_DIM)), KV_LORA),
        "mla_w_o": nrm((N_B, MLA_HEADS * V_DIM, D), MLA_HEADS * V_DIM),
        "final_g": gain((D,)),
    }


def reference(x, c, ctx, c_ctx, mod_w, mod_b, norm_g, ffn_w_gate, ffn_w_up, ffn_w_down,
              gm_w_in, gm_ln_g, gm_ln_b, gm_w_s, gm_b_s, gm_w_out,
              mla_w_dq, mla_q_norm, mla_w_uq, mla_w_dkv, mla_kv_norm, mla_w_ukv, mla_w_o,
              final_g):
    rope = axial_rope_tables(x.shape[1], x.dtype)
    y = ctx
    for i in range(DEPTH):
        last = i == DEPTH - 1
        use_a = i % N_MIXERS == 0
        j = i // N_MIXERS
        ctx_needed = (not last) or (not use_a)
        m_x = adaln(c, mod_w[i], mod_b[i])
        m_y = adaln(c_ctx[None], mod_w[i], mod_b[i])
        x = ffn_sublayer(x, m_x, 0, norm_g[i, 0], ffn_w_gate[i, 0], ffn_w_up[i, 0], ffn_w_down[i, 0])
        if ctx_needed:
            y = ffn_sublayer(y, m_y, 0, norm_g[i, 0], ffn_w_gate[i, 0], ffn_w_up[i, 0], ffn_w_down[i, 0])
        hx = pre_mod(x, m_x, 1, norm_g[i, 1])
        if use_a:
            gm = (gm_w_in[j], gm_ln_g[j], gm_ln_b[j], gm_w_s[j], gm_b_s[j], gm_w_out[j])
            ox = chunk_gmlp(hx, *gm)
            oy = chunk_gmlp(pre_mod(y, m_y, 1, norm_g[i, 1]), *gm) if not last else None
        else:
            hy = pre_mod(y, m_y, 1, norm_g[i, 1])
            ox, oy = mla(hx, hy, mla_w_dq[j], mla_q_norm[j], mla_w_uq[j], mla_w_dkv[j],
                         mla_kv_norm[j], mla_w_ukv[j], mla_w_o[j], rope, not last)
        x = x + m_x[:, :, 5] * ox
        x = ffn_sublayer(x, m_x, 2, norm_g[i, 2], ffn_w_gate[i, 1], ffn_w_up[i, 1], ffn_w_down[i, 1])
        if not last:
            y = y + m_y[:, :, 5] * oy
            y = ffn_sublayer(y, m_y, 2, norm_g[i, 2], ffn_w_gate[i, 1], ffn_w_up[i, 1], ffn_w_down[i, 1])
    return rms_norm(x, final_g)
```

```cpp
#include <hip/hip_runtime.h>
#include <cstdio>
#include <cstdint>
#define MK_SPLIT 1
namespace pg8 {
#define PG8_LAS __attribute__((address_space(3)))
typedef unsigned short bf16_t;
typedef short bf16x8 __attribute__((ext_vector_type(8)));
typedef float f32x4 __attribute__((ext_vector_type(4)));
typedef unsigned u32x4 __attribute__((ext_vector_type(4)));
constexpr int BM = 256, BK = 64, HALF = 128, HTB = HALF * BK * 2  , STAGE_BYTES = 8 * HTB, NXCD = 8, WGM = 8;

__host__ __device__ __forceinline__ int lds_byte(int r, int c) { const int st = (r >> 4) * 2 + (c >> 5), rr = r & 15, cc = c & 31, ob = rr * 64 + cc * 2; return st * 1024 + (ob ^ (((ob >> 9) & 1) << 5)); }
__host__ __device__ __forceinline__ void stage_rc(int b, int& R, int& C) { const int st = b / 1024, sb = b % 1024, swz = sb ^ (((sb >> 9) & 1) << 5); R = (st >> 1) * 16 + swz / 64; C = (st & 1) * 32 + (swz % 64) / 2; }
__host__ __device__ __forceinline__ int perm32(int rho) { const int n = rho >> 4, i = rho & 15; return 8 * (i >> 2) + 4 * n + (i & 3); }

struct Unit { int pm, pn; };
struct Gemm { const bf16_t* A; const bf16_t* Bt; int M, N, K; };

struct StaticOrder {
    int nM, nN, nwg, G, c;
    __host__ __device__ void init(int M, int N, int G_, int c_) { nM = M / BM; nN = N / BM; nwg = nM * nN; G = G_; c = c_; }
    __host__ __device__ bool next(int i, Unit& u) const {
        const long L = (long)i * G + c; if (L >= nwg) return false;
        int wgid = (int)L; { const int q = nwg / NXCD, r = nwg % NXCD, xcd = wgid % NXCD, off = wgid / NXCD; wgid = (xcd < r ? xcd * (q + 1) : r * (q + 1) + (xcd - r) * q) + off; }
        const int nig = WGM * nN, gid = wgid / nig, fm = gid * WGM, gsz = (nM - fm) < WGM ? (nM - fm) : WGM;
        u.pm = fm + ((wgid % nig) % gsz); u.pn = (wgid % nig) / gsz; return true;
    }
    __device__ __forceinline__ void a_ready(const Unit&) const {}
    __device__ __forceinline__ void done(const Unit&) const {}
};

__device__ __forceinline__ unsigned cvt_pk_bf16(float lo, float hi) { unsigned r; asm volatile("v_cvt_pk_bf16_f32 %0, %1, %2" : "=v"(r) : "v"(lo), "v"(hi)); return r; }
typedef float f32x2 __attribute__((ext_vector_type(2)));
template <class Epi, class Sched, bool ALIGN_EPI = false, bool SP2 = false>
__device__ __forceinline__ void gemm_phase(PG8_LAS unsigned char* lds, const Gemm g, const Sched& S, const Epi& E) {
    const int tid = threadIdx.x, wid = __builtin_amdgcn_readfirstlane(tid >> 6), lane = tid & 63, wr = wid >> 2, wc = wid & 3, fr = lane & 15, fq = lane >> 4;
    const int K = g.K, nt = K / BK;
    unsigned voffA[2], voffB[2];
#pragma unroll
    for (int i = 0; i < 2; ++i) { int R, C; stage_rc(tid * 16 + i * 8192, R, C); const int Rb = Epi::PERM ? ((R & ~31) + perm32(R & 31)) : R;
        voffA[i] = (unsigned)(R * K + C) * 2u; voffB[i] = (unsigned)(Rb * K + C) * 2u; }
    const size_t kstep = (size_t)(BK * 2);
    const size_t hstep = (size_t)HALF * K * 2;
    const size_t tstep = 2 * hstep;
    const unsigned ldsw = (unsigned)wid * 1024u;
    const int aoff = lds_byte(wr * 64 + fr, fq * 8), boff = lds_byte(wc * 32 + fr, fq * 8);
#define PG8_SA(b, h) (((b) * 2 + (h)) * HTB)
#define PG8_SB(b, h) ((4 + (b) * 2 + (h)) * HTB)
#define PG8_STAGE(bufoff, gbase, voff) do { _Pragma("unroll") for (int _i = 0; _i < 2; ++_i) \
        __builtin_amdgcn_global_load_lds((const unsigned*)((const char*)(gbase) + (voff)[_i]), (PG8_LAS unsigned*)(lds + (bufoff) + ldsw + _i * 8192), 16, 0, 0); } while (0)
#define PG8_LDA(dst, b, h) do { _Pragma("unroll") for (int m = 0; m < 4; ++m) _Pragma("unroll") for (int k = 0; k < 2; ++k) dst[m][k] = *(const PG8_LAS bf16x8*)(lds + PG8_SA(b, h) + aoff + m * 2048 + k * 1024); } while (0)
#define PG8_LDB(dst, b, h) do { _Pragma("unroll") for (int n = 0; n < 2; ++n) _Pragma("unroll") for (int k = 0; k < 2; ++k) dst[n][k] = *(const PG8_LAS bf16x8*)(lds + PG8_SB(b, h) + boff + n * 2048 + k * 1024); } while (0)
#define PG8_MMA(ai, bj, At, Bt) do { __builtin_amdgcn_s_setprio(1); _Pragma("unroll") for (int m = 0; m < 4; ++m) _Pragma("unroll") for (int n = 0; n < 2; ++n) _Pragma("unroll") for (int k = 0; k < 2; ++k) \
        acc[ai][bj][m][n] = __builtin_amdgcn_mfma_f32_16x16x32_bf16(Bt[n][k], At[m][k], acc[ai][bj][m][n], 0, 0, 0); __builtin_amdgcn_s_setprio(0); } while (0)
#define PG8_WAIT_V(n) asm volatile("s_waitcnt vmcnt(" #n ")" ::: "memory")
#define PG8_WAIT_L(n) asm volatile("s_waitcnt lgkmcnt(" #n ")" ::: "memory")
#define PG8_BAR __builtin_amdgcn_s_barrier()
#define PG8_SCHED __builtin_amdgcn_sched_barrier(0)
    Unit cur, nxt; int ui = 0;
    if (!S.next(0, cur)) return;
    f32x4 acc[2][2][4][2];
#pragma unroll
    for (int a = 0; a < 2; ++a)
#pragma unroll
        for (int b = 0; b < 2; ++b)
#pragma unroll
            for (int m = 0; m < 4; ++m)
#pragma unroll
                for (int n = 0; n < 2; ++n) acc[a][b][m][n] = (f32x4){0.f, 0.f, 0.f, 0.f};
    bf16x8 At[4][2], B0[2][2], B1[2][2];
    const char* cA = (const char*)g.A + (size_t)cur.pm * tstep; const char* cB = (const char*)g.Bt + (size_t)cur.pn * tstep;
    S.a_ready(cur);
    if constexpr (SP2) {
        PG8_STAGE(PG8_SB(0, 0), cB, voffB); PG8_STAGE(PG8_SB(0, 1), cB + hstep, voffB); PG8_STAGE(PG8_SA(0, 0), cA, voffA); PG8_STAGE(PG8_SA(0, 1), cA + hstep, voffA);
        if (wr == 1) PG8_BAR;
        PG8_WAIT_V(2); PG8_BAR;
        PG8_STAGE(PG8_SB(1, 0), cB + kstep, voffB); PG8_STAGE(PG8_SA(1, 0), cA + kstep, voffA); PG8_STAGE(PG8_SB(1, 1), cB + hstep + kstep, voffB);
        PG8_WAIT_V(6); PG8_BAR;
    } else {
        PG8_STAGE(PG8_SB(0, 0), cB, voffB); PG8_STAGE(PG8_SA(0, 0), cA, voffA); PG8_STAGE(PG8_SB(0, 1), cB + hstep, voffB); PG8_STAGE(PG8_SA(0, 1), cA + hstep, voffA);
        if (wr == 1) PG8_BAR;
        PG8_WAIT_V(4); PG8_BAR;
        PG8_STAGE(PG8_SB(1, 0), cB + kstep, voffB); PG8_STAGE(PG8_SA(1, 0), cA + kstep, voffA); PG8_STAGE(PG8_SB(1, 1), cB + hstep + kstep, voffB);
        PG8_WAIT_V(6); PG8_BAR;
    }
    for (;;) {
        const bool has_next = S.next(ui + 1, nxt);
        const char* nA = has_next ? (const char*)g.A + (size_t)nxt.pm * tstep : cA; const char* nB = has_next ? (const char*)g.Bt + (size_t)nxt.pn * tstep : cB;
        for (int t = 0; t < nt; t += 2) {
            const bool last = (t == nt - 2);
            const char* a1 = cA + (size_t)(t + 1) * kstep;
            const char* a2 = last ? nA : cA + (size_t)(t + 2) * kstep; const char* b2 = last ? nB : cB + (size_t)(t + 2) * kstep;
            const char* a3 = a2 + kstep; const char* b3 = b2 + kstep;
            if (last && has_next) S.a_ready(nxt);
            if constexpr (SP2) {
            PG8_LDB(B0, 0, 0); PG8_LDB(B1, 0, 1); PG8_SCHED; PG8_LDA(At, 0, 0); PG8_STAGE(PG8_SA(1, 1), a1 + hstep, voffA);
            PG8_WAIT_V(8); PG8_WAIT_L(0); PG8_BAR; PG8_MMA(0, 0, At, B0); PG8_MMA(0, 1, At, B1); PG8_BAR; PG8_SCHED;
            PG8_LDA(At, 0, 1); PG8_STAGE(PG8_SB(0, 0), b2, voffB); PG8_STAGE(PG8_SB(0, 1), b2 + hstep, voffB); PG8_STAGE(PG8_SA(0, 0), a2, voffA);
            PG8_WAIT_V(8); PG8_WAIT_L(0); PG8_BAR; PG8_MMA(1, 0, At, B0); PG8_MMA(1, 1, At, B1); PG8_BAR; PG8_SCHED;
            PG8_LDB(B0, 1, 0); PG8_LDB(B1, 1, 1); PG8_SCHED; PG8_LDA(At, 1, 0); PG8_STAGE(PG8_SA(0, 1), a2 + hstep, voffA);
            PG8_WAIT_V(8); PG8_WAIT_L(0); PG8_BAR; PG8_MMA(0, 0, At, B0); PG8_MMA(0, 1, At, B1); PG8_BAR; PG8_SCHED;
            PG8_LDA(At, 1, 1); PG8_STAGE(PG8_SB(1, 0), b3, voffB); PG8_STAGE(PG8_SB(1, 1), b3 + hstep, voffB); PG8_STAGE(PG8_SA(1, 0), a3, voffA);
            PG8_WAIT_V(8); PG8_WAIT_L(0); PG8_BAR; PG8_MMA(1, 0, At, B0); PG8_MMA(1, 1, At, B1); PG8_BAR; PG8_SCHED;
            } else {
            PG8_LDB(B0, 0, 0); PG8_SCHED; PG8_LDA(At, 0, 0); PG8_STAGE(PG8_SA(1, 1), a1 + hstep, voffA);
            PG8_WAIT_L(8); PG8_BAR; PG8_WAIT_L(0); PG8_MMA(0, 0, At, B0); PG8_BAR; PG8_SCHED;
            PG8_LDB(B1, 0, 1); PG8_STAGE(PG8_SB(0, 0), b2, voffB);
            PG8_BAR; PG8_WAIT_L(0); PG8_MMA(0, 1, At, B1); PG8_BAR;
            PG8_LDA(At, 0, 1); PG8_STAGE(PG8_SA(0, 0), a2, voffA);
            PG8_BAR; PG8_WAIT_L(0); PG8_MMA(1, 0, At, B0); PG8_BAR; PG8_SCHED;
            PG8_STAGE(PG8_SB(0, 1), b2 + hstep, voffB);
            PG8_WAIT_V(6); PG8_BAR; PG8_MMA(1, 1, At, B1); PG8_BAR;
            PG8_LDB(B0, 1, 0); PG8_SCHED; PG8_LDA(At, 1, 0); PG8_STAGE(PG8_SA(0, 1), a2 + hstep, voffA);
            PG8_WAIT_L(8); PG8_BAR; PG8_WAIT_L(0); PG8_MMA(0, 0, At, B0); PG8_BAR; PG8_SCHED;
            PG8_LDB(B1, 1, 1); PG8_STAGE(PG8_SB(1, 0), b3, voffB);
            PG8_BAR; PG8_WAIT_L(0); PG8_MMA(0, 1, At, B1); PG8_BAR;
            PG8_LDA(At, 1, 1); PG8_STAGE(PG8_SA(1, 0), a3, voffA);
            PG8_BAR; PG8_WAIT_L(0); PG8_MMA(1, 0, At, B0); PG8_BAR; PG8_SCHED;
            PG8_STAGE(PG8_SB(1, 1), b3 + hstep, voffB);
            PG8_WAIT_V(6); PG8_BAR; PG8_MMA(1, 1, At, B1); PG8_BAR;
            }
        }
        if constexpr (ALIGN_EPI) { if (wr == 0) PG8_BAR; }
        if constexpr (!Epi::AFTER_DRAIN) { E(acc, cur, wr, wc, fr, fq); S.done(cur); }
        if (!has_next) break;
#pragma unroll
        for (int a = 0; a < 2; ++a)
#pragma unroll
            for (int b = 0; b < 2; ++b)
#pragma unroll
                for (int m = 0; m < 4; ++m)
#pragma unroll
                    for (int n = 0; n < 2; ++n) acc[a][b][m][n] = (f32x4){0.f, 0.f, 0.f, 0.f};
        cur = nxt; cA = nA; cB = nB; ++ui;
        if constexpr (ALIGN_EPI) { if (wr == 1) PG8_BAR; }
    }
    PG8_WAIT_V(0);
    if constexpr (!ALIGN_EPI) { if (wr == 0) PG8_BAR; }
    PG8_BAR;
    if constexpr (Epi::AFTER_DRAIN) { E.fused(acc, cur, wr, wc, fr, fq, lds, wid, lane); S.done(cur); }
#undef PG8_SA
#undef PG8_SB
#undef PG8_STAGE
#undef PG8_LDA
#undef PG8_LDB
#undef PG8_MMA
#undef PG8_WAIT_V
#undef PG8_WAIT_L
#undef PG8_BAR
#undef PG8_SCHED
}
}
#define GAS __attribute__((address_space(1)))
#define LAS __attribute__((address_space(3)))
typedef unsigned short bf16;
typedef unsigned v4u __attribute__((ext_vector_type(4)));
typedef float f32x4 __attribute__((ext_vector_type(4)));
typedef short bf16x8 __attribute__((ext_vector_type(8)));
typedef GAS unsigned gu32;
typedef GAS unsigned long long gu64;
#define RLX_AGENT __ATOMIC_RELAXED, __HIP_MEMORY_SCOPE_AGENT
#define LDS_WAIT() asm volatile("s_waitcnt lgkmcnt(0)" ::: "memory")
#define VM_WAIT() asm volatile("s_waitcnt vmcnt(0)" ::: "memory")
__device__ __forceinline__ unsigned long long rt() { return __builtin_amdgcn_s_memrealtime(); }
__device__ __forceinline__ unsigned f2bf(float f) { unsigned u = __builtin_bit_cast(unsigned, f); return (u + 0x7fffu + ((u >> 16) & 1u)) >> 16; }
__device__ __forceinline__ unsigned pk2(float lo, float hi) { return f2bf(lo) | (f2bf(hi) << 16); }

#define XB_TMO      128
#define XB_XCNT(j)  (256  + 64 * (j))
#define XB_XSUB(j)  (1280 + 64 * (j))
#define XB_XGEN(j)  (2304 + 64 * (j))
#define XB_TOP      3328
#define XB_TOPGEN   3392
#define XCD_BAR_WORDS 3456
#define XB_SPIN_CAP (1u << 18)

__device__ __forceinline__ unsigned xb_ld(unsigned* p)              { return __hip_atomic_load(p, __ATOMIC_RELAXED, __HIP_MEMORY_SCOPE_AGENT); }
__device__ __forceinline__ unsigned xb_add(unsigned* p, unsigned v) { return __hip_atomic_fetch_add(p, v, __ATOMIC_RELAXED, __HIP_MEMORY_SCOPE_AGENT); }
__device__ __forceinline__ unsigned xb_xcc_id() { return (unsigned)__builtin_amdgcn_s_getreg((3 << 11) | 20) & 0xFu; }
#define XB_SPIN(cond, bar) do { unsigned _sp = 0; while (cond) { __builtin_amdgcn_s_sleep(1); \
    if ((++_sp & 255u) == 0u) { if (xb_ld(&(bar)[XB_TMO])) break; if (_sp > XB_SPIN_CAP) { atomicAdd(&(bar)[XB_TMO], 1u); break; } } } } while (0)

struct XcdBarrier {
    unsigned* bar; unsigned x;
    volatile LAS unsigned* st;
};

__device__ __forceinline__ XcdBarrier xcd_barrier_post(unsigned* bar, volatile LAS unsigned* st) {
    XcdBarrier b; b.bar = bar; b.x = xb_xcc_id(); b.st = st;
    if (threadIdx.x == 0) (void)xb_add(&bar[XB_XCNT(b.x)], 1u);
    return b;
}
__device__ __forceinline__ void xcd_barrier_complete(unsigned* bar, unsigned x, unsigned& nloc, unsigned& nx) {
    const unsigned G = gridDim.x * gridDim.y * gridDim.z;
    unsigned sum, cnt, mine, sp = 0u;
    for (;;) {
        sum = 0u; cnt = 0u; mine = 0u;
#pragma unroll
        for (unsigned j = 0; j < 16; ++j) { const unsigned c = xb_ld(&bar[XB_XCNT(j)]); sum += c; cnt += (c > 0u) ? 1u : 0u; mine = (j == x) ? c : mine; }
        if (sum == G) break;
        __builtin_amdgcn_s_sleep(1);
        if ((++sp & 255u) == 0u) { if (xb_ld(&bar[XB_TMO])) break; if (sp > XB_SPIN_CAP) { atomicAdd(&bar[XB_TMO], 1u); break; } }
    }
    nloc = mine > 0u ? mine : 1u; nx = cnt > 0u ? cnt : 1u;
}

__device__ __forceinline__ void xcd_barrier(const XcdBarrier& b) {
    asm volatile("s_waitcnt vmcnt(0)" ::: "memory");
    __syncthreads();
    if (threadIdx.x == 0) {
        unsigned* bar = b.bar;
        __builtin_amdgcn_s_waitcnt(0);
        unsigned nloc = b.st[0], nx = b.st[1];
        if (nloc == 0u) { xcd_barrier_complete(bar, b.x, nloc, nx); b.st[0] = nloc; b.st[1] = nx; }
        const unsigned old = xb_add(&bar[XB_XSUB(b.x)], 1u);
        const unsigned gen = old / nloc;
        if (old + 1u == (gen + 1u) * nloc) {
            __builtin_amdgcn_fence(__ATOMIC_RELEASE, "agent");
            asm volatile("s_waitcnt vmcnt(0)" ::: "memory");
            const unsigned og = xb_add(&bar[XB_TOP], 1u);
            const unsigned tg = og / nx;
            if (og + 1u == (tg + 1u) * nx) xb_add(&bar[XB_TOPGEN], 1u);
            else XB_SPIN(xb_ld(&bar[XB_TOPGEN]) == tg, bar);
            __builtin_amdgcn_fence(__ATOMIC_ACQUIRE, "agent");
            xb_add(&bar[XB_XGEN(b.x)], 1u);
            asm volatile("s_waitcnt vmcnt(0)" ::: "memory");
        } else {
            XB_SPIN(xb_ld(&bar[XB_XGEN(b.x)]) == gen, bar);
            __builtin_amdgcn_fence(__ATOMIC_ACQUIRE, "agent");
            asm volatile("s_waitcnt vmcnt(0)" ::: "memory");
        }
    }
    __syncthreads();
}

typedef float f32x16 __attribute__((ext_vector_type(16)));
typedef short s16x4 __attribute__((ext_vector_type(4)));
typedef unsigned u32x2 __attribute__((ext_vector_type(2)));

constexpr int D = 2048, FF = 5632, NGU = 2 * FF, SEQ = 16384, NB = 2, CTXL = 256;
constexpr int M_LAT = NB * SEQ;
constexpr int M_CTX = NB * CTXL;
constexpr int M_ALL = M_LAT + M_CTX;
constexpr int NMODV = 9 * D;
constexpr int QLORA = 448, KVLORA = 160, ROPE = 64, NHEAD = 16, DQK = 192, DVH = 128;
constexpr int NDQKV = 768;
constexpr int KQ = 512, KKV = 256;
constexpr float EPS = 1e-6f;
constexpr int KSPLIT = 14;
constexpr int NWAVES = 8;

constexpr size_t MiB = 1u << 20;
constexpr size_t WS_CTL = 0, CTL_ZERO_BYTES = 1 * MiB;
constexpr size_t WS_STATS = 512 * 1024;
constexpr size_t WS_MOD = 1 * MiB;
constexpr size_t WS_ROPE = 2 * MiB;
constexpr size_t WS_MODP = 3 * MiB;
constexpr size_t WS_WGU = 10 * MiB;
constexpr size_t SZ_WGU = 44 * MiB;
constexpr size_t WS_WD = WS_WGU + 4 * SZ_WGU;
constexpr size_t SZ_WD = 22 * MiB;
constexpr size_t WS_GMIN = WS_WD + 4 * SZ_WD;
constexpr size_t WS_GMOUT = WS_GMIN + 16 * MiB;
constexpr size_t WS_WDQKV = WS_GMOUT + 8 * MiB;
constexpr size_t WS_WUQ = WS_WDQKV + 3 * MiB;
constexpr size_t WS_WUKV = WS_WUQ + 3 * MiB;
constexpr size_t WS_WO = WS_WUKV + 2 * MiB;
constexpr size_t WS_Y = WS_WO + 8 * MiB;
constexpr size_t WS_XN = WS_Y + 4 * MiB;
constexpr size_t WS_BIG = WS_XN + 130 * MiB;
constexpr size_t WS_U = WS_BIG, WS_V = WS_BIG + 130 * MiB;
constexpr size_t WS_Q = WS_BIG, WS_KN = WS_BIG + 192 * MiB, WS_VV = WS_KN + 130 * MiB, WS_F = WS_VV + 130 * MiB;
constexpr size_t WS_CQ = WS_F + 98 * MiB, WS_CKV = WS_CQ + 33 * MiB, WS_KPE = WS_CKV + 17 * MiB, WS_END = WS_KPE + 5 * MiB;
static_assert((size_t)M_ALL * D * 2 <= 130 * MiB && (size_t)M_ALL * FF * 2 <= 358 * MiB && (size_t)M_LAT * 3072 * 2 <= 192 * MiB, "ws map");
static_assert((size_t)M_ALL * NDQKV * 4 <= 98 * MiB && (size_t)M_ALL * KQ * 2 <= 33 * MiB && (size_t)M_ALL * KKV * 2 <= 17 * MiB && (size_t)M_ALL * 64 * 2 <= 5 * MiB, "ws map 2");
static_assert(WS_STATS + (size_t)M_ALL * 8 <= CTL_ZERO_BYTES, "stats inside the zeroed region");
constexpr int CW_TMO = 0, CW_CODE = 1, CW_BAR = 4096;

constexpr int RING_OFF = 0, RING_BYTES = 131072;
constexpr int ATT_SHM_V = 64 * 256, ATT_SHM_K = 64 * 384;
constexpr int ATT_OFF_K = 2 * ATT_SHM_V, ATT_OFF_WS = ATT_OFF_K + 2 * ATT_SHM_K, ATT_OFF_QPE = ATT_OFF_WS + NWAVES * 256, ATT_NQR = 5, ATT_END = ATT_OFF_QPE + NWAVES * (12 - ATT_NQR) * 1024, ATT_OFF_OST = 0;
static_assert(NWAVES * 8192 <= ATT_OFF_WS, "O stage overlays the K/V buffers");
constexpr int MISC_OFF = 141312, LDS_BYTES = 141312 + 512;
static_assert(ATT_END <= MISC_OFF && RING_BYTES <= MISC_OFF && MISC_OFF + 128 <= LDS_BYTES, "LDS map");

enum Phase { PH_PRO = 0, PH_MOD, PH_L0 = 2,
             PH_END = 27 };
constexpr int N_PHASES = 25;

struct Args { const float* in[24]; float* out; unsigned char* ws; int ph_lo, ph_hi; };
static_assert(sizeof(Args) == 24 * 8 + 8 + 8 + 8, "Args has no padding");

struct Frame {
    LAS unsigned char* lds;
    gu32* ctl;
    int wave, vcu, G;
};
__device__ __forceinline__ int mk_lane() { int l; asm volatile("v_mbcnt_lo_u32_b32 %0, -1, 0\n\tv_mbcnt_hi_u32_b32 %0, -1, %0" : "=v"(l)); return l; }

__device__ __forceinline__ float wave_sum(float v) {
#pragma unroll
    for (int o = 1; o < 64; o <<= 1) v += __shfl_xor(v, o);
    return v;
}
__device__ __forceinline__ float silu_f(float x) { return x * __builtin_amdgcn_rcpf(1.0f + __builtin_amdgcn_exp2f(-1.4426950408889634f * x)); }
__device__ __forceinline__ float gelu_tanh_f(float x) {
    const float z = 0.7978845608028654f * (x + 0.044715f * x * x * x);
    return x * __builtin_amdgcn_rcpf(1.0f + __builtin_amdgcn_exp2f(-2.0f * 1.4426950408889634f * z));
}
__device__ __forceinline__ int cond_of_row(int r) { return r < SEQ ? 0 : (r < M_LAT ? 1 : 2); }

struct EpiSwiGLU {
    static constexpr bool PERM = true, AFTER_DRAIN = false;
    pg8::bf16_t* H;
    __device__ __forceinline__ void operator()(const pg8::f32x4 (&acc)[2][2][4][2], const pg8::Unit& u, int wr, int wc, int fr, int fq) const {
        const int row0 = u.pm * 256 + wr * 64 + fr, col0 = u.pn * 128 + wc * 32 + 8 * fq;
#pragma unroll
        for (int ai = 0; ai < 2; ++ai)
#pragma unroll
            for (int m = 0; m < 4; ++m) {
                pg8::bf16_t* rowp = H + (size_t)(row0 + ai * 128 + m * 16) * FF + col0;
                float h[8];
#pragma unroll
                for (int n = 0; n < 2; ++n)
#pragma unroll
                    for (int j = 0; j < 4; ++j) h[n * 4 + j] = silu_f(acc[ai][0][m][n][j]) * acc[ai][1][m][n][j];
                pg8::u32x4 w; w.x = pg8::cvt_pk_bf16(h[0], h[1]); w.y = pg8::cvt_pk_bf16(h[2], h[3]); w.z = pg8::cvt_pk_bf16(h[4], h[5]); w.w = pg8::cvt_pk_bf16(h[6], h[7]);
                *(pg8::u32x4*)rowp = w;
            }
    }
};
struct EpiResid {
    static constexpr bool PERM = false, AFTER_DRAIN = false;
    const float* baseL; const float* baseC; float* outL; float* outC;
    const float* gate;
    float coef;
    __device__ __forceinline__ void operator()(const pg8::f32x4 (&acc)[2][2][4][2], const pg8::Unit& u, int wr, int wc, int fr, int fq) const {
        const int row0 = u.pm * 256 + wr * 64 + fr, col0 = u.pn * 256 + wc * 32 + 4 * fq;
        const int cond = u.pm < 64 ? 0 : (u.pm < 128 ? 1 : 2);
        const float* base = u.pm < 128 ? baseL : baseC; float* out = u.pm < 128 ? outL : outC;
        const float* gv = gate + (size_t)cond * NMODV + col0;
        pg8::f32x4 g[2][2];
#pragma unroll
        for (int bj = 0; bj < 2; ++bj)
#pragma unroll
            for (int n = 0; n < 2; ++n) g[bj][n] = *(const pg8::f32x4*)(gv + bj * 128 + n * 16) * coef;
#pragma unroll
        for (int ai = 0; ai < 2; ++ai)
#pragma unroll
            for (int m = 0; m < 4; ++m) {
                const size_t off = (size_t)(row0 + ai * 128 + m * 16) * D + col0;
#pragma unroll
                for (int bj = 0; bj < 2; ++bj)
#pragma unroll
                    for (int n = 0; n < 2; ++n) {
                        const pg8::f32x4 b = *(const pg8::f32x4*)(base + off + bj * 128 + n * 16);
                        *(pg8::f32x4*)(out + off + bj * 128 + n * 16) = b + g[bj][n] * acc[ai][bj][m][n];
                    }
            }
    }
};
struct EpiGeluUV {
    static constexpr bool PERM = true, AFTER_DRAIN = false;
    pg8::bf16_t* U; pg8::bf16_t* V; float* stats;
    __device__ __forceinline__ void operator()(const pg8::f32x4 (&acc)[2][2][4][2], const pg8::Unit& u, int wr, int wc, int fr, int fq) const {
        const int row0 = u.pm * 256 + wr * 64 + fr;
        const bool isv = u.pn >= 8;
        pg8::bf16_t* base = isv ? V : U;
        const int col0 = (u.pn & 7) * 256 + wc * 32 + 8 * fq;
#pragma unroll
        for (int ai = 0; ai < 2; ++ai)
#pragma unroll
            for (int m = 0; m < 4; ++m) {
                const int row = row0 + ai * 128 + m * 16;
                pg8::bf16_t* rowp = base + (size_t)row * D + col0;
                float s = 0.f, q = 0.f;
#pragma unroll
                for (int bj = 0; bj < 2; ++bj) {
                    float z[8];
#pragma unroll
                    for (int n = 0; n < 2; ++n)
#pragma unroll
                        for (int j = 0; j < 4; ++j) { const float t = gelu_tanh_f(acc[ai][bj][m][n][j]); z[n * 4 + j] = t; s += t; q += t * t; }
                    pg8::u32x4 w; w.x = pg8::cvt_pk_bf16(z[0], z[1]); w.y = pg8::cvt_pk_bf16(z[2], z[3]); w.z = pg8::cvt_pk_bf16(z[4], z[5]); w.w = pg8::cvt_pk_bf16(z[6], z[7]);
                    *(pg8::u32x4*)(rowp + bj * 128) = w;
                }
                if (isv) {
                    s += __shfl_xor(s, 16); s += __shfl_xor(s, 32); q += __shfl_xor(q, 16); q += __shfl_xor(q, 32);
                    if (fq == 0) { atomicAdd(stats + 2 * row, s); atomicAdd(stats + 2 * row + 1, q); }
                }
            }
    }
};
struct EpiF32 {
    static constexpr bool PERM = false, AFTER_DRAIN = false;
    float* C; int ldc;
    __device__ __forceinline__ void operator()(const pg8::f32x4 (&acc)[2][2][4][2], const pg8::Unit& u, int wr, int wc, int fr, int fq) const {
        const int row0 = u.pm * 256 + wr * 64 + fr, col0 = u.pn * 256 + wc * 32 + 4 * fq;
#pragma unroll
        for (int ai = 0; ai < 2; ++ai)
#pragma unroll
            for (int m = 0; m < 4; ++m) { float* rowp = C + (size_t)(row0 + ai * 128 + m * 16) * ldc + col0;
#pragma unroll
                for (int bj = 0; bj < 2; ++bj)
#pragma unroll
                    for (int n = 0; n < 2; ++n) *(pg8::f32x4*)(rowp + bj * 128 + n * 16) = acc[ai][bj][m][n]; }
    }
};
struct EpiQRope {
    static constexpr bool PERM = true, AFTER_DRAIN = false;
    pg8::bf16_t* Q; const float* rope;
    __device__ __forceinline__ void operator()(const pg8::f32x4 (&acc)[2][2][4][2], const pg8::Unit& u, int wr, int wc, int fr, int fq) const {
        const int row0 = u.pm * 256 + wr * 64 + fr;
#pragma unroll
        for (int bj = 0; bj < 2; ++bj) {
            const int g32 = u.pn * 8 + bj * 4 + wc, gh = g32 % 6;
            const int col0 = g32 * 32 + 8 * fq;
#pragma unroll
            for (int ai = 0; ai < 2; ++ai)
#pragma unroll
                for (int m = 0; m < 4; ++m) {
                    const int row = row0 + ai * 128 + m * 16;
                    float x[8];
#pragma unroll
                    for (int n = 0; n < 2; ++n)
#pragma unroll
                        for (int j = 0; j < 4; ++j) x[n * 4 + j] = acc[ai][bj][m][n][j];
                    if (gh >= 4) {
                        const int t = row & (SEQ - 1), pos = (gh == 4) ? (t >> 6) : (t & 63);
                        const float* cp = rope + pos * 16 + 8 * (fq & 1); const float* sp = cp + 256 * 16;
                        const float sgn = (fq & 2) ? 1.f : -1.f;
#pragma unroll
                        for (int e = 0; e < 8; ++e) { const float p = __shfl_xor(x[e], 32); x[e] = x[e] * cp[e] + sgn * p * sp[e]; }
                    }
                    pg8::u32x4 w; w.x = pg8::cvt_pk_bf16(x[0], x[1]); w.y = pg8::cvt_pk_bf16(x[2], x[3]); w.z = pg8::cvt_pk_bf16(x[4], x[5]); w.w = pg8::cvt_pk_bf16(x[6], x[7]);
                    *(pg8::u32x4*)(Q + (size_t)row * 3072 + col0) = w;
                }
        }
    }
};
struct EpiKV {
    static constexpr bool PERM = true, AFTER_DRAIN = false;
    pg8::bf16_t* KN; pg8::bf16_t* V;
    __device__ __forceinline__ void operator()(const pg8::f32x4 (&acc)[2][2][4][2], const pg8::Unit& u, int wr, int wc, int fr, int fq) const {
        const int row0 = u.pm * 256 + wr * 64 + fr, col0 = u.pn * 128 + wc * 32 + 8 * fq;
#pragma unroll
        for (int ai = 0; ai < 2; ++ai)
#pragma unroll
            for (int m = 0; m < 4; ++m) {
                const size_t off = (size_t)(row0 + ai * 128 + m * 16) * D + col0;
#pragma unroll
                for (int bj = 0; bj < 2; ++bj) {
                    const pg8::f32x4 v0 = acc[ai][bj][m][0], v1 = acc[ai][bj][m][1];
                    pg8::u32x4 w; w.x = pg8::cvt_pk_bf16(v0[0], v0[1]); w.y = pg8::cvt_pk_bf16(v0[2], v0[3]); w.z = pg8::cvt_pk_bf16(v1[0], v1[1]); w.w = pg8::cvt_pk_bf16(v1[2], v1[3]);
                    *(pg8::u32x4*)((bj ? V : KN) + off) = w;
                }
            }
    }
};

__device__ __forceinline__ void transpose_item(const float* W, int K, int N, bf16* WT, int Kd, int drow0, int k0, int n0, LAS float* scr, int lane) {
#pragma unroll 8
    for (int i = 0; i < 32; ++i) { const int kk = 2 * i + (lane >> 5), k = k0 + kk; scr[kk * 33 + (lane & 31)] = (k < K) ? W[(size_t)k * N + n0 + (lane & 31)] : 0.f; }
    LDS_WAIT(); asm volatile("" ::: "memory");
    const int c = lane & 7;
#pragma unroll
    for (int j = 0; j < 4; ++j) { const int n = (lane >> 3) + 8 * j; const LAS float* s = scr + (8 * c) * 33 + n;
        v4u o; o.x = pk2(s[0 * 33], s[1 * 33]); o.y = pk2(s[2 * 33], s[3 * 33]); o.z = pk2(s[4 * 33], s[5 * 33]); o.w = pk2(s[6 * 33], s[7 * 33]);
        *(GAS v4u*)(WT + (size_t)(drow0 + n) * Kd + k0 + 8 * c) = o; }
    LDS_WAIT(); asm volatile("" ::: "memory");
}
__device__ __forceinline__ void transpose_mat(const float* W, int K, int N, bf16* WT, int Kd, int drow_off, int r, LAS float* scr, int lane) {
    const int nblk = N / 32, kb = r / nblk, nb = r % nblk;
    transpose_item(W, K, N, WT, Kd, drow_off + 32 * nb, 64 * kb, 32 * nb, scr, lane);
}

__device__ __forceinline__ void ph_prologue(Frame& F, const Args& a) {
    unsigned char* ws = a.ws; const int lane_ = mk_lane(), tid_ = F.wave * 64 + lane_;
    const int gw = F.vcu * NWAVES + F.wave, NGW = F.G * NWAVES;
    LAS float* stab = (LAS float*)(F.lds + 98304);
    for (int k = tid_; k < D; k += NWAVES * 64) {
        pg8::f32x4 s; s.x = silu_f(a.in[1][k]); s.y = silu_f(a.in[1][D + k]); s.z = silu_f(a.in[3][k]); s.w = 0.f;
        *(LAS pg8::f32x4*)(stab + 4 * k) = s;
    }
    __syncthreads();
    {
        constexpr int NT = 2 * 72 * KSPLIT;
        for (int t = gw; t < NT; t += NGW) {
            const int ks = t % KSPLIT, cb = (t / KSPLIT) % 72, l = t / (KSPLIT * 72);
            const int kbeg = ks * D / KSPLIT, kend = (ks + 1) * D / KSPLIT, col = cb * 256 + 4 * lane_;
            const float* w = a.in[4] + ((size_t)l * D + kbeg) * NMODV + col;
            pg8::f32x4 a0 = {0.f, 0.f, 0.f, 0.f}, a1 = a0, a2 = a0;
#pragma unroll 8
            for (int k = kbeg; k < kend; ++k) {
                const pg8::f32x4 wv = *(const pg8::f32x4*)w; w += NMODV;
                const pg8::f32x4 s = *(LAS pg8::f32x4*)(stab + 4 * k);
                a0 += wv * s.x; a1 += wv * s.y; a2 += wv * s.z;
            }
            float* p = (float*)(ws + WS_MODP) + ((size_t)(ks * 2 + l) * 3) * NMODV + col;
            *(pg8::f32x4*)p = a0; *(pg8::f32x4*)(p + NMODV) = a1; *(pg8::f32x4*)(p + 2 * NMODV) = a2;
        }
    }
    for (int i = blockIdx.x * (NWAVES * 64) + tid_; i < 256 * 16; i += F.G * NWAVES * 64) {
        const int pos = i >> 4, f = i & 15;
        const float inv = __builtin_amdgcn_exp2f(-(float)f * (13.287712379549449f / 16.0f));
        const float rev = (float)pos * inv * 0.15915494309189535f;
        float* rp = (float*)(ws + WS_ROPE);
        rp[i] = __builtin_amdgcn_cosf(rev); rp[4096 + i] = __builtin_amdgcn_sinf(rev);
    }
    { v4u z = {0u, 0u, 0u, 0u}; GAS v4u* p = (GAS v4u*)(ws + WS_WDQKV + (size_t)672 * D * 2);
      for (int i = blockIdx.x * (NWAVES * 64) + tid_; i < 96 * D * 2 / 16; i += F.G * NWAVES * 64) p[i] = z; }
    LAS float* scr = (LAS float*)(F.lds + F.wave * 8448);
    constexpr int IT_FFN = 5632, N_FFN = 12 * IT_FFN;
    constexpr int I_GMIN = 32 * 128, I_GMOUT = 32 * 64, I_WO = 32 * 64, I_DQ = 32 * 14, I_DKV = 32 * 7, I_UQ = 8 * 96, I_UKV = 4 * 128;
    constexpr int NITEMS = N_FFN + I_GMIN + I_GMOUT + I_WO + I_DQ + I_DKV + I_UQ + I_UKV;
    for (int it = gw; it < NITEMS; it += NGW) {
        int r = it;
        if (r < N_FFN) {
            const int idx = r / IT_FFN, sub = idx / 3, kind = idx % 3; r -= idx * IT_FFN;
            if (kind < 2) {
                const float* W = a.in[7 + kind] + (size_t)sub * D * FF;
                const int nblk = FF / 32, kb = r / nblk, nb = r % nblk, n0 = 32 * nb;
                transpose_item(W, D, FF, (bf16*)(ws + WS_WGU + sub * SZ_WGU), D, (n0 >> 7) * 256 + kind * 128 + (n0 & 127), 64 * kb, n0, scr, lane_);
            } else {
                transpose_mat(a.in[9] + (size_t)sub * FF * D, FF, D, (bf16*)(ws + WS_WD + sub * SZ_WD), FF, 0, r, scr, lane_);
            }
            continue;
        }
        r -= N_FFN;
        if (r < I_GMIN) { transpose_mat(a.in[10], D, 4096, (bf16*)(ws + WS_GMIN), D, 0, r, scr, lane_); continue; } r -= I_GMIN;
        if (r < I_GMOUT) { transpose_mat(a.in[15], D, D, (bf16*)(ws + WS_GMOUT), D, 0, r, scr, lane_); continue; } r -= I_GMOUT;
        if (r < I_WO) { transpose_mat(a.in[22], D, D, (bf16*)(ws + WS_WO), D, 0, r, scr, lane_); continue; } r -= I_WO;
        if (r < I_DQ) { transpose_mat(a.in[16], D, QLORA, (bf16*)(ws + WS_WDQKV), D, 0, r, scr, lane_); continue; } r -= I_DQ;
        if (r < I_DKV) { transpose_mat(a.in[19], D, KVLORA + ROPE, (bf16*)(ws + WS_WDQKV), D, QLORA, r, scr, lane_); continue; } r -= I_DKV;
        if (r < I_UQ) { transpose_mat(a.in[18], QLORA, 3072, (bf16*)(ws + WS_WUQ), KQ, 0, r, scr, lane_); continue; } r -= I_UQ;
        transpose_mat(a.in[21], KVLORA, 4096, (bf16*)(ws + WS_WUKV), KKV, 0, r, scr, lane_);
    }
}
__device__ __forceinline__ void ph_modreduce(Frame& F, const Args& a) {
    const int tid_ = F.wave * 64 + mk_lane();
    const float* mp = (const float*)(a.ws + WS_MODP); float* mod = (float*)(a.ws + WS_MOD);
    for (int i = blockIdx.x * (NWAVES * 64) + tid_; i < 2 * 3 * NMODV; i += F.G * NWAVES * 64) {
        const int n = i % NMODV, l = i / (3 * NMODV);
        float s = a.in[5][l * NMODV + n];
#pragma unroll
        for (int ks = 0; ks < KSPLIT; ++ks) s += mp[(size_t)ks * 2 * 3 * NMODV + i];
        mod[i] = s;
    }
}
__device__ __forceinline__ void ph_norm(Frame& F, const float* srcL, const float* srcC  , int M, const float* g, const float* modl  , int k, bf16* XN) {
    const int gw = F.vcu * NWAVES + F.wave, NGW = F.G * NWAVES, lane_ = mk_lane();
    int cur = -1; pg8::f32x4 A[8], B[8];
    for (int r = gw; r < M; r += NGW) {
        const int cond = cond_of_row(r);
        if (cond != cur) {
            cur = cond;
            const float* sh = modl + (size_t)cond * NMODV + (3 * k) * D; const float* sc = sh + D;
#pragma unroll
            for (int j = 0; j < 8; ++j) { const int c = 4 * lane_ + 256 * j; const pg8::f32x4 gg = *(const pg8::f32x4*)(g + c), s1 = *(const pg8::f32x4*)(sc + c);
                A[j] = gg * (s1 + 1.0f); B[j] = *(const pg8::f32x4*)(sh + c); }
        }
        const float* xr = (r < M_LAT ? srcL : srcC) + (size_t)r * D + 4 * lane_;
        pg8::f32x4 v[8]; float ss = 0.f;
#pragma unroll
        for (int j = 0; j < 8; ++j) { v[j] = *(const GAS pg8::f32x4*)(xr + 256 * j); ss += (v[j].x * v[j].x + v[j].y * v[j].y) + (v[j].z * v[j].z + v[j].w * v[j].w); }
        const float rstd = __builtin_amdgcn_rsqf(wave_sum(ss) * (1.0f / D) + EPS);
        GAS u32x2* o = (GAS u32x2*)(XN + (size_t)r * D + 4 * lane_);
#pragma unroll
        for (int j = 0; j < 8; ++j) { const pg8::f32x4 y = v[j] * rstd * A[j] + B[j]; u32x2 w; w.x = pg8::cvt_pk_bf16(y.x, y.y); w.y = pg8::cvt_pk_bf16(y.z, y.w); o[64 * j] = w; }
    }
}
__device__ __forceinline__ void ph_final(Frame& F, float* X, const float* g) {
    const int gw = F.vcu * NWAVES + F.wave, NGW = F.G * NWAVES, lane_ = mk_lane();
    pg8::f32x4 A[8];
#pragma unroll
    for (int j = 0; j < 8; ++j) A[j] = *(const pg8::f32x4*)(g + 4 * lane_ + 256 * j);
    for (int r = gw; r < M_LAT; r += NGW) {
        float* xr = X + (size_t)r * D + 4 * lane_;
        pg8::f32x4 v[8]; float ss = 0.f;
#pragma unroll
        for (int j = 0; j < 8; ++j) { v[j] = *(const GAS pg8::f32x4*)(xr + 256 * j); ss += (v[j].x * v[j].x + v[j].y * v[j].y) + (v[j].z * v[j].z + v[j].w * v[j].w); }
        const float rstd = __builtin_amdgcn_rsqf(wave_sum(ss) * (1.0f / D) + EPS);
#pragma unroll
        for (int j = 0; j < 8; ++j) *(GAS pg8::f32x4*)(xr + 256 * j) = v[j] * rstd * A[j];
    }
}
__device__ __forceinline__ void ph_mla_norm(Frame& F, const float* Fm, const float* qn, const float* kvn, const float* rope, bf16* CQ, bf16* CKV, bf16* KPE) {
    const int gw = F.vcu * NWAVES + F.wave, NGW = F.G * NWAVES, lane = mk_lane();
    for (int r = gw; r < M_ALL; r += NGW) {
        const float* fr = Fm + (size_t)r * NDQKV;
        float x[8]; float ss = 0.f;
        if (lane < 56) {
            const pg8::f32x4 a = *(const GAS pg8::f32x4*)(fr + 8 * lane), b = *(const GAS pg8::f32x4*)(fr + 8 * lane + 4);
            x[0] = a.x; x[1] = a.y; x[2] = a.z; x[3] = a.w; x[4] = b.x; x[5] = b.y; x[6] = b.z; x[7] = b.w;
#pragma unroll
            for (int e = 0; e < 8; ++e) ss += x[e] * x[e];
        } else {
#pragma unroll
            for (int e = 0; e < 8; ++e) x[e] = 0.f;
        }
        const float rq = __builtin_amdgcn_rsqf(wave_sum(ss) * (1.0f / QLORA) + EPS);
        {
            float y[8];
#pragma unroll
            for (int e = 0; e < 8; ++e) y[e] = (lane < 56) ? x[e] * rq * qn[8 * lane + e] : 0.f;
            v4u w; w.x = pg8::cvt_pk_bf16(y[0], y[1]); w.y = pg8::cvt_pk_bf16(y[2], y[3]); w.z = pg8::cvt_pk_bf16(y[4], y[5]); w.w = pg8::cvt_pk_bf16(y[6], y[7]);
            *(GAS v4u*)(CQ + (size_t)r * KQ + 8 * lane) = w;
        }
        float z[8]; float s2 = 0.f;
        if (lane < 20) {
            const pg8::f32x4 a = *(const GAS pg8::f32x4*)(fr + QLORA + 8 * lane), b = *(const GAS pg8::f32x4*)(fr + QLORA + 8 * lane + 4);
            z[0] = a.x; z[1] = a.y; z[2] = a.z; z[3] = a.w; z[4] = b.x; z[5] = b.y; z[6] = b.z; z[7] = b.w;
#pragma unroll
            for (int e = 0; e < 8; ++e) s2 += z[e] * z[e];
        } else if (lane >= 32 && lane < 40) {
            const int j = lane - 32;
            const pg8::f32x4 a = *(const GAS pg8::f32x4*)(fr + QLORA + KVLORA + 8 * j), b = *(const GAS pg8::f32x4*)(fr + QLORA + KVLORA + 8 * j + 4);
            z[0] = a.x; z[1] = a.y; z[2] = a.z; z[3] = a.w; z[4] = b.x; z[5] = b.y; z[6] = b.z; z[7] = b.w;
        } else {
#pragma unroll
            for (int e = 0; e < 8; ++e) z[e] = 0.f;
        }
        const float rk = __builtin_amdgcn_rsqf(wave_sum(s2) * (1.0f / KVLORA) + EPS);
        float pz[8];
#pragma unroll
        for (int e = 0; e < 8; ++e) pz[e] = __shfl_xor(z[e], 2);
        if (lane < 32) {
            float y[8];
#pragma unroll
            for (int e = 0; e < 8; ++e) y[e] = (lane < 20) ? z[e] * rk * kvn[8 * lane + e] : 0.f;
            v4u w; w.x = pg8::cvt_pk_bf16(y[0], y[1]); w.y = pg8::cvt_pk_bf16(y[2], y[3]); w.z = pg8::cvt_pk_bf16(y[4], y[5]); w.w = pg8::cvt_pk_bf16(y[6], y[7]);
            *(GAS v4u*)(CKV + (size_t)r * KKV + 8 * lane) = w;
        } else if (lane < 40) {
            const int j = lane - 32;
            float y[8];
            if (r < M_LAT) {
                const int t = r & (SEQ - 1), pos = (j < 4) ? (t >> 6) : (t & 63);
                const float* cp = rope + pos * 16 + 8 * (j & 1); const float* sp = cp + 4096;
                const float sgn = (j & 2) ? 1.f : -1.f;
#pragma unroll
                for (int e = 0; e < 8; ++e) y[e] = z[e] * cp[e] + sgn * pz[e] * sp[e];
            } else {
#pragma unroll
                for (int e = 0; e < 8; ++e) y[e] = z[e];
            }
            v4u w; w.x = pg8::cvt_pk_bf16(y[0], y[1]); w.y = pg8::cvt_pk_bf16(y[2], y[3]); w.z = pg8::cvt_pk_bf16(y[4], y[5]); w.w = pg8::cvt_pk_bf16(y[6], y[7]);
            *(GAS v4u*)(KPE + (size_t)r * 64 + 8 * j) = w;
        }
    }
}

__device__ __forceinline__ s16x4 tr_read_dyn(int addr) { s16x4 r; asm volatile("ds_read_b64_tr_b16 %0, %1" : "=&v"(r) : "v"(addr) : "memory"); return r; }
__device__ __forceinline__ void ph_gm_mix(Frame& F, bf16* U, const bf16* V, const float* stats, const float* lng, const float* lnb, const float* w_s, const float* b_s) {
    constexpr int WS_STRIDE = 272, VN_STRIDE = 528, VN_OFF = 128 * WS_STRIDE;
    const int lane = mk_lane(), wave = F.wave, tid = wave * 64 + lane, wp = wave >> 2, wd = wave & 3;
    LAS unsigned char* lw = F.lds; LAS unsigned char* lv = F.lds + VN_OFF;
    const int NU = (M_ALL / 128) * 8;
    for (int un = F.vcu; un < NU; un += F.G) {
        const int c = un >> 3, g = un & 7, R0 = 128 * c, F0 = 256 * g;
        __syncthreads();
        { const float* w = w_s + (size_t)g * 128 * 128;
#pragma unroll
          for (int i = 0; i < 8; ++i) { const int id = tid + 512 * i, p = id >> 5, q4 = (id & 31) * 4; const pg8::f32x4 v = *(const GAS pg8::f32x4*)(w + p * 128 + q4);
              u32x2 o; o.x = pg8::cvt_pk_bf16(v.x, v.y); o.y = pg8::cvt_pk_bf16(v.z, v.w); *(LAS u32x2*)(lw + p * WS_STRIDE + q4 * 2) = o; } }
        { const int dg = tid & 31; const float* gp = lng + F0 + 8 * dg; const float* bp = lnb + F0 + 8 * dg;
          const pg8::f32x4 g0 = *(const pg8::f32x4*)gp, g1 = *(const pg8::f32x4*)(gp + 4), b0 = *(const pg8::f32x4*)bp, b1 = *(const pg8::f32x4*)(bp + 4);
#pragma unroll
          for (int i = 0; i < 8; ++i) { const int q = (tid >> 5) + 16 * i, row = R0 + q;
              const v4u raw = *(const GAS v4u*)(V + (size_t)row * D + F0 + 8 * dg);
              const float s = stats[2 * row], ss = stats[2 * row + 1];
              const float mean = s * (1.0f / D), var = ss * (1.0f / D) - mean * mean, rstd = __builtin_amdgcn_rsqf(var + EPS);
              float x[8];
              x[0] = __uint_as_float(raw.x << 16); x[1] = __uint_as_float(raw.x & 0xffff0000u); x[2] = __uint_as_float(raw.y << 16); x[3] = __uint_as_float(raw.y & 0xffff0000u);
              x[4] = __uint_as_float(raw.z << 16); x[5] = __uint_as_float(raw.z & 0xffff0000u); x[6] = __uint_as_float(raw.w << 16); x[7] = __uint_as_float(raw.w & 0xffff0000u);
              float y[8];
              y[0] = (x[0] - mean) * rstd * g0.x + b0.x; y[1] = (x[1] - mean) * rstd * g0.y + b0.y; y[2] = (x[2] - mean) * rstd * g0.z + b0.z; y[3] = (x[3] - mean) * rstd * g0.w + b0.w;
              y[4] = (x[4] - mean) * rstd * g1.x + b1.x; y[5] = (x[5] - mean) * rstd * g1.y + b1.y; y[6] = (x[6] - mean) * rstd * g1.z + b1.z; y[7] = (x[7] - mean) * rstd * g1.w + b1.w;
              v4u o; o.x = pg8::cvt_pk_bf16(y[0], y[1]); o.y = pg8::cvt_pk_bf16(y[2], y[3]); o.z = pg8::cvt_pk_bf16(y[4], y[5]); o.w = pg8::cvt_pk_bf16(y[6], y[7]);
              *(LAS v4u*)(lv + q * VN_STRIDE + dg * 16) = o; } }
        __syncthreads();
        pg8::f32x4 acc[4][4];
#pragma unroll
        for (int mi = 0; mi < 4; ++mi)
#pragma unroll
            for (int ni = 0; ni < 4; ++ni) acc[mi][ni] = (pg8::f32x4){0.f, 0.f, 0.f, 0.f};
        const int G4 = lane >> 4, i16 = lane & 15, ta = i16 >> 2, tb = i16 & 3;
        const int vbase = (int)(unsigned)(uintptr_t)lv + (8 * G4 + ta) * VN_STRIDE + (wd * 64 + 4 * tb) * 2;
#pragma unroll
        for (int ks = 0; ks < 4; ++ks) {
            pg8::bf16x8 Bw[4], Av[4];
#pragma unroll
            for (int mi = 0; mi < 4; ++mi) Bw[mi] = *(const LAS pg8::bf16x8*)(lw + (wp * 64 + 16 * mi + i16) * WS_STRIDE + (32 * ks + 8 * G4) * 2);
#pragma unroll
            for (int ni = 0; ni < 4; ++ni) { const int ad = vbase + 32 * ks * VN_STRIDE + ni * 32;
                const s16x4 lo = tr_read_dyn(ad), hi = tr_read_dyn(ad + 4 * VN_STRIDE);
                Av[ni] = (pg8::bf16x8){lo[0], lo[1], lo[2], lo[3], hi[0], hi[1], hi[2], hi[3]}; }
            asm volatile("s_waitcnt lgkmcnt(0)" ::: "memory"); __builtin_amdgcn_sched_barrier(0);
#pragma unroll
            for (int mi = 0; mi < 4; ++mi)
#pragma unroll
                for (int ni = 0; ni < 4; ++ni) acc[mi][ni] = __builtin_amdgcn_mfma_f32_16x16x32_bf16(Av[ni], Bw[mi], acc[mi][ni], 0, 0, 0);
        }
#pragma unroll
        for (int mi = 0; mi < 4; ++mi) {
            const int p = wp * 64 + 16 * mi + i16; const float bias = b_s[g * 128 + p];
#pragma unroll
            for (int ni = 0; ni < 4; ++ni) {
                GAS u32x2* up = (GAS u32x2*)(U + (size_t)(R0 + p) * D + F0 + wd * 64 + 16 * ni + 4 * G4);
                const u32x2 uu = *up;
                const float u0 = __uint_as_float(uu.x << 16), u1 = __uint_as_float(uu.x & 0xffff0000u), u2 = __uint_as_float(uu.y << 16), u3 = __uint_as_float(uu.y & 0xffff0000u);
                u32x2 o; o.x = pg8::cvt_pk_bf16(u0 * (acc[mi][ni][0] + bias), u1 * (acc[mi][ni][1] + bias)); o.y = pg8::cvt_pk_bf16(u2 * (acc[mi][ni][2] + bias), u3 * (acc[mi][ni][3] + bias));
                *up = o;
            }
        }
    }
    __syncthreads();
}

namespace att {
constexpr float SCALE = 0.07216878364870322f;
constexpr float THR = 8.f;
constexpr int NT = (SEQ + CTXL) / 64;
constexpr int NQR = ATT_NQR;
#define SBAR() __builtin_amdgcn_sched_barrier(0)
__device__ __forceinline__ int crow(int r, int hi) { return (r & 3) + 8 * (r >> 2) + 4 * hi; }
__device__ __forceinline__ unsigned cvtpk(float lo, float hi) { unsigned r; asm volatile("v_cvt_pk_bf16_f32 %0, %1, %2" : "=v"(r) : "v"(lo), "v"(hi)); return r; }
__device__ __forceinline__ void partialSM(f32x16& p0, f32x16& p1, float& m_reg, float& mn, float& alpha) {
  constexpr float C = SCALE * 1.4426950408889634f;
  float pmax = p0[0];
#pragma unroll
  for (int r = 1; r < 16; ++r) pmax = fmaxf(pmax, p0[r]);
#pragma unroll
  for (int r = 0; r < 16; ++r) pmax = fmaxf(pmax, p1[r]);
  { auto rr = __builtin_amdgcn_permlane32_swap(__float_as_uint(pmax), __float_as_uint(pmax), false, false);
    pmax = fmaxf(__uint_as_float(rr[0]), __uint_as_float(rr[1])); }
  if (__builtin_expect(__all(pmax - m_reg <= THR / SCALE), 1)) { mn = m_reg; alpha = 1.f; }
  else { mn = fmaxf(m_reg, pmax); alpha = __builtin_amdgcn_exp2f((m_reg - mn) * C); m_reg = mn; }
  float mnC = -mn * C;
#pragma unroll
  for (int r = 0; r < 16; ++r) p0[r] = fmaf(p0[r], C, mnC);
#pragma unroll
  for (int r = 0; r < 16; ++r) p1[r] = fmaf(p1[r], C, mnC);
#pragma unroll
  for (int r = 0; r < 16; ++r) p0[r] = __builtin_amdgcn_exp2f(p0[r]);
}
__device__ __forceinline__ void finishSM(f32x16& p0, f32x16& p1, float alpha, float& l_reg, bf16x8& pa0, bf16x8& pa1, bf16x8& pa2, bf16x8& pa3) {
#pragma unroll
  for (int r = 0; r < 16; ++r) p1[r] = __builtin_amdgcn_exp2f(p1[r]);
  float ps = 0;
#pragma unroll
  for (int r = 0; r < 16; ++r) ps += p0[r];
#pragma unroll
  for (int r = 0; r < 16; ++r) ps += p1[r];
  { auto rr = __builtin_amdgcn_permlane32_swap(__float_as_uint(ps), __float_as_uint(ps), false, false);
    ps = __uint_as_float(rr[0]) + __uint_as_float(rr[1]); }
  l_reg = l_reg * alpha + ps;
#define PK4(P, BASE, OUT) do { unsigned a0 = cvtpk(P[BASE + 0], P[BASE + 1]), a1 = cvtpk(P[BASE + 2], P[BASE + 3]);   \
    unsigned b0 = cvtpk(P[BASE + 4], P[BASE + 5]), b1 = cvtpk(P[BASE + 6], P[BASE + 7]);                              \
    auto r0 = __builtin_amdgcn_permlane32_swap(a0, b0, false, false); auto r1 = __builtin_amdgcn_permlane32_swap(a1, b1, false, false); \
    v4u w = {r0[0], r1[0], r0[1], r1[1]}; OUT = *reinterpret_cast<bf16x8*>(&w); } while (0)
  PK4(p0, 0, pa0); PK4(p0, 8, pa1); PK4(p1, 0, pa2); PK4(p1, 8, pa3);
#undef PK4
}
__device__ __forceinline__ void qkt(f32x16& p0, f32x16& p1, const LAS char* Ks  , const bf16x8 (&qr)[NQR], const LAS char* qpe) {
  p0 = f32x16{}; p1 = f32x16{};
#pragma unroll
  for (int d0 = 0; d0 < 12; ++d0) {
    bf16x8 b0 = *reinterpret_cast<const LAS bf16x8*>(Ks + d0 * 2048);
    bf16x8 b1 = *reinterpret_cast<const LAS bf16x8*>(Ks + d0 * 2048 + 1024);
    bf16x8 q;
    if (d0 < NQR) q = qr[d0]; else q = *reinterpret_cast<const LAS bf16x8*>(qpe + (d0 - NQR) * 1024);
    p0 = __builtin_amdgcn_mfma_f32_32x32x16_bf16(b0, q, p0, 0, 0, 0);
    p1 = __builtin_amdgcn_mfma_f32_32x32x16_bf16(b1, q, p1, 0, 0, 0); }
}
__device__ __forceinline__ int v_st(int k, int c) { const int kk = (k & ~0xC) | ((k & 4) << 1) | ((k & 8) >> 1); return ((kk >> 3) * 4 + (c >> 5)) * 512 + ((kk & 7) * 32 + (c & 31)) * 2; }
__device__ __forceinline__ int v_rd_base(int lane) { return ((lane & 3) << 3) | (((lane >> 2) & 3) << 6) | (((lane >> 4) & 1) << 5) | (((lane >> 5) & 1) << 8); }
constexpr int v_rd_off(int d0, int ks, int half) { return d0 * 512 + ks * 4096 + half * 2048; }
template <int OFF> __device__ __forceinline__ s16x4 tr_read(int vb) {
  s16x4 r; asm volatile("ds_read_b64_tr_b16 %0, %1 offset:%2" : "=&v"(r) : "v"(vb), "i"(OFF) : "memory"); return r;
}
template <int D0> __device__ __forceinline__ void pv_one(f32x16& od, int vb, bf16x8 pa0, bf16x8 pa1, bf16x8 pa2, bf16x8 pa3) {
  const s16x4 l0 = tr_read<v_rd_off(D0, 0, 0)>(vb), h0 = tr_read<v_rd_off(D0, 0, 1)>(vb), l1 = tr_read<v_rd_off(D0, 1, 0)>(vb), h1 = tr_read<v_rd_off(D0, 1, 1)>(vb);
  const s16x4 l2 = tr_read<v_rd_off(D0, 2, 0)>(vb), h2 = tr_read<v_rd_off(D0, 2, 1)>(vb), l3 = tr_read<v_rd_off(D0, 3, 0)>(vb), h3 = tr_read<v_rd_off(D0, 3, 1)>(vb);
  asm volatile("s_waitcnt lgkmcnt(0)" ::: "memory"); SBAR();
#define PK(L, H) (bf16x8){L[0], L[1], L[2], L[3], H[0], H[1], H[2], H[3]}
  od = __builtin_amdgcn_mfma_f32_32x32x16_bf16(pa0, PK(l0, h0), od, 0, 0, 0);
  od = __builtin_amdgcn_mfma_f32_32x32x16_bf16(pa1, PK(l1, h1), od, 0, 0, 0);
  od = __builtin_amdgcn_mfma_f32_32x32x16_bf16(pa2, PK(l2, h2), od, 0, 0, 0);
  od = __builtin_amdgcn_mfma_f32_32x32x16_bf16(pa3, PK(l3, h3), od, 0, 0, 0);
#undef PK
}
__device__ __forceinline__ void pv_d0(f32x16 (&o)[4], int vb, bf16x8 pa0, bf16x8 pa1, bf16x8 pa2, bf16x8 pa3) {
  pv_one<0>(o[0], vb, pa0, pa1, pa2, pa3); pv_one<1>(o[1], vb, pa0, pa1, pa2, pa3); pv_one<2>(o[2], vb, pa0, pa1, pa2, pa3); pv_one<3>(o[3], vb, pa0, pa1, pa2, pa3);
}
__device__ __forceinline__ int krow(int j, int b) { return j < 256 ? b * SEQ + 64 * j : M_LAT + b * CTXL + 64 * (j - 256); }

__device__ __forceinline__ void attn_unit(const bf16* __restrict__ Qb, const bf16* __restrict__ KNh, const bf16* __restrict__ KPE, const bf16* __restrict__ Vh, bf16* __restrict__ Ob, int b, LAS char* lds) {
  const int tid = threadIdx.x, wid = tid >> 6, lane = tid & 63, r32 = lane & 31, hi = lane >> 5;
  LAS char* V_lds = lds; LAS char* K_lds = lds + ATT_OFF_K;
  LAS float* wsf = (LAS float*)(lds + ATT_OFF_WS) + wid * 64; LAS float* li_l = wsf; LAS float* al_l = wsf + 32;
  LAS char* ost = lds + ATT_OFF_OST + wid * 8192;
  LAS char* qpe = lds + ATT_OFF_QPE + wid * ((12 - NQR) * 1024) + lane * 16;
  float m_reg = -1e30f, l_reg = 0; f32x16 o[4] = {}; bf16x8 qr[NQR];
  const bf16* Qw = Qb + (size_t)(wid * 32 + r32) * 3072 + hi * 8;
#pragma unroll
  for (int d0 = 0; d0 < NQR; ++d0) qr[d0] = *reinterpret_cast<const bf16x8*>(Qw + d0 * 16);
#pragma unroll
  for (int d0 = NQR; d0 < 12; ++d0) *reinterpret_cast<LAS bf16x8*>(qpe + (d0 - NQR) * 1024) = *reinterpret_cast<const bf16x8*>(Qw + d0 * 16);
  const int sr = tid >> 4, sc = (tid & 15) * 8, vst0 = v_st(sr, sc), vst1 = v_st(32 + sr, sc);
  const int khalf = lane & 1, krl = (lane >> 1) & 3, kc8 = (lane >> 3) & 7, kswz = wid & 1;
  const int krow0 = 8 * wid + krl, krow1 = krow0 + 4, kcol = kc8 * 16 + khalf * 8;
  const int kst0 = kc8 * 2048 + krow0 * 32 + ((khalf ^ kswz) * 16), kst1 = kst0 + 128;
  const int prow = 8 * wid + 4 * (lane >> 5) + krl, pcol = ((lane >> 3) & 3) * 16 + khalf * 8, kst2 = (8 + ((lane >> 3) & 3)) * 2048 + prow * 32 + ((khalf ^ kswz) * 16);
  const LAS char* krd = K_lds + r32 * 32 + ((hi ^ ((r32 >> 3) & 1)) * 16);
  const int vb0 = (int)(unsigned)(uintptr_t)V_lds + v_rd_base(lane);
  bf16x8 vs0, vs1, ks0, ks1, kp;
#define SLOAD(j) do { const int rb_ = krow((j), b); \
    vs0 = *reinterpret_cast<const bf16x8*>(&Vh[(size_t)(rb_ + sr) * D + sc]); vs1 = *reinterpret_cast<const bf16x8*>(&Vh[(size_t)(rb_ + 32 + sr) * D + sc]); \
    ks0 = *reinterpret_cast<const bf16x8*>(&KNh[(size_t)(rb_ + krow0) * D + kcol]); ks1 = *reinterpret_cast<const bf16x8*>(&KNh[(size_t)(rb_ + krow1) * D + kcol]); \
    kp = *reinterpret_cast<const bf16x8*>(&KPE[(size_t)(rb_ + prow) * 64 + pcol]); } while (0)
#define SWRITE(bb) do { *(LAS bf16x8*)(V_lds + (bb) * ATT_SHM_V + vst0) = vs0; *(LAS bf16x8*)(V_lds + (bb) * ATT_SHM_V + vst1) = vs1; \
    *(LAS bf16x8*)(K_lds + (bb) * ATT_SHM_K + kst0) = ks0; *(LAS bf16x8*)(K_lds + (bb) * ATT_SHM_K + kst1) = ks1; *(LAS bf16x8*)(K_lds + (bb) * ATT_SHM_K + kst2) = kp; } while (0)
#define SWAIT() asm volatile("s_waitcnt vmcnt(0)" ::: "memory")
#define RESC(a) do { if (__any((a) < 1.f)) { if (hi == 0) al_l[r32] = (a); asm volatile("s_waitcnt lgkmcnt(0)" ::: "memory"); \
    _Pragma("unroll") for (int d = 0; d < 4; ++d) _Pragma("unroll") for (int r = 0; r < 16; ++r) o[d][r] *= al_l[crow(r, hi)]; } } while (0)
  f32x16 pA0, pA1, pB0, pB1; float mnA, mnB, alA, alB; bf16x8 pa0, pa1, pa2, pa3;
  SLOAD(0); SWAIT(); SWRITE(0); __syncthreads();
  qkt(pA0, pA1, krd, qr, qpe); partialSM(pA0, pA1, m_reg, mnA, alA);
  SLOAD(1);
  SWAIT(); SWRITE(1); __syncthreads();
  for (int j = 1; j + 1 < NT; j += 2) {
    SBAR(); qkt(pB0, pB1, krd + ATT_SHM_K, qr, qpe);
    finishSM(pA0, pA1, alA, l_reg, pa0, pa1, pa2, pa3); SBAR();
    SLOAD(j + 1); SBAR();
    pv_d0(o, vb0, pa0, pa1, pa2, pa3); partialSM(pB0, pB1, m_reg, mnB, alB);
    __syncthreads(); SWAIT(); SWRITE(0);
    RESC(alB); __syncthreads();
    SBAR(); qkt(pA0, pA1, krd, qr, qpe);
    finishSM(pB0, pB1, alB, l_reg, pa0, pa1, pa2, pa3); SBAR();
    SLOAD(j + 2); SBAR();
    pv_d0(o, vb0 + ATT_SHM_V, pa0, pa1, pa2, pa3); partialSM(pA0, pA1, m_reg, mnA, alA);
    __syncthreads(); SWAIT(); SWRITE(1);
    RESC(alA); __syncthreads();
  }
  SBAR(); qkt(pB0, pB1, krd + ATT_SHM_K, qr, qpe);
  finishSM(pA0, pA1, alA, l_reg, pa0, pa1, pa2, pa3); SBAR();
  pv_d0(o, vb0, pa0, pa1, pa2, pa3); partialSM(pB0, pB1, m_reg, mnB, alB);
  __syncthreads(); RESC(alB);
  finishSM(pB0, pB1, alB, l_reg, pa0, pa1, pa2, pa3); SBAR();
  pv_d0(o, vb0 + ATT_SHM_V, pa0, pa1, pa2, pa3);
  __syncthreads();
  if (hi == 0) li_l[r32] = l_reg; asm volatile("s_waitcnt lgkmcnt(0)" ::: "memory");
#pragma unroll
  for (int r = 0; r < 16; ++r) { const int orow = crow(r, hi); const float rl = __builtin_amdgcn_rcpf(li_l[orow]);
#pragma unroll
    for (int d0 = 0; d0 < 4; ++d0) *(LAS unsigned short*)(ost + orow * 256 + (d0 * 32 + r32) * 2) = (unsigned short)f2bf(o[d0][r] * rl); }
  asm volatile("s_waitcnt lgkmcnt(0)" ::: "memory");
#pragma unroll
  for (int i = 0; i < 8; ++i) { const int gidx = i * 64 + lane, row = gidx >> 4, cg = gidx & 15;
    const v4u v = *(const LAS v4u*)(ost + row * 256 + cg * 16);
    *(GAS v4u*)(Ob + (size_t)(wid * 32 + row) * D + cg * 8) = v; }
  __syncthreads();
#undef SLOAD
#undef SWRITE
#undef SWAIT
#undef RESC
}
#undef SBAR
}

#ifndef MK_SPLIT
#define MK_SPLIT 0
#endif
#if MK_SPLIT
#define GRID_BAR() do { } while (0)
#else
#define GRID_BAR() xcd_barrier(bar)
#endif
#define IN(k) (lo <= (k) && (k) < hi)
#define SEAM(k) do { if (IN(k) && IN((k) + 1)) GRID_BAR(); } while (0)
template <int l> __device__ __forceinline__ void layer_body(Frame& F, const Args& args, const int lo, const int hi, const XcdBarrier& bar) {
    unsigned char* ws = args.ws;
    float* X = args.out;
    float* Yc = (float*)(ws + WS_Y) - (size_t)M_LAT * D;
    const float* XinC = args.in[2] - (size_t)M_LAT * D;
    bf16* XN = (bf16*)(ws + WS_XN);
    bf16* Hb = (bf16*)(ws + WS_BIG);
    const float* MOD = (const float*)(ws + WS_MOD);
    const float* ROPEt = (const float*)(ws + WS_ROPE);
    (void)XinC; (void)ROPEt;
        const int pb = l == 0 ? 2 : 12;
        const float* modl = MOD + (size_t)l * 3 * NMODV;
        const float* ng = args.in[6] + (size_t)l * 3 * D;
        if (IN(pb + 0)) { ph_norm(F, l == 0 ? args.in[0] : X, l == 0 ? XinC : Yc, M_ALL, ng, modl, 0, XN); } SEAM(pb + 0);
        if (IN(pb + 1)) {
            pg8::Gemm g{XN, (const bf16*)(ws + WS_WGU + (size_t)(l * 2) * SZ_WGU), M_ALL, NGU, D}; pg8::StaticOrder S; S.init(M_ALL, NGU, F.G, (int)blockIdx.x);
            EpiSwiGLU E{Hb};
            pg8::gemm_phase<EpiSwiGLU, pg8::StaticOrder, true, true>(F.lds + RING_OFF, g, S, E);
        } SEAM(pb + 1);
        if (IN(pb + 2)) {
            pg8::Gemm g{Hb, (const bf16*)(ws + WS_WD + (size_t)(l * 2) * SZ_WD), M_ALL, D, FF}; pg8::StaticOrder S; S.init(M_ALL, D, F.G, (int)blockIdx.x);
            EpiResid E{l == 0 ? args.in[0] : X, l == 0 ? XinC : Yc, X, Yc, modl + 2 * D, 0.5f};
            pg8::gemm_phase<EpiResid, pg8::StaticOrder, true, true>(F.lds + RING_OFF, g, S, E);
        } SEAM(pb + 2);
        if (IN(pb + 3)) { ph_norm(F, X, Yc, M_ALL, ng + D, modl, 1, XN); } SEAM(pb + 3);
        int pn2;
        if constexpr (l == 0) {
            bf16* Ub = (bf16*)(ws + WS_U); bf16* Vb = (bf16*)(ws + WS_V); float* stats = (float*)(ws + WS_STATS);
            if (IN(6)) {
                pg8::Gemm g{XN, (const bf16*)(ws + WS_GMIN), M_ALL, 4096, D}; pg8::StaticOrder S; S.init(M_ALL, 4096, F.G, (int)blockIdx.x);
                EpiGeluUV E{Ub, Vb, stats};
                pg8::gemm_phase<EpiGeluUV, pg8::StaticOrder, true, true>(F.lds + RING_OFF, g, S, E);
            } SEAM(6);
            if (IN(7)) { ph_gm_mix(F, Ub, Vb, stats, args.in[11], args.in[12], args.in[13], args.in[14]); } SEAM(7);
            if (IN(8)) {
                pg8::Gemm g{Ub, (const bf16*)(ws + WS_GMOUT), M_ALL, D, D}; pg8::StaticOrder S; S.init(M_ALL, D, F.G, (int)blockIdx.x);
                EpiResid E{X, Yc, X, Yc, modl + 5 * D, 1.0f};
                pg8::gemm_phase<EpiResid, pg8::StaticOrder, true, true>(F.lds + RING_OFF, g, S, E);
            } SEAM(8);
            pn2 = 9;
        } else {
            float* Fm = (float*)(ws + WS_F); bf16* CQ = (bf16*)(ws + WS_CQ); bf16* CKV = (bf16*)(ws + WS_CKV); bf16* KPE = (bf16*)(ws + WS_KPE);
            bf16* Qb = (bf16*)(ws + WS_Q); bf16* KN = (bf16*)(ws + WS_KN); bf16* VV = (bf16*)(ws + WS_VV); bf16* Ob = XN;
            if (IN(16)) {
                pg8::Gemm g{XN, (const bf16*)(ws + WS_WDQKV), M_ALL, NDQKV, D}; pg8::StaticOrder S; S.init(M_ALL, NDQKV, F.G, (int)blockIdx.x);
                EpiF32 E{Fm, NDQKV};
                pg8::gemm_phase<EpiF32, pg8::StaticOrder, true, true>(F.lds + RING_OFF, g, S, E);
            } SEAM(16);
            if (IN(17)) { ph_mla_norm(F, Fm, args.in[17], args.in[20], ROPEt, CQ, CKV, KPE); } SEAM(17);
            if (IN(18)) {
                {   pg8::Gemm g{CQ, (const bf16*)(ws + WS_WUQ), M_LAT, 3072, KQ}; pg8::StaticOrder S; S.init(M_LAT, 3072, F.G, (int)blockIdx.x);
                    EpiQRope E{Qb, ROPEt};
                    pg8::gemm_phase<EpiQRope, pg8::StaticOrder, true, true>(F.lds + RING_OFF, g, S, E); }
                __syncthreads();
                {   pg8::Gemm g{CKV, (const bf16*)(ws + WS_WUKV), M_ALL, 4096, KKV}; pg8::StaticOrder S; S.init(M_ALL, 4096, F.G, (int)blockIdx.x);
                    EpiKV E{KN, VV};
                    pg8::gemm_phase<EpiKV, pg8::StaticOrder, true, true>(F.lds + RING_OFF, g, S, E); }
            } SEAM(18);
            if (IN(19)) {
                __syncthreads();
                for (int L = F.vcu; L < NB * NHEAD * (SEQ / 256); L += F.G) {
                    const int qb = L & 63, bh = L >> 6, b = bh >> 4, h = bh & 15;
                    att::attn_unit(Qb + (size_t)(b * SEQ + qb * 256) * 3072 + h * DQK, KN + h * DVH, KPE, VV + h * DVH, Ob + (size_t)(b * SEQ + qb * 256) * D + h * DVH, b, (LAS char*)F.lds);
                }
                __syncthreads();
            } SEAM(19);
            if (IN(20)) {
                pg8::Gemm g{Ob, (const bf16*)(ws + WS_WO), M_LAT, D, D}; pg8::StaticOrder S; S.init(M_LAT, D, F.G, (int)blockIdx.x);
                EpiResid E{X, Yc, X, Yc, modl + 5 * D, 1.0f};
                pg8::gemm_phase<EpiResid, pg8::StaticOrder, true, true>(F.lds + RING_OFF, g, S, E);
            } SEAM(20);
            pn2 = 21;
        }
        const int M2 = l == 0 ? M_ALL : M_LAT;
        if (IN(pn2)) { ph_norm(F, X, Yc, M2, ng + 2 * D, modl, 2, XN); } SEAM(pn2);
        if (IN(pn2 + 1)) {
            pg8::Gemm g{XN, (const bf16*)(ws + WS_WGU + (size_t)(l * 2 + 1) * SZ_WGU), M2, NGU, D}; pg8::StaticOrder S; S.init(M2, NGU, F.G, (int)blockIdx.x);
            EpiSwiGLU E{Hb};
            pg8::gemm_phase<EpiSwiGLU, pg8::StaticOrder, true, true>(F.lds + RING_OFF, g, S, E);
        } SEAM(pn2 + 1);
        if (IN(pn2 + 2)) {
            pg8::Gemm g{Hb, (const bf16*)(ws + WS_WD + (size_t)(l * 2 + 1) * SZ_WD), M2, D, FF}; pg8::StaticOrder S; S.init(M2, D, F.G, (int)blockIdx.x);
            EpiResid E{X, Yc, X, Yc, modl + 8 * D, 0.5f};
            pg8::gemm_phase<EpiResid, pg8::StaticOrder, true, true>(F.lds + RING_OFF, g, S, E);
        } SEAM(pn2 + 2);
    }

__global__ void __launch_bounds__(NWAVES * 64, 2) mk_fwd(Args args) {
    extern __shared__ __attribute__((aligned(16))) unsigned char lds[];
    Frame F;
    F.lds = (LAS unsigned char*)lds;
    F.wave = __builtin_amdgcn_readfirstlane((int)threadIdx.x >> 6);
    F.G = gridDim.x; { const int bx = blockIdx.x; F.vcu = (F.G % 8 == 0) ? (bx % 8) * (F.G / 8) + bx / 8 : bx; }
    unsigned char* ws = args.ws;
    F.ctl = (gu32*)(ws + WS_CTL);
    volatile LAS unsigned* MISC = (volatile LAS unsigned*)(F.lds + MISC_OFF);
    for (int u = threadIdx.x; u < (LDS_BYTES - MISC_OFF) / 4; u += NWAVES * 64) ((LAS unsigned*)(F.lds + MISC_OFF))[u] = 0u;
    __syncthreads();
#if MK_SPLIT
    XcdBarrier bar; bar.bar = (unsigned*)(F.ctl + CW_BAR); bar.x = 0; bar.st = nullptr;
#else
    XcdBarrier bar = xcd_barrier_post((unsigned*)(F.ctl + CW_BAR), MISC + 8);
#endif
    const int lo = args.ph_lo, hi = args.ph_hi;

    float* X = args.out;
    float* Yc = (float*)(ws + WS_Y) - (size_t)M_LAT * D;
    const float* XinC = args.in[2] - (size_t)M_LAT * D;
    bf16* XN = (bf16*)(ws + WS_XN);
    bf16* Hb = (bf16*)(ws + WS_BIG);
    const float* MOD = (const float*)(ws + WS_MOD);
    const float* ROPEt = (const float*)(ws + WS_ROPE);

    if (IN(0)) { ph_prologue(F, args); } SEAM(0);
    if (IN(1)) { ph_modreduce(F, args); } SEAM(1);

    layer_body<0>(F, args, lo, hi, bar);
    layer_body<1>(F, args, lo, hi, bar);
    if (IN(24)) { ph_final(F, X, args.in[23]); }
#undef IN
#undef SEAM
#undef GRID_BAR
}

extern "C" void kernel_launch(void* const* d_in, const int* in_sizes, int n_in, void* d_out, int out_size, void* d_ws, size_t ws_size, hipStream_t stream) {
    static int grid = 0;
    if (grid == 0) {
        if (n_in != 24 || in_sizes[0] != M_LAT * D || out_size != M_LAT * D || ws_size < WS_END) {
            fprintf(stderr, "kernel_launch: shape mismatch: n_in %d in0 %d out %d ws %zu (need %zu)\n", n_in, n_in > 0 ? in_sizes[0] : -1, out_size, ws_size, (size_t)WS_END); grid = -1; return; }
        int dev = 0, cus = 0, per_cu = 0;
        if (hipGetDevice(&dev) != hipSuccess || hipDeviceGetAttribute(&cus, hipDeviceAttributeMultiprocessorCount, dev) != hipSuccess) { grid = -1; return; }
        if (hipFuncSetAttribute((const void*)mk_fwd, hipFuncAttributeMaxDynamicSharedMemorySize, LDS_BYTES) != hipSuccess) { fprintf(stderr, "kernel_launch: hipFuncSetAttribute failed\n"); grid = -1; return; }
        if (hipOccupancyMaxActiveBlocksPerMultiprocessor(&per_cu, (const void*)mk_fwd, NWAVES * 64, LDS_BYTES) != hipSuccess || per_cu < 1)
            fprintf(stderr, "kernel_launch: note: occupancy query reports %d workgroups per CU\n", per_cu);
        (void)hipGetLastError();
        grid = cus;
    }
    if (grid < 0) return;
    if (hipMemsetAsync((char*)d_ws + WS_CTL, 0, CTL_ZERO_BYTES, stream) != hipSuccess) { fprintf(stderr, "kernel_launch: memset failed\n"); return; }
    Args a{};
    for (int i = 0; i < 24; ++i) a.in[i] = (const float*)d_in[i];
    a.out = (float*)d_out; a.ws = (unsigned char*)d_ws;
#if MK_SPLIT
    for (int p = 0; p < N_PHASES; ++p) { a.ph_lo = p; a.ph_hi = p + 1;
        hipLaunchKernelGGL(mk_fwd, dim3(grid), dim3(NWAVES * 64), LDS_BYTES, stream, a); }
#else
    a.ph_lo = 0; a.ph_hi = N_PHASES;
    hipLaunchKernelGGL(mk_fwd, dim3(grid), dim3(NWAVES * 64), LDS_BYTES, stream, a);
#endif
    const hipError_t le = hipPeekAtLastError();
    if (le != hipSuccess) fprintf(stderr, "kernel_launch: launch failed: %s\n", hipGetErrorName(le));
}
```

```cpp
#include <hip/hip_runtime.h>
#include <cstdio>
#include <cstdint>

namespace pg8 {
#define PG8_LAS __attribute__((address_space(3)))
typedef unsigned short bf16_t;
typedef short bf16x8 __attribute__((ext_vector_type(8)));
typedef float f32x4 __attribute__((ext_vector_type(4)));
typedef unsigned u32x4 __attribute__((ext_vector_type(4)));
constexpr int BM = 256, BK = 64, HALF = 128, HTB = HALF * BK * 2  , STAGE_BYTES = 8 * HTB, NXCD = 8, WGM = 8;

__host__ __device__ __forceinline__ int lds_byte(int r, int c) { const int st = (r >> 4) * 2 + (c >> 5), rr = r & 15, cc = c & 31, ob = rr * 64 + cc * 2; return st * 1024 + (ob ^ (((ob >> 9) & 1) << 5)); }
__host__ __device__ __forceinline__ void stage_rc(int b, int& R, int& C) { const int st = b / 1024, sb = b % 1024, swz = sb ^ (((sb >> 9) & 1) << 5); R = (st >> 1) * 16 + swz / 64; C = (st & 1) * 32 + (swz % 64) / 2; }
__host__ __device__ __forceinline__ int perm32(int rho) { const int n = rho >> 4, i = rho & 15; return 8 * (i >> 2) + 4 * n + (i & 3); }

struct Unit { int pm, pn, kofs; };
struct Gemm { const bf16_t* A; const bf16_t* Bt; int M, N, K, ld; };

struct StaticOrder {
    int nM, nN, nwg, G, c, wgm;
    __host__ __device__ void init(int M, int N, int G_, int c_, int wgm_ = WGM) { nM = M / BM; nN = N / BM; nwg = nM * nN; G = G_; c = c_; wgm = wgm_; }
    __host__ __device__ bool next(int i, Unit& u) const {
        const long L = (long)i * G + c; if (L >= nwg) return false;
        int wgid = (int)L; { const int q = nwg / NXCD, r = nwg % NXCD, xcd = wgid % NXCD, off = wgid / NXCD; wgid = (xcd < r ? xcd * (q + 1) : r * (q + 1) + (xcd - r) * q) + off; }
        const int nig = wgm * nN, gid = wgid / nig, fm = gid * wgm, gsz = (nM - fm) < wgm ? (nM - fm) : wgm;
        u.pm = fm + ((wgid % nig) % gsz); u.pn = (wgid % nig) / gsz; u.kofs = 0; return true;
    }
    __device__ __forceinline__ void a_ready(const Unit&) const {}
    __device__ __forceinline__ void done(const Unit&) const {}
};

__device__ __forceinline__ unsigned cvt_pk_bf16(float lo, float hi) { unsigned r; asm volatile("v_cvt_pk_bf16_f32 %0, %1, %2" : "=v"(r) : "v"(lo), "v"(hi)); return r; }
typedef float f32x2 __attribute__((ext_vector_type(2)));
template <class Epi, class Sched, bool ALIGN_EPI = false, bool SP2 = false>
__device__ __forceinline__ void gemm_phase(PG8_LAS unsigned char* lds, const Gemm g, const Sched& S, const Epi& E) {
    int tid_l = threadIdx.x; asm volatile("" : "+v"(tid_l));
    const int tid = tid_l, wid = __builtin_amdgcn_readfirstlane(tid >> 6), lane = tid & 63, wr = wid >> 2, wc = wid & 3, fr = lane & 15, fq = lane >> 4;
    const int K = g.K, nt = K / BK, LD = g.ld;
    unsigned voffA[2], voffB[2];
#pragma unroll
    for (int i = 0; i < 2; ++i) { int R, C; stage_rc(tid * 16 + i * 8192, R, C); const int Rb = Epi::PERM ? ((R & ~31) + perm32(R & 31)) : R;
        voffA[i] = (unsigned)(R * LD + C) * 2u; voffB[i] = (unsigned)(Rb * LD + C) * 2u; }
    const size_t kstep = (size_t)(BK * 2);
    const size_t hstep = (size_t)HALF * LD * 2;
    const size_t tstep = 2 * hstep;
    const unsigned ldsw = (unsigned)wid * 1024u;
    const int aoff = lds_byte(wr * 64 + fr, fq * 8), boff = lds_byte(wc * 32 + fr, fq * 8);
#define PG8_SA(b, h) (((b) * 2 + (h)) * HTB)
#define PG8_SB(b, h) ((4 + (b) * 2 + (h)) * HTB)
#define PG8_STAGE(bufoff, gbase, voff) do { _Pragma("unroll") for (int _i = 0; _i < 2; ++_i) \
        __builtin_amdgcn_global_load_lds((const unsigned*)((const char*)(gbase) + (voff)[_i]), (PG8_LAS unsigned*)(lds + (bufoff) + ldsw + _i * 8192), 16, 0, 0); } while (0)
#define PG8_LDA(dst, b, h) do { _Pragma("unroll") for (int m = 0; m < 4; ++m) _Pragma("unroll") for (int k = 0; k < 2; ++k) dst[m][k] = *(const PG8_LAS bf16x8*)(lds + PG8_SA(b, h) + aoff + m * 2048 + k * 1024); } while (0)
#define PG8_LDB(dst, b, h) do { _Pragma("unroll") for (int n = 0; n < 2; ++n) _Pragma("unroll") for (int k = 0; k < 2; ++k) dst[n][k] = *(const PG8_LAS bf16x8*)(lds + PG8_SB(b, h) + boff + n * 2048 + k * 1024); } while (0)
#define PG8_MMA(ai, bj, At, Bt) do { __builtin_amdgcn_s_setprio(1); _Pragma("unroll") for (int m = 0; m < 4; ++m) _Pragma("unroll") for (int n = 0; n < 2; ++n) _Pragma("unroll") for (int k = 0; k < 2; ++k) \
        acc[ai][bj][m][n] = __builtin_amdgcn_mfma_f32_16x16x32_bf16(Bt[n][k], At[m][k], acc[ai][bj][m][n], 0, 0, 0); __builtin_amdgcn_s_setprio(0); } while (0)
#define PG8_WAIT_V(n) asm volatile("s_waitcnt vmcnt(" #n ")" ::: "memory")
#define PG8_WAIT_L(n) asm volatile("s_waitcnt lgkmcnt(" #n ")" ::: "memory")
#define PG8_BAR __builtin_amdgcn_s_barrier()
#define PG8_SCHED __builtin_amdgcn_sched_barrier(0)
    Unit cur, nxt; int ui = 0;
    if (!S.next(0, cur)) return;
    f32x4 acc[2][2][4][2];
#pragma unroll
    for (int a = 0; a < 2; ++a)
#pragma unroll
        for (int b = 0; b < 2; ++b)
#pragma unroll
            for (int m = 0; m < 4; ++m)
#pragma unroll
                for (int n = 0; n < 2; ++n) acc[a][b][m][n] = (f32x4){0.f, 0.f, 0.f, 0.f};
    bf16x8 At[4][2], B0[2][2], B1[2][2];
    const char* cA = (const char*)g.A + (size_t)cur.pm * tstep + cur.kofs; const char* cB = (const char*)g.Bt + (size_t)cur.pn * tstep + cur.kofs;
    S.a_ready(cur);
    if constexpr (SP2) {
        PG8_STAGE(PG8_SB(0, 0), cB, voffB); PG8_STAGE(PG8_SB(0, 1), cB + hstep, voffB); PG8_STAGE(PG8_SA(0, 0), cA, voffA); PG8_STAGE(PG8_SA(0, 1), cA + hstep, voffA);
        if (wr == 1) PG8_BAR;
        PG8_WAIT_V(2); PG8_BAR;
        PG8_STAGE(PG8_SB(1, 0), cB + kstep, voffB); PG8_STAGE(PG8_SA(1, 0), cA + kstep, voffA); PG8_STAGE(PG8_SB(1, 1), cB + hstep + kstep, voffB);
        PG8_WAIT_V(6); PG8_BAR;
    } else {
        PG8_STAGE(PG8_SB(0, 0), cB, voffB); PG8_STAGE(PG8_SA(0, 0), cA, voffA); PG8_STAGE(PG8_SB(0, 1), cB + hstep, voffB); PG8_STAGE(PG8_SA(0, 1), cA + hstep, voffA);
        if (wr == 1) PG8_BAR;
        PG8_WAIT_V(4); PG8_BAR;
        PG8_STAGE(PG8_SB(1, 0), cB + kstep, voffB); PG8_STAGE(PG8_SA(1, 0), cA + kstep, voffA); PG8_STAGE(PG8_SB(1, 1), cB + hstep + kstep, voffB);
        PG8_WAIT_V(6); PG8_BAR;
    }
    for (;;) {
        const bool has_next = S.next(ui + 1, nxt);
        const char* nA = has_next ? (const char*)g.A + (size_t)nxt.pm * tstep + nxt.kofs : cA; const char* nB = has_next ? (const char*)g.Bt + (size_t)nxt.pn * tstep + nxt.kofs : cB;
        for (int t = 0; t < nt; t += 2) {
            const bool last = (t == nt - 2);
            const char* a1 = cA + (size_t)(t + 1) * kstep;
            const char* a2 = last ? nA : cA + (size_t)(t + 2) * kstep; const char* b2 = last ? nB : cB + (size_t)(t + 2) * kstep;
            const char* a3 = a2 + kstep; const char* b3 = b2 + kstep;
            if (last && has_next) S.a_ready(nxt);
            if constexpr (SP2) {
            PG8_LDB(B0, 0, 0); PG8_LDB(B1, 0, 1); PG8_SCHED; PG8_LDA(At, 0, 0); PG8_STAGE(PG8_SA(1, 1), a1 + hstep, voffA);
            PG8_WAIT_V(8); PG8_WAIT_L(0); PG8_BAR; PG8_MMA(0, 0, At, B0); PG8_MMA(0, 1, At, B1); PG8_BAR; PG8_SCHED;
            PG8_LDA(At, 0, 1); PG8_STAGE(PG8_SB(0, 0), b2, voffB); PG8_STAGE(PG8_SB(0, 1), b2 + hstep, voffB); PG8_STAGE(PG8_SA(0, 0), a2, voffA);
            PG8_WAIT_V(8); PG8_WAIT_L(0); PG8_BAR; PG8_MMA(1, 0, At, B0); PG8_MMA(1, 1, At, B1); PG8_BAR; PG8_SCHED;
            PG8_LDB(B0, 1, 0); PG8_LDB(B1, 1, 1); PG8_SCHED; PG8_LDA(At, 1, 0); PG8_STAGE(PG8_SA(0, 1), a2 + hstep, voffA);
            PG8_WAIT_V(8); PG8_WAIT_L(0); PG8_BAR; PG8_MMA(0, 0, At, B0); PG8_MMA(0, 1, At, B1); PG8_BAR; PG8_SCHED;
            PG8_LDA(At, 1, 1); PG8_STAGE(PG8_SB(1, 0), b3, voffB); PG8_STAGE(PG8_SB(1, 1), b3 + hstep, voffB); PG8_STAGE(PG8_SA(1, 0), a3, voffA);
            PG8_WAIT_V(8); PG8_WAIT_L(0); PG8_BAR; PG8_MMA(1, 0, At, B0); PG8_MMA(1, 1, At, B1); PG8_BAR; PG8_SCHED;
            } else {
            PG8_LDB(B0, 0, 0); PG8_SCHED; PG8_LDA(At, 0, 0); PG8_STAGE(PG8_SA(1, 1), a1 + hstep, voffA);
            PG8_WAIT_L(8); PG8_BAR; PG8_WAIT_L(0); PG8_MMA(0, 0, At, B0); PG8_BAR; PG8_SCHED;
            PG8_LDB(B1, 0, 1); PG8_STAGE(PG8_SB(0, 0), b2, voffB);
            PG8_BAR; PG8_WAIT_L(0); PG8_MMA(0, 1, At, B1); PG8_BAR;
            PG8_LDA(At, 0, 1); PG8_STAGE(PG8_SA(0, 0), a2, voffA);
            PG8_BAR; PG8_WAIT_L(0); PG8_MMA(1, 0, At, B0); PG8_BAR; PG8_SCHED;
            PG8_STAGE(PG8_SB(0, 1), b2 + hstep, voffB);
            PG8_WAIT_V(6); PG8_BAR; PG8_MMA(1, 1, At, B1); PG8_BAR;
            PG8_LDB(B0, 1, 0); PG8_SCHED; PG8_LDA(At, 1, 0); PG8_STAGE(PG8_SA(0, 1), a2 + hstep, voffA);
            PG8_WAIT_L(8); PG8_BAR; PG8_WAIT_L(0); PG8_MMA(0, 0, At, B0); PG8_BAR; PG8_SCHED;
            PG8_LDB(B1, 1, 1); PG8_STAGE(PG8_SB(1, 0), b3, voffB);
            PG8_BAR; PG8_WAIT_L(0); PG8_MMA(0, 1, At, B1); PG8_BAR;
            PG8_LDA(At, 1, 1); PG8_STAGE(PG8_SA(1, 0), a3, voffA);
            PG8_BAR; PG8_WAIT_L(0); PG8_MMA(1, 0, At, B0); PG8_BAR; PG8_SCHED;
            PG8_STAGE(PG8_SB(1, 1), b3 + hstep, voffB);
            PG8_WAIT_V(6); PG8_BAR; PG8_MMA(1, 1, At, B1); PG8_BAR;
            }
        }
        if constexpr (ALIGN_EPI) { if (wr == 0) PG8_BAR; }
        if constexpr (!Epi::AFTER_DRAIN) { E(acc, cur, wr, wc, fr, fq); S.done(cur); }
        if (!has_next) break;
#pragma unroll
        for (int a = 0; a < 2; ++a)
#pragma unroll
            for (int b = 0; b < 2; ++b)
#pragma unroll
                for (int m = 0; m < 4; ++m)
#pragma unroll
                    for (int n = 0; n < 2; ++n) acc[a][b][m][n] = (f32x4){0.f, 0.f, 0.f, 0.f};
        cur = nxt; cA = nA; cB = nB; ++ui;
        if constexpr (ALIGN_EPI) { if (wr == 1) PG8_BAR; }
    }
    PG8_WAIT_V(0);
    if constexpr (!ALIGN_EPI) { if (wr == 0) PG8_BAR; }
    PG8_BAR;
    if constexpr (Epi::AFTER_DRAIN) { E.fused(acc, cur, wr, wc, fr, fq, lds, wid, lane); S.done(cur); }
#undef PG8_SA
#undef PG8_SB
#undef PG8_STAGE
#undef PG8_LDA
#undef PG8_LDB
#undef PG8_MMA
#undef PG8_WAIT_V
#undef PG8_WAIT_L
#undef PG8_BAR
#undef PG8_SCHED
}
}
#define GAS __attribute__((address_space(1)))
#define LAS __attribute__((address_space(3)))
typedef unsigned short bf16;
typedef unsigned v4u __attribute__((ext_vector_type(4)));
typedef float f32x4 __attribute__((ext_vector_type(4)));
typedef short bf16x8 __attribute__((ext_vector_type(8)));
typedef GAS unsigned gu32;
typedef GAS unsigned long long gu64;
#define RLX_AGENT __ATOMIC_RELAXED, __HIP_MEMORY_SCOPE_AGENT
#define LDS_WAIT() asm volatile("s_waitcnt lgkmcnt(0)" ::: "memory")
#define VM_WAIT() asm volatile("s_waitcnt vmcnt(0)" ::: "memory")
__device__ __forceinline__ unsigned long long rt() { return __builtin_amdgcn_s_memrealtime(); }
__device__ __forceinline__ unsigned f2bf(float f) { unsigned u = __builtin_bit_cast(unsigned, f); return (u + 0x7fffu + ((u >> 16) & 1u)) >> 16; }
__device__ __forceinline__ unsigned pk2(float lo, float hi) { return f2bf(lo) | (f2bf(hi) << 16); }

#define XB_TMO      128
#define XB_XCNT(j)  (256  + 64 * (j))
#define XB_XSUB(j)  (1280 + 64 * (j))
#define XB_XGEN(j)  (2304 + 64 * (j))
#define XB_TOP      3328
#define XB_TOPGEN   3392
#define XCD_BAR_WORDS 3456
#define XB_SPIN_CAP (1u << 18)

__device__ __forceinline__ unsigned xb_ld(unsigned* p)              { return __hip_atomic_load(p, __ATOMIC_RELAXED, __HIP_MEMORY_SCOPE_AGENT); }
__device__ __forceinline__ unsigned xb_add(unsigned* p, unsigned v) { return __hip_atomic_fetch_add(p, v, __ATOMIC_RELAXED, __HIP_MEMORY_SCOPE_AGENT); }
__device__ __forceinline__ unsigned xb_xcc_id() { return (unsigned)__builtin_amdgcn_s_getreg((3 << 11) | 20) & 0xFu; }
#define XB_SPIN(cond, bar) do { unsigned _sp = 0; while (cond) { __builtin_amdgcn_s_sleep(1); \
    if ((++_sp & 255u) == 0u) { if (xb_ld(&(bar)[XB_TMO])) break; if (_sp > XB_SPIN_CAP) { atomicAdd(&(bar)[XB_TMO], 1u); break; } } } } while (0)

struct XcdBarrier {
    unsigned* bar; unsigned x;
    volatile LAS unsigned* st;
};

__device__ __forceinline__ XcdBarrier xcd_barrier_post(unsigned* bar, volatile LAS unsigned* st) {
    XcdBarrier b; b.bar = bar; b.x = xb_xcc_id(); b.st = st;
    if (threadIdx.x == 0) (void)xb_add(&bar[XB_XCNT(b.x)], 1u);
    return b;
}
__device__ __forceinline__ void xcd_barrier_complete(unsigned* bar, unsigned x, unsigned& nloc, unsigned& nx) {
    const unsigned G = gridDim.x * gridDim.y * gridDim.z;
    unsigned sum, cnt, mine, sp = 0u;
    for (;;) {
        sum = 0u; cnt = 0u; mine = 0u;
#pragma unroll
        for (unsigned j = 0; j < 16; ++j) { const unsigned c = xb_ld(&bar[XB_XCNT(j)]); sum += c; cnt += (c > 0u) ? 1u : 0u; mine = (j == x) ? c : mine; }
        if (sum == G) break;
        __builtin_amdgcn_s_sleep(1);
        if ((++sp & 255u) == 0u) { if (xb_ld(&bar[XB_TMO])) break; if (sp > XB_SPIN_CAP) { atomicAdd(&bar[XB_TMO], 1u); break; } }
    }
    nloc = mine > 0u ? mine : 1u; nx = cnt > 0u ? cnt : 1u;
}

__device__ __forceinline__ void xcd_barrier(const XcdBarrier& b) {
    asm volatile("s_waitcnt vmcnt(0)" ::: "memory");
    __syncthreads();
    if (threadIdx.x == 0) {
        unsigned* bar = b.bar;
        __builtin_amdgcn_s_waitcnt(0);
        unsigned nloc = b.st[0], nx = b.st[1];
        if (nloc == 0u) { xcd_barrier_complete(bar, b.x, nloc, nx); b.st[0] = nloc; b.st[1] = nx; }
        const unsigned old = xb_add(&bar[XB_XSUB(b.x)], 1u);
        const unsigned gen = old / nloc;
        if (old + 1u == (gen + 1u) * nloc) {
            __builtin_amdgcn_fence(__ATOMIC_RELEASE, "agent");
            asm volatile("s_waitcnt vmcnt(0)" ::: "memory");
            const unsigned og = xb_add(&bar[XB_TOP], 1u);
            const unsigned tg = og / nx;
            if (og + 1u == (tg + 1u) * nx) xb_add(&bar[XB_TOPGEN], 1u);
            else XB_SPIN(xb_ld(&bar[XB_TOPGEN]) == tg, bar);
            __builtin_amdgcn_fence(__ATOMIC_ACQUIRE, "agent");
            xb_add(&bar[XB_XGEN(b.x)], 1u);
            asm volatile("s_waitcnt vmcnt(0)" ::: "memory");
        } else {
            XB_SPIN(xb_ld(&bar[XB_XGEN(b.x)]) == gen, bar);
            __builtin_amdgcn_fence(__ATOMIC_ACQUIRE, "agent");
            asm volatile("s_waitcnt vmcnt(0)" ::: "memory");
        }
    }
    __syncthreads();
}

typedef float f32x16 __attribute__((ext_vector_type(16)));
typedef short s16x4 __attribute__((ext_vector_type(4)));
typedef unsigned u32x2 __attribute__((ext_vector_type(2)));

constexpr int D = 2048, FF = 5632, NGU = 2 * FF, SEQ = 16384, NB = 2, CTXL = 256;
constexpr int M_LAT = NB * SEQ;
constexpr int M_CTX = NB * CTXL;
constexpr int M_ALL = M_LAT + M_CTX;
constexpr int NMODV = 9 * D;
constexpr int QLORA = 448, KVLORA = 160, ROPE = 64, NHEAD = 16, DQK = 192, DVH = 128;
constexpr int NDQKV = 768;
constexpr int KQ = 512, KKV = 256;
constexpr float EPS = 1e-6f;
constexpr int KSPLIT = 14;
constexpr int NWAVES = 8;

constexpr size_t MiB = 1u << 20;
constexpr size_t WS_CTL = 0, CTL_ZERO_BYTES = 1 * MiB;
constexpr size_t WS_STATS = 512 * 1024;
constexpr size_t WS_MOD = 1 * MiB;
constexpr size_t WS_ROPE = 2 * MiB;
constexpr size_t WS_MODP = 3 * MiB;
constexpr size_t WS_WGU = 10 * MiB;
constexpr size_t SZ_WGU = 44 * MiB;
constexpr size_t WS_WD = WS_WGU + 4 * SZ_WGU;
constexpr size_t SZ_WD = 22 * MiB;
constexpr size_t WS_GMIN = WS_WD + 4 * SZ_WD;
constexpr size_t WS_GMOUT = WS_GMIN + 16 * MiB;
constexpr size_t WS_WDQKV = WS_GMOUT + 8 * MiB;
constexpr size_t WS_WUQ = WS_WDQKV + 3 * MiB;
constexpr size_t WS_WUKV = WS_WUQ + 3 * MiB;
constexpr size_t WS_WO = WS_WUKV + 2 * MiB;
constexpr size_t WS_Y = WS_WO + 8 * MiB;
constexpr size_t WS_XB = WS_Y + 4 * MiB;
constexpr size_t WS_XN = WS_XB;
constexpr size_t WS_BIG = WS_XN + 130 * MiB;
constexpr size_t WS_U = WS_BIG, WS_V = WS_BIG + 130 * MiB;
constexpr size_t WS_Q = WS_BIG, WS_KN = WS_BIG + 192 * MiB, WS_VV = WS_KN + 130 * MiB, WS_F = WS_VV + 130 * MiB;
constexpr size_t WS_CQ = WS_F + 98 * MiB, WS_CKV = WS_CQ + 33 * MiB, WS_KPE = WS_CKV + 17 * MiB, WS_END = WS_KPE + 5 * MiB;
static_assert((size_t)M_ALL * D * 2 <= 130 * MiB && (size_t)M_ALL * FF * 2 <= 358 * MiB && (size_t)M_LAT * 3072 * 2 <= 192 * MiB, "ws map");
static_assert((size_t)M_ALL * NDQKV * 4 <= 98 * MiB && (size_t)M_ALL * KQ * 2 <= 33 * MiB && (size_t)M_ALL * KKV * 2 <= 17 * MiB && (size_t)M_ALL * 64 * 2 <= 5 * MiB, "ws map 2");
static_assert(WS_STATS + (size_t)M_ALL * 8 <= CTL_ZERO_BYTES, "stats inside the zeroed region");
constexpr int CW_TMO = 0, CW_CODE = 1, CW_BAR = 4096;

constexpr int RING_OFF = 0, RING_BYTES = 131072;
constexpr int ATT_SHM_V = 64 * 256, ATT_SHM_K = 64 * 384;
constexpr int ATT_OFF_K = 2 * ATT_SHM_V, ATT_OFF_WS = ATT_OFF_K + 2 * ATT_SHM_K, ATT_OFF_QPE = ATT_OFF_WS + NWAVES * 256, ATT_NQR = 5, ATT_END = ATT_OFF_QPE + NWAVES * (12 - ATT_NQR) * 1024, ATT_OFF_OST = 0;
static_assert(NWAVES * 8192 <= ATT_OFF_WS, "O stage overlays the K/V buffers");
constexpr int ATT_NQD = 12;
constexpr int MISC_OFF = 149504, LDS_BYTES = 149504 + 512;
static_assert(ATT_END <= MISC_OFF && RING_BYTES <= MISC_OFF && MISC_OFF + 128 <= LDS_BYTES, "LDS map");

enum Phase { PH_PRO = 0, PH_MOD, PH_L0 = 2,
             PH_END = 27 };
constexpr int N_PHASES = 25;

struct Args { const float* in[24]; float* out; unsigned char* ws; int ph_lo, ph_hi; };
static_assert(sizeof(Args) == 24 * 8 + 8 + 8 + 8, "Args has no padding");

struct Frame {
    LAS unsigned char* lds;
    gu32* ctl;
    int wave, vcu, G;
};
__device__ __forceinline__ int mk_lane() { int l; asm volatile("v_mbcnt_lo_u32_b32 %0, -1, 0\n\tv_mbcnt_hi_u32_b32 %0, -1, %0" : "=v"(l)); return l; }

__device__ __forceinline__ float wave_sum(float v) {
#pragma unroll
    for (int o = 1; o < 64; o <<= 1) v += __shfl_xor(v, o);
    return v;
}
__device__ __forceinline__ float silu_f(float x) { return x * __builtin_amdgcn_rcpf(1.0f + __builtin_amdgcn_exp2f(-1.4426950408889634f * x)); }
__device__ __forceinline__ float gelu_tanh_f(float x) {
    const float z = 0.7978845608028654f * (x + 0.044715f * x * x * x);
    return x * __builtin_amdgcn_rcpf(1.0f + __builtin_amdgcn_exp2f(-2.0f * 1.4426950408889634f * z));
}
__device__ __forceinline__ int cond_of_row(int r) { return r < SEQ ? 0 : (r < M_LAT ? 1 : 2); }

typedef float f32x2 __attribute__((ext_vector_type(2)));
constexpr float GATE_SCALE = 1.4426950408889634f, UP_SCALE = 0.6931471805599453f;
struct EpiSwiGLU {
    static constexpr bool PERM = true, AFTER_DRAIN = false;
    pg8::bf16_t* H;
    __device__ __forceinline__ void operator()(const pg8::f32x4 (&acc)[2][2][4][2], const pg8::Unit& u, int wr, int wc, int fr, int fq) const {
        asm volatile("" : "+v"(fr), "+v"(fq));
        const int row0 = u.pm * 256 + wr * 64 + fr, col0 = u.pn * 128 + wc * 32 + 8 * fq;
#pragma unroll
        for (int ai = 0; ai < 2; ++ai)
#pragma unroll
            for (int m = 0; m < 4; ++m) {
                pg8::bf16_t* rowp = H + (size_t)(row0 + ai * 128 + m * 16) * FF + col0;
                f32x2 hp[4];
#pragma unroll
                for (int n = 0; n < 2; ++n)
#pragma unroll
                    for (int j = 0; j < 4; j += 2) {
                        const f32x2 g2 = {acc[ai][0][m][n][j], acc[ai][0][m][n][j + 1]}, u2 = {acc[ai][1][m][n][j], acc[ai][1][m][n][j + 1]};
                        f32x2 e2 = {__builtin_amdgcn_exp2f(-g2.x), __builtin_amdgcn_exp2f(-g2.y)};
                        e2 = e2 + 1.0f;
                        const f32x2 r2 = {__builtin_amdgcn_rcpf(e2.x), __builtin_amdgcn_rcpf(e2.y)};
                        hp[n * 2 + (j >> 1)] = (g2 * u2) * r2; }
                pg8::u32x4 w; w.x = pg8::cvt_pk_bf16(hp[0].x, hp[0].y); w.y = pg8::cvt_pk_bf16(hp[1].x, hp[1].y); w.z = pg8::cvt_pk_bf16(hp[2].x, hp[2].y); w.w = pg8::cvt_pk_bf16(hp[3].x, hp[3].y);
                *(pg8::u32x4*)rowp = w;
            }
    }
};
typedef _Float16 h16x4 __attribute__((ext_vector_type(4)));
__device__ __forceinline__ pg8::f32x4 bf4_to_f32(u32x2 w) { const h16x4 h = __builtin_bit_cast(h16x4, w); return __builtin_convertvector(h, pg8::f32x4); }
__device__ __forceinline__ u32x2 f32_to_bf4(pg8::f32x4 v) { const h16x4 h = __builtin_convertvector(v, h16x4); return __builtin_bit_cast(u32x2, h); }
template <bool BASE_F32> struct EpiResidT {
    static constexpr bool PERM = true, AFTER_DRAIN = false;
    const void* base; pg8::bf16_t* out;
    const float* gate;
    float coef;
    __device__ __forceinline__ void operator()(const pg8::f32x4 (&acc)[2][2][4][2], const pg8::Unit& u, int wr, int wc, int fr, int fq) const {
        asm volatile("" : "+v"(fr), "+v"(fq));
        typedef _Float16 h16x8 __attribute__((ext_vector_type(8)));
        typedef float f32x8v __attribute__((ext_vector_type(8)));
        const int row0 = u.pm * 256 + wr * 64 + fr, col0 = u.pn * 256 + wc * 32 + 8 * fq;
        const int cond = u.pm < 64 ? 0 : 1;
        const float* gv = gate + (size_t)cond * NMODV + col0;
        pg8::f32x4 g[2][2];
#pragma unroll
        for (int bj = 0; bj < 2; ++bj)
#pragma unroll
            for (int n = 0; n < 2; ++n) g[bj][n] = *(const pg8::f32x4*)(gv + bj * 128 + 4 * n) * coef;
#pragma unroll
        for (int ai = 0; ai < 2; ++ai) {
            pg8::f32x4 bv[4][2][2];
#pragma unroll
            for (int m = 0; m < 4; ++m)
#pragma unroll
                for (int bj = 0; bj < 2; ++bj) { const size_t off = (size_t)(row0 + ai * 128 + m * 16) * D + col0 + bj * 128;
                    if constexpr (BASE_F32) { bv[m][bj][0] = *(const pg8::f32x4*)((const float*)base + off); bv[m][bj][1] = *(const pg8::f32x4*)((const float*)base + off + 4); }
                    else { const h16x8 h = __builtin_bit_cast(h16x8, *(const pg8::u32x4*)((const pg8::bf16_t*)base + off)); const f32x8v f = __builtin_convertvector(h, f32x8v);
                        bv[m][bj][0] = (pg8::f32x4){f[0], f[1], f[2], f[3]}; bv[m][bj][1] = (pg8::f32x4){f[4], f[5], f[6], f[7]}; } }
#pragma unroll
            for (int m = 0; m < 4; ++m)
#pragma unroll
                for (int bj = 0; bj < 2; ++bj) {
                    const pg8::f32x4 o0 = bv[m][bj][0] + g[bj][0] * acc[ai][bj][m][0], o1 = bv[m][bj][1] + g[bj][1] * acc[ai][bj][m][1];
                    const f32x8v f = {o0[0], o0[1], o0[2], o0[3], o1[0], o1[1], o1[2], o1[3]};
                    *(pg8::u32x4*)(out + (size_t)(row0 + ai * 128 + m * 16) * D + col0 + bj * 128) = __builtin_bit_cast(pg8::u32x4, __builtin_convertvector(f, h16x8));
                }
        }
    }
};
typedef EpiResidT<false> EpiResid;
typedef EpiResidT<true> EpiResidF32;
struct EpiResidAtomic {
    static constexpr bool PERM = false, AFTER_DRAIN = false;
    float* outC;
    const float* gate;
    float coef;
    __device__ __forceinline__ void operator()(const pg8::f32x4 (&acc)[2][2][4][2], const pg8::Unit& u, int wr, int wc, int fr, int fq) const {
        asm volatile("" : "+v"(fr), "+v"(fq));
        const int row0 = u.pm * 256 + wr * 64 + fr, col0 = u.pn * 256 + wc * 32 + 4 * fq;
        const float* gv = gate + (size_t)2 * NMODV + col0;
        pg8::f32x4 g[2][2];
#pragma unroll
        for (int bj = 0; bj < 2; ++bj)
#pragma unroll
            for (int n = 0; n < 2; ++n) g[bj][n] = *(const pg8::f32x4*)(gv + bj * 128 + n * 16) * coef;
#pragma unroll
        for (int ai = 0; ai < 2; ++ai)
#pragma unroll
            for (int m = 0; m < 4; ++m) {
                float* op = outC + (size_t)(row0 + ai * 128 + m * 16) * D + col0;
#pragma unroll
                for (int bj = 0; bj < 2; ++bj)
#pragma unroll
                    for (int n = 0; n < 2; ++n) {
                        const pg8::f32x4 v = g[bj][n] * acc[ai][bj][m][n];
#pragma unroll
                        for (int j = 0; j < 4; ++j) unsafeAtomicAdd(op + bj * 128 + n * 16 + j, v[j]);
                    }
            }
    }
};
struct EpiPartial {
    static constexpr bool PERM = false, AFTER_DRAIN = false;
    float* part;
    const float* gate; float coef; int kslice_bytes;
    __device__ __forceinline__ void operator()(const pg8::f32x4 (&acc)[2][2][4][2], const pg8::Unit& u, int wr, int wc, int fr, int fq) const {
        asm volatile("" : "+v"(fr), "+v"(fq));
        const int row0 = u.pm * 256 + wr * 64 + fr, col0 = u.pn * 256 + wc * 32 + 4 * fq;
        const float* gv = gate + (size_t)2 * NMODV + col0;
        float* pbase = part + (size_t)(u.kofs / kslice_bytes) * ((size_t)M_CTX * D);
        pg8::f32x4 g[2][2];
#pragma unroll
        for (int bj = 0; bj < 2; ++bj)
#pragma unroll
            for (int n = 0; n < 2; ++n) g[bj][n] = *(const pg8::f32x4*)(gv + bj * 128 + n * 16) * coef;
#pragma unroll
        for (int ai = 0; ai < 2; ++ai)
#pragma unroll
            for (int m = 0; m < 4; ++m) {
                float* op = pbase + (size_t)(row0 + ai * 128 + m * 16) * D + col0;
#pragma unroll
                for (int bj = 0; bj < 2; ++bj)
#pragma unroll
                    for (int n = 0; n < 2; ++n) *(pg8::f32x4*)(op + bj * 128 + n * 16) = g[bj][n] * acc[ai][bj][m][n];
            }
    }
};
constexpr int CTX_P = 11;
static_assert(FF % (CTX_P * 128) == 0, "every K slice must be an even number of 64-wide K tiles");
struct SplitKOrder {
    int nN, P, kslice_bytes, G, c;
    __device__ __forceinline__ bool next(int i, pg8::Unit& u) const {
        const int L = i * G + c; if (L >= 2 * nN * P) return false;
        const int part = L / (2 * nN), t = L % (2 * nN);
        u.pm = 128 + (t & 1); u.pn = t >> 1; u.kofs = part * kslice_bytes; return true;
    }
    __device__ __forceinline__ void a_ready(const pg8::Unit&) const {}
    __device__ __forceinline__ void done(const pg8::Unit&) const {}
};
struct ClaimOrder {
    int nN, P, kslice_bytes; unsigned* ctr; volatile LAS unsigned* mb;
    __device__ __forceinline__ bool next(int i, pg8::Unit& u) const {
        if (i > 0) return false;
        if (threadIdx.x == 0) *mb = atomicAdd(ctr, 1u);
        __syncthreads();
        const int L = (int)*mb; if (L >= 2 * nN * P) return false;
        const int part = L / (2 * nN), t = L % (2 * nN);
        u.pm = 128 + (t & 1); u.pn = t >> 1; u.kofs = part * kslice_bytes; return true;
    }
    __device__ __forceinline__ void a_ready(const pg8::Unit&) const {}
    __device__ __forceinline__ void done(const pg8::Unit&) const {}
};
static_assert(2 * (D / 256) * CTX_P <= 256, "ClaimOrder: one unit per workgroup");
struct EpiGeluUV {
    static constexpr bool PERM = true, AFTER_DRAIN = false;
    pg8::bf16_t* U; pg8::bf16_t* V; float* stats;
    __device__ __forceinline__ void operator()(const pg8::f32x4 (&acc)[2][2][4][2], const pg8::Unit& u, int wr, int wc, int fr, int fq) const {
        asm volatile("" : "+v"(fr), "+v"(fq));
        const int row0 = u.pm * 256 + wr * 64 + fr;
        const bool isv = u.pn >= 8;
        pg8::bf16_t* base = isv ? V : U;
        const int col0 = (u.pn & 7) * 256 + wc * 32 + 8 * fq;
#pragma unroll
        for (int ai = 0; ai < 2; ++ai)
#pragma unroll
            for (int m = 0; m < 4; ++m) {
                const int row = row0 + ai * 128 + m * 16;
                pg8::bf16_t* rowp = base + (size_t)row * D + col0;
                float s = 0.f, q = 0.f;
#pragma unroll
                for (int bj = 0; bj < 2; ++bj) {
                    float z[8];
#pragma unroll
                    for (int n = 0; n < 2; ++n)
#pragma unroll
                        for (int j = 0; j < 4; ++j) { const float t = gelu_tanh_f(acc[ai][bj][m][n][j]); z[n * 4 + j] = t; s += t; q += t * t; }
                    pg8::u32x4 w; w.x = pg8::cvt_pk_bf16(z[0], z[1]); w.y = pg8::cvt_pk_bf16(z[2], z[3]); w.z = pg8::cvt_pk_bf16(z[4], z[5]); w.w = pg8::cvt_pk_bf16(z[6], z[7]);
                    *(pg8::u32x4*)(rowp + bj * 128) = w;
                }
                if (isv) {
                    s += __shfl_xor(s, 16); s += __shfl_xor(s, 32); q += __shfl_xor(q, 16); q += __shfl_xor(q, 32);
                    if (fq == 0) { atomicAdd(stats + 2 * row, s); atomicAdd(stats + 2 * row + 1, q); }
                }
            }
    }
};
struct EpiF32 {
    static constexpr bool PERM = false, AFTER_DRAIN = false;
    float* C; int ldc;
    __device__ __forceinline__ void operator()(const pg8::f32x4 (&acc)[2][2][4][2], const pg8::Unit& u, int wr, int wc, int fr, int fq) const {
        asm volatile("" : "+v"(fr), "+v"(fq));
        const int row0 = u.pm * 256 + wr * 64 + fr, col0 = u.pn * 256 + wc * 32 + 4 * fq;
#pragma unroll
        for (int ai = 0; ai < 2; ++ai)
#pragma unroll
            for (int m = 0; m < 4; ++m) { float* rowp = C + (size_t)(row0 + ai * 128 + m * 16) * ldc + col0;
#pragma unroll
                for (int bj = 0; bj < 2; ++bj)
#pragma unroll
                    for (int n = 0; n < 2; ++n) *(pg8::f32x4*)(rowp + bj * 128 + n * 16) = acc[ai][bj][m][n]; }
    }
};
constexpr float QPRESCALE = 0.07216878364870322f * 1.4426950408889634f;
struct EpiQRope {
    static constexpr bool PERM = true, AFTER_DRAIN = false;
    pg8::bf16_t* Q; const float* rope;
    __device__ __forceinline__ void operator()(const pg8::f32x4 (&acc)[2][2][4][2], const pg8::Unit& u, int wr, int wc, int fr, int fq) const {
        asm volatile("" : "+v"(fr), "+v"(fq));
        const int row0 = u.pm * 256 + wr * 64 + fr;
#pragma unroll
        for (int bj = 0; bj < 2; ++bj) {
            const int g32 = u.pn * 8 + bj * 4 + wc, gh = g32 % 6;
            const int col0 = g32 * 32 + 8 * fq;
#pragma unroll
            for (int ai = 0; ai < 2; ++ai)
#pragma unroll
                for (int m = 0; m < 4; ++m) {
                    const int row = row0 + ai * 128 + m * 16;
                    float x[8];
#pragma unroll
                    for (int n = 0; n < 2; ++n)
#pragma unroll
                        for (int j = 0; j < 4; ++j) x[n * 4 + j] = acc[ai][bj][m][n][j];
                    if (gh >= 4) {
                        const int t = row & (SEQ - 1), pos = (gh == 4) ? (t >> 6) : (t & 63);
                        const float* cp = rope + pos * 16 + 8 * (fq & 1); const float* sp = cp + 256 * 16;
                        const float sgn = (fq & 2) ? 1.f : -1.f;
#pragma unroll
                        for (int e = 0; e < 8; ++e) { const float p = __shfl_xor(x[e], 32); x[e] = x[e] * cp[e] + sgn * p * sp[e]; }
                    }
#pragma unroll
                    for (int e = 0; e < 8; ++e) x[e] *= QPRESCALE;
                    pg8::u32x4 w; w.x = pg8::cvt_pk_bf16(x[0], x[1]); w.y = pg8::cvt_pk_bf16(x[2], x[3]); w.z = pg8::cvt_pk_bf16(x[4], x[5]); w.w = pg8::cvt_pk_bf16(x[6], x[7]);
                    *(pg8::u32x4*)(Q + (size_t)row * 3072 + col0) = w;
                }
        }
    }
};
struct EpiKV {
    static constexpr bool PERM = true, AFTER_DRAIN = false;
    pg8::bf16_t* KN; pg8::bf16_t* V;
    __device__ __forceinline__ void operator()(const pg8::f32x4 (&acc)[2][2][4][2], const pg8::Unit& u, int wr, int wc, int fr, int fq) const {
        asm volatile("" : "+v"(fr), "+v"(fq));
        const int row0 = u.pm * 256 + wr * 64 + fr, col0 = u.pn * 128 + wc * 32 + 8 * fq;
#pragma unroll
        for (int ai = 0; ai < 2; ++ai)
#pragma unroll
            for (int m = 0; m < 4; ++m) {
                const size_t off = (size_t)(row0 + ai * 128 + m * 16) * D + col0;
#pragma unroll
                for (int bj = 0; bj < 2; ++bj) {
                    const pg8::f32x4 v0 = acc[ai][bj][m][0], v1 = acc[ai][bj][m][1];
                    pg8::u32x4 w; w.x = pg8::cvt_pk_bf16(v0[0], v0[1]); w.y = pg8::cvt_pk_bf16(v0[2], v0[3]); w.z = pg8::cvt_pk_bf16(v1[0], v1[1]); w.w = pg8::cvt_pk_bf16(v1[2], v1[3]);
                    *(pg8::u32x4*)((bj ? V : KN) + off) = w;
                }
            }
    }
};

__device__ __forceinline__ void transpose_item(const float* W, int K, int N, bf16* WT, int Kd, int drow0, int k0, int n0, LAS float* scr, int lane, float scale = 1.0f) {
    float wv[32];
#pragma unroll
    for (int i = 0; i < 32; ++i) { const int kk = 2 * i + (lane >> 5), k = k0 + kk; wv[i] = (k < K) ? W[(size_t)k * N + n0 + (lane & 31)] : 0.f; }
    if (scale != 1.0f) {
#pragma unroll
        for (int i = 0; i < 32; ++i) wv[i] *= scale; }
#pragma unroll
    for (int i = 0; i < 32; ++i) { const int kk = 2 * i + (lane >> 5); scr[kk * 33 + (lane & 31)] = wv[i]; }
    LDS_WAIT(); asm volatile("" ::: "memory");
    const int c = lane & 7;
#pragma unroll
    for (int j = 0; j < 4; ++j) { const int n = (lane >> 3) + 8 * j; const LAS float* s = scr + (8 * c) * 33 + n;
        v4u o; o.x = pk2(s[0 * 33], s[1 * 33]); o.y = pk2(s[2 * 33], s[3 * 33]); o.z = pk2(s[4 * 33], s[5 * 33]); o.w = pk2(s[6 * 33], s[7 * 33]);
        *(GAS v4u*)(WT + (size_t)(drow0 + n) * Kd + k0 + 8 * c) = o; }
    LDS_WAIT(); asm volatile("" ::: "memory");
}
__device__ __forceinline__ void transpose_mat(const float* W, int K, int N, bf16* WT, int Kd, int drow_off, int r, LAS float* scr, int lane) {
    const int nblk = N / 32, kb = r / nblk, nb = r % nblk;
    transpose_item(W, K, N, WT, Kd, drow_off + 32 * nb, 64 * kb, 32 * nb, scr, lane);
}

__device__ __forceinline__ void ph_prologue(Frame& F, const Args& a) {
    unsigned char* ws = a.ws; const int lane_ = mk_lane(), tid_ = F.wave * 64 + lane_;
    const int gw = F.vcu * NWAVES + F.wave, NGW = F.G * NWAVES;
    LAS float* stab = (LAS float*)(F.lds + 98304);
    for (int k = tid_; k < D; k += NWAVES * 64) {
        pg8::f32x4 s; s.x = silu_f(a.in[1][k]); s.y = silu_f(a.in[1][D + k]); s.z = silu_f(a.in[3][k]); s.w = 0.f;
        *(LAS pg8::f32x4*)(stab + 4 * k) = s;
    }
    __syncthreads();
    {
        constexpr int NT = 2 * 72 * KSPLIT;
        for (int t = gw; t < NT; t += NGW) {
            const int ks = t % KSPLIT, cb = (t / KSPLIT) % 72, l = t / (KSPLIT * 72);
            const int kbeg = ks * D / KSPLIT, kend = (ks + 1) * D / KSPLIT, col = cb * 256 + 4 * lane_;
            const float* w = a.in[4] + ((size_t)l * D + kbeg) * NMODV + col;
            pg8::f32x4 a0 = {0.f, 0.f, 0.f, 0.f}, a1 = a0, a2 = a0;
#pragma unroll 16
            for (int k = kbeg; k < kend; ++k) {
                const pg8::f32x4 wv = *(const pg8::f32x4*)w; w += NMODV;
                const pg8::f32x4 s = *(LAS pg8::f32x4*)(stab + 4 * k);
                a0 += wv * s.x; a1 += wv * s.y; a2 += wv * s.z;
            }
            float* p = (float*)(ws + WS_MODP) + ((size_t)(ks * 2 + l) * 3) * NMODV + col;
            *(pg8::f32x4*)p = a0; *(pg8::f32x4*)(p + NMODV) = a1; *(pg8::f32x4*)(p + 2 * NMODV) = a2;
        }
    }
    for (int i = blockIdx.x * (NWAVES * 64) + tid_; i < 256 * 16; i += F.G * NWAVES * 64) {
        const int pos = i >> 4, f = i & 15;
        const float inv = __builtin_amdgcn_exp2f(-(float)f * (13.287712379549449f / 16.0f));
        const float rev = (float)pos * inv * 0.15915494309189535f;
        float* rp = (float*)(ws + WS_ROPE);
        rp[i] = __builtin_amdgcn_cosf(rev); rp[4096 + i] = __builtin_amdgcn_sinf(rev);
    }
    { const GAS v4u* src = (const GAS v4u*)a.in[2]; GAS v4u* dst = (GAS v4u*)(ws + WS_Y);
      for (int i = blockIdx.x * (NWAVES * 64) + tid_; i < M_CTX * D / 4; i += F.G * NWAVES * 64) dst[i] = src[i]; }
    { v4u z = {0u, 0u, 0u, 0u}; GAS v4u* p = (GAS v4u*)(ws + WS_WDQKV + (size_t)672 * D * 2);
      for (int i = blockIdx.x * (NWAVES * 64) + tid_; i < 96 * D * 2 / 16; i += F.G * NWAVES * 64) p[i] = z; }
    LAS float* scr = (LAS float*)(F.lds + F.wave * 8448);
    constexpr int IT_FFN = 5632, N_FFN = 12 * IT_FFN;
    constexpr int I_GMIN = 32 * 128, I_GMOUT = 32 * 64, I_WO = 32 * 64, I_DQ = 32 * 14, I_DKV = 32 * 7, I_UQ = 8 * 96, I_UKV = 4 * 128;
    constexpr int NITEMS = N_FFN + I_GMIN + I_GMOUT + I_WO + I_DQ + I_DKV + I_UQ + I_UKV;
    for (int it = gw; it < NITEMS; it += NGW) {
        int r = it;
        if (r < N_FFN) {
            const int idx = r / IT_FFN, sub = idx / 3, kind = idx % 3; r -= idx * IT_FFN;
            if (kind < 2) {
                const float* W = a.in[7 + kind] + (size_t)sub * D * FF;
                const int nblk = FF / 32, kb = r / nblk, nb = r % nblk, n0 = 32 * nb;
                transpose_item(W, D, FF, (bf16*)(ws + WS_WGU + sub * SZ_WGU), D, (n0 >> 7) * 256 + kind * 128 + (n0 & 127), 64 * kb, n0, scr, lane_, kind == 0 ? GATE_SCALE : UP_SCALE);
            } else {
                transpose_mat(a.in[9] + (size_t)sub * FF * D, FF, D, (bf16*)(ws + WS_WD + sub * SZ_WD), FF, 0, r, scr, lane_);
            }
            continue;
        }
        r -= N_FFN;
        if (r < I_GMIN) { transpose_mat(a.in[10], D, 4096, (bf16*)(ws + WS_GMIN), D, 0, r, scr, lane_); continue; } r -= I_GMIN;
        if (r < I_GMOUT) { transpose_mat(a.in[15], D, D, (bf16*)(ws + WS_GMOUT), D, 0, r, scr, lane_); continue; } r -= I_GMOUT;
        if (r < I_WO) { transpose_mat(a.in[22], D, D, (bf16*)(ws + WS_WO), D, 0, r, scr, lane_); continue; } r -= I_WO;
        if (r < I_DQ) { transpose_mat(a.in[16], D, QLORA, (bf16*)(ws + WS_WDQKV), D, 0, r, scr, lane_); continue; } r -= I_DQ;
        if (r < I_DKV) { transpose_mat(a.in[19], D, KVLORA + ROPE, (bf16*)(ws + WS_WDQKV), D, QLORA, r, scr, lane_); continue; } r -= I_DKV;
        if (r < I_UQ) { transpose_mat(a.in[18], QLORA, 3072, (bf16*)(ws + WS_WUQ), KQ, 0, r, scr, lane_); continue; } r -= I_UQ;
        transpose_mat(a.in[21], KVLORA, 4096, (bf16*)(ws + WS_WUKV), KKV, 0, r, scr, lane_);
    }
}
__device__ __forceinline__ void ph_modreduce(Frame& F, const Args& a) {
    const int tid_ = F.wave * 64 + mk_lane();
    const float* mp = (const float*)(a.ws + WS_MODP); float* mod = (float*)(a.ws + WS_MOD);
    for (int i = blockIdx.x * (NWAVES * 64) + tid_; i < 2 * 3 * NMODV; i += F.G * NWAVES * 64) {
        const int n = i % NMODV, l = i / (3 * NMODV);
        float s = a.in[5][l * NMODV + n];
#pragma unroll
        for (int ks = 0; ks < KSPLIT; ++ks) s += mp[(size_t)ks * 2 * 3 * NMODV + i];
        mod[i] = s;
    }
}
template <bool LAT_F32, int P = 0> __device__ __forceinline__ void ph_norm(Frame& F, const void* srcL  , const float* srcC  , int M, const float* g, const float* modl  , int k, bf16* XN, const float* part = nullptr  , float* Ywr = nullptr  ) {
    typedef _Float16 h16x8 __attribute__((ext_vector_type(8)));
    typedef float f32x8v __attribute__((ext_vector_type(8)));
    const int gw = F.vcu * NWAVES + F.wave, NGW = F.G * NWAVES, lane_ = mk_lane();
    int cur = -1; f32x8v A[4], B[4];
    auto do_row = [&](const int r) {
        const int cond = cond_of_row(r);
        if (cond != cur) {
            cur = cond;
            const float* sh = modl + (size_t)cond * NMODV + (3 * k) * D; const float* sc = sh + D;
#pragma unroll
            for (int j = 0; j < 4; ++j) { const int c = 8 * lane_ + 512 * j; const f32x8v gg = *(const f32x8v*)(g + c), s1 = *(const f32x8v*)(sc + c);
                A[j] = gg * (s1 + 1.0f); B[j] = *(const f32x8v*)(sh + c); }
        }
        f32x8v v[4]; float ss = 0.f;
        if (LAT_F32 || r >= M_LAT) {
            const float* xr = (r < M_LAT ? (const float*)srcL : srcC) + (size_t)r * D + 8 * lane_;
#pragma unroll
            for (int j = 0; j < 4; ++j) v[j] = *(const GAS f32x8v*)(xr + 512 * j);
            if (P > 0 && r >= M_LAT) {
                const float* pr = part + (size_t)r * D + 8 * lane_;
#pragma unroll
                for (int p0 = 0; p0 < P; p0 += 3) {
                    f32x8v t[3][4];
#pragma unroll
                    for (int pp = 0; pp < 3; ++pp)
#pragma unroll
                        for (int j = 0; j < 4; ++j) if (p0 + pp < P) t[pp][j] = *(const GAS f32x8v*)(pr + (size_t)(p0 + pp) * ((size_t)M_CTX * D) + 512 * j);
#pragma unroll
                    for (int pp = 0; pp < 3; ++pp)
#pragma unroll
                        for (int j = 0; j < 4; ++j) if (p0 + pp < P) v[j] += t[pp][j]; }
                float* yw = Ywr + (size_t)r * D + 8 * lane_;
#pragma unroll
                for (int j = 0; j < 4; ++j) *(GAS f32x8v*)(yw + 512 * j) = v[j];
            }
        } else {
            const bf16* xr = (const bf16*)srcL + (size_t)r * D + 8 * lane_;
#pragma unroll
            for (int j = 0; j < 4; ++j) v[j] = __builtin_convertvector(__builtin_bit_cast(h16x8, *(const GAS v4u*)(xr + 512 * j)), f32x8v);
        }
#pragma unroll
        for (int j = 0; j < 4; ++j) { const f32x8v q = v[j] * v[j]; ss += ((q[0] + q[1]) + (q[2] + q[3])) + ((q[4] + q[5]) + (q[6] + q[7])); }
        const float rstd = __builtin_amdgcn_rsqf(wave_sum(ss) * (1.0f / D) + EPS);
        GAS v4u* o = (GAS v4u*)(XN + (size_t)r * D + 8 * lane_);
#pragma unroll
        for (int j = 0; j < 4; ++j) { const f32x8v y = v[j] * rstd * A[j] + B[j]; v4u w; w.x = pg8::cvt_pk_bf16(y[0], y[1]); w.y = pg8::cvt_pk_bf16(y[2], y[3]); w.z = pg8::cvt_pk_bf16(y[4], y[5]); w.w = pg8::cvt_pk_bf16(y[6], y[7]); o[64 * j] = w; }
    };
    for (int r = gw; r < (M < M_LAT ? M : M_LAT); r += NGW) do_row(r);
    if (M > M_LAT) {
        const int S = NGW >= M_CTX ? NGW / M_CTX : 1;
        if (gw % S == 0) for (int jr = gw / S; jr < M - M_LAT; jr += NGW / S) do_row(M_LAT + jr);
    }
}
__device__ __forceinline__ void ph_final(Frame& F, const bf16* XB, float* out, const float* g) {
    typedef _Float16 h16x8 __attribute__((ext_vector_type(8)));
    typedef float f32x8v __attribute__((ext_vector_type(8)));
    const int gw = F.vcu * NWAVES + F.wave, NGW = F.G * NWAVES, lane_ = mk_lane();
    f32x8v A[4];
#pragma unroll
    for (int j = 0; j < 4; ++j) A[j] = *(const f32x8v*)(g + 8 * lane_ + 512 * j);
    for (int r = gw; r < M_LAT; r += NGW) {
        const bf16* xr = XB + (size_t)r * D + 8 * lane_; float* orow = out + (size_t)r * D + 8 * lane_;
        f32x8v v[4]; float ss = 0.f;
#pragma unroll
        for (int j = 0; j < 4; ++j) { v[j] = __builtin_convertvector(__builtin_bit_cast(h16x8, *(const GAS v4u*)(xr + 512 * j)), f32x8v); const f32x8v q = v[j] * v[j]; ss += ((q[0] + q[1]) + (q[2] + q[3])) + ((q[4] + q[5]) + (q[6] + q[7])); }
        const float rstd = __builtin_amdgcn_rsqf(wave_sum(ss) * (1.0f / D) + EPS);
#pragma unroll
        for (int j = 0; j < 4; ++j) *(GAS f32x8v*)(orow + 512 * j) = v[j] * rstd * A[j];
    }
}
__device__ __forceinline__ void ph_mla_norm(Frame& F, const float* Fm, const float* qn, const float* kvn, const float* rope, bf16* CQ, bf16* CKV, bf16* KPE) {
    const int gw = F.vcu * NWAVES + F.wave, NGW = F.G * NWAVES, lane = mk_lane();
    for (int r = gw; r < M_ALL; r += NGW) {
        const float* fr = Fm + (size_t)r * NDQKV;
        float x[8]; float ss = 0.f;
        if (lane < 56) {
            const pg8::f32x4 a = *(const GAS pg8::f32x4*)(fr + 8 * lane), b = *(const GAS pg8::f32x4*)(fr + 8 * lane + 4);
            x[0] = a.x; x[1] = a.y; x[2] = a.z; x[3] = a.w; x[4] = b.x; x[5] = b.y; x[6] = b.z; x[7] = b.w;
#pragma unroll
            for (int e = 0; e < 8; ++e) ss += x[e] * x[e];
        } else {
#pragma unroll
            for (int e = 0; e < 8; ++e) x[e] = 0.f;
        }
        const float rq = __builtin_amdgcn_rsqf(wave_sum(ss) * (1.0f / QLORA) + EPS);
        {
            float y[8];
#pragma unroll
            for (int e = 0; e < 8; ++e) y[e] = (lane < 56) ? x[e] * rq * qn[8 * lane + e] : 0.f;
            v4u w; w.x = pg8::cvt_pk_bf16(y[0], y[1]); w.y = pg8::cvt_pk_bf16(y[2], y[3]); w.z = pg8::cvt_pk_bf16(y[4], y[5]); w.w = pg8::cvt_pk_bf16(y[6], y[7]);
            *(GAS v4u*)(CQ + (size_t)r * KQ + 8 * lane) = w;
        }
        float z[8]; float s2 = 0.f;
        if (lane < 20) {
            const pg8::f32x4 a = *(const GAS pg8::f32x4*)(fr + QLORA + 8 * lane), b = *(const GAS pg8::f32x4*)(fr + QLORA + 8 * lane + 4);
            z[0] = a.x; z[1] = a.y; z[2] = a.z; z[3] = a.w; z[4] = b.x; z[5] = b.y; z[6] = b.z; z[7] = b.w;
#pragma unroll
            for (int e = 0; e < 8; ++e) s2 += z[e] * z[e];
        } else if (lane >= 32 && lane < 40) {
            const int j = lane - 32;
            const pg8::f32x4 a = *(const GAS pg8::f32x4*)(fr + QLORA + KVLORA + 8 * j), b = *(const GAS pg8::f32x4*)(fr + QLORA + KVLORA + 8 * j + 4);
            z[0] = a.x; z[1] = a.y; z[2] = a.z; z[3] = a.w; z[4] = b.x; z[5] = b.y; z[6] = b.z; z[7] = b.w;
        } else {
#pragma unroll
            for (int e = 0; e < 8; ++e) z[e] = 0.f;
        }
        const float rk = __builtin_amdgcn_rsqf(wave_sum(s2) * (1.0f / KVLORA) + EPS);
        float pz[8];
#pragma unroll
        for (int e = 0; e < 8; ++e) pz[e] = __shfl_xor(z[e], 2);
        if (lane < 32) {
            float y[8];
#pragma unroll
            for (int e = 0; e < 8; ++e) y[e] = (lane < 20) ? z[e] * rk * kvn[8 * lane + e] : 0.f;
            v4u w; w.x = pg8::cvt_pk_bf16(y[0], y[1]); w.y = pg8::cvt_pk_bf16(y[2], y[3]); w.z = pg8::cvt_pk_bf16(y[4], y[5]); w.w = pg8::cvt_pk_bf16(y[6], y[7]);
            *(GAS v4u*)(CKV + (size_t)r * KKV + 8 * lane) = w;
        } else if (lane < 40) {
            const int j = lane - 32;
            float y[8];
            if (r < M_LAT) {
                const int t = r & (SEQ - 1), pos = (j < 4) ? (t >> 6) : (t & 63);
                const float* cp = rope + pos * 16 + 8 * (j & 1); const float* sp = cp + 4096;
                const float sgn = (j & 2) ? 1.f : -1.f;
#pragma unroll
                for (int e = 0; e < 8; ++e) y[e] = z[e] * cp[e] + sgn * pz[e] * sp[e];
            } else {
#pragma unroll
                for (int e = 0; e < 8; ++e) y[e] = z[e];
            }
            v4u w; w.x = pg8::cvt_pk_bf16(y[0], y[1]); w.y = pg8::cvt_pk_bf16(y[2], y[3]); w.z = pg8::cvt_pk_bf16(y[4], y[5]); w.w = pg8::cvt_pk_bf16(y[6], y[7]);
            *(GAS v4u*)(KPE + (size_t)r * 64 + 8 * j) = w;
        }
    }
}

__device__ __forceinline__ s16x4 tr_read_dyn(int addr) { s16x4 r; asm volatile("ds_read_b64_tr_b16 %0, %1" : "=&v"(r) : "v"(addr) : "memory"); return r; }
__device__ __forceinline__ void ph_gm_mix(Frame& F, bf16* U, const bf16* V, const float* stats, const float* lng, const float* lnb, const float* w_s, const float* b_s, bf16* Uout = nullptr) {
    if (Uout == nullptr) Uout = U;
    constexpr int WS_STRIDE = 272, VN_STRIDE = 528, VN_OFF = 128 * WS_STRIDE;
    const int lane = mk_lane(), wave = F.wave, tid = wave * 64 + lane, wp = wave >> 2, wd = wave & 3;
    LAS unsigned char* lw = F.lds; LAS unsigned char* lv = F.lds + VN_OFF;
    const int NU = (M_ALL / 128) * 8;
    for (int un = F.vcu; un < NU; un += F.G) {
        const int c = un >> 3, g = un & 7, R0 = 128 * c, F0 = 256 * g;
        __syncthreads();
        { const float* w = w_s + (size_t)g * 128 * 128;
#pragma unroll
          for (int i = 0; i < 8; ++i) { const int id = tid + 512 * i, p = id >> 5, q4 = (id & 31) * 4; const pg8::f32x4 v = *(const GAS pg8::f32x4*)(w + p * 128 + q4);
              u32x2 o; o.x = pg8::cvt_pk_bf16(v.x, v.y); o.y = pg8::cvt_pk_bf16(v.z, v.w); *(LAS u32x2*)(lw + p * WS_STRIDE + q4 * 2) = o; } }
        { const int dg = tid & 31; const float* gp = lng + F0 + 8 * dg; const float* bp = lnb + F0 + 8 * dg;
          const pg8::f32x4 g0 = *(const pg8::f32x4*)gp, g1 = *(const pg8::f32x4*)(gp + 4), b0 = *(const pg8::f32x4*)bp, b1 = *(const pg8::f32x4*)(bp + 4);
#pragma unroll
          for (int i = 0; i < 8; ++i) { const int q = (tid >> 5) + 16 * i, row = R0 + q;
              const v4u raw = *(const GAS v4u*)(V + (size_t)row * D + F0 + 8 * dg);
              const float s = stats[2 * row], ss = stats[2 * row + 1];
              const float mean = s * (1.0f / D), var = ss * (1.0f / D) - mean * mean, rstd = __builtin_amdgcn_rsqf(var + EPS);
              float x[8];
              x[0] = __uint_as_float(raw.x << 16); x[1] = __uint_as_float(raw.x & 0xffff0000u); x[2] = __uint_as_float(raw.y << 16); x[3] = __uint_as_float(raw.y & 0xffff0000u);
              x[4] = __uint_as_float(raw.z << 16); x[5] = __uint_as_float(raw.z & 0xffff0000u); x[6] = __uint_as_float(raw.w << 16); x[7] = __uint_as_float(raw.w & 0xffff0000u);
              float y[8];
              y[0] = (x[0] - mean) * rstd * g0.x + b0.x; y[1] = (x[1] - mean) * rstd * g0.y + b0.y; y[2] = (x[2] - mean) * rstd * g0.z + b0.z; y[3] = (x[3] - mean) * rstd * g0.w + b0.w;
              y[4] = (x[4] - mean) * rstd * g1.x + b1.x; y[5] = (x[5] - mean) * rstd * g1.y + b1.y; y[6] = (x[6] - mean) * rstd * g1.z + b1.z; y[7] = (x[7] - mean) * rstd * g1.w + b1.w;
              v4u o; o.x = pg8::cvt_pk_bf16(y[0], y[1]); o.y = pg8::cvt_pk_bf16(y[2], y[3]); o.z = pg8::cvt_pk_bf16(y[4], y[5]); o.w = pg8::cvt_pk_bf16(y[6], y[7]);
              *(LAS v4u*)(lv + q * VN_STRIDE + dg * 16) = o; } }
        __syncthreads();
        pg8::f32x4 acc[4][4];
#pragma unroll
        for (int mi = 0; mi < 4; ++mi)
#pragma unroll
            for (int ni = 0; ni < 4; ++ni) acc[mi][ni] = (pg8::f32x4){0.f, 0.f, 0.f, 0.f};
        const int G4 = lane >> 4, i16 = lane & 15, ta = i16 >> 2, tb = i16 & 3;
        const int vbase = (int)(unsigned)(uintptr_t)lv + (8 * G4 + ta) * VN_STRIDE + (wd * 64 + 4 * tb) * 2;
#pragma unroll
        for (int ks = 0; ks < 4; ++ks) {
            pg8::bf16x8 Bw[4], Av[4];
#pragma unroll
            for (int mi = 0; mi < 4; ++mi) Bw[mi] = *(const LAS pg8::bf16x8*)(lw + (wp * 64 + 16 * mi + i16) * WS_STRIDE + (32 * ks + 8 * G4) * 2);
#pragma unroll
            for (int ni = 0; ni < 4; ++ni) { const int ad = vbase + 32 * ks * VN_STRIDE + ni * 32;
                const s16x4 lo = tr_read_dyn(ad), hi = tr_read_dyn(ad + 4 * VN_STRIDE);
                Av[ni] = (pg8::bf16x8){lo[0], lo[1], lo[2], lo[3], hi[0], hi[1], hi[2], hi[3]}; }
            asm volatile("s_waitcnt lgkmcnt(0)" ::: "memory"); __builtin_amdgcn_sched_barrier(0);
#pragma unroll
            for (int mi = 0; mi < 4; ++mi)
#pragma unroll
                for (int ni = 0; ni < 4; ++ni) acc[mi][ni] = __builtin_amdgcn_mfma_f32_16x16x32_bf16(Av[ni], Bw[mi], acc[mi][ni], 0, 0, 0);
        }
        u32x2 uall[4][4];
#pragma unroll
        for (int mi = 0; mi < 4; ++mi)
#pragma unroll
            for (int ni = 0; ni < 4; ++ni) uall[mi][ni] = *(const GAS u32x2*)(U + (size_t)(R0 + wp * 64 + 16 * mi + i16) * D + F0 + wd * 64 + 16 * ni + 4 * G4);
#pragma unroll
        for (int mi = 0; mi < 4; ++mi) {
            const int p = wp * 64 + 16 * mi + i16; const float bias = b_s[g * 128 + p];
#pragma unroll
            for (int ni = 0; ni < 4; ++ni) {
                GAS u32x2* up = (GAS u32x2*)(Uout + (size_t)(R0 + p) * D + F0 + wd * 64 + 16 * ni + 4 * G4);
                const u32x2 uu = uall[mi][ni];
                const float u0 = __uint_as_float(uu.x << 16), u1 = __uint_as_float(uu.x & 0xffff0000u), u2 = __uint_as_float(uu.y << 16), u3 = __uint_as_float(uu.y & 0xffff0000u);
                u32x2 o; o.x = pg8::cvt_pk_bf16(u0 * (acc[mi][ni][0] + bias), u1 * (acc[mi][ni][1] + bias)); o.y = pg8::cvt_pk_bf16(u2 * (acc[mi][ni][2] + bias), u3 * (acc[mi][ni][3] + bias));
                *up = o;
            }
        }
    }
    __syncthreads();
}

namespace att {
constexpr float SCALE = 0.07216878364870322f;
#ifndef ATT_THR
#define ATT_THR 8.f
#endif
constexpr float THR = ATT_THR;
constexpr int NT = (SEQ + CTXL) / 64;
constexpr int NQR = ATT_NQR;
#define SBAR() __builtin_amdgcn_sched_barrier(0)
__device__ __forceinline__ int crow(int r, int hi) { return (r & 3) + 8 * (r >> 2) + 4 * hi; }
__device__ __forceinline__ unsigned cvtpk(float lo, float hi) { unsigned r; asm volatile("v_cvt_pk_bf16_f32 %0, %1, %2" : "=v"(r) : "v"(lo), "v"(hi)); return r; }
__device__ __forceinline__ float sm_rowmax(const f32x16& p0, const f32x16& p1) {
  float pmax = p0[0];
#pragma unroll
  for (int r = 1; r < 16; ++r) pmax = fmaxf(pmax, p0[r]);
#pragma unroll
  for (int r = 0; r < 16; ++r) pmax = fmaxf(pmax, p1[r]);
  auto rr = __builtin_amdgcn_permlane32_swap(__float_as_uint(pmax), __float_as_uint(pmax), false, false);
  return fmaxf(__uint_as_float(rr[0]), __uint_as_float(rr[1]));
}
__device__ __forceinline__ void sm_decide(float pmax, float& m_reg, float& mnC, float& alpha) {
  constexpr float C = SCALE * 1.4426950408889634f;
  const bool grow = (pmax - m_reg) > (THR / SCALE);
  const float mn = grow ? pmax : m_reg;
  const float a = __builtin_amdgcn_exp2f((m_reg - mn) * C);
  alpha = grow ? a : 1.f; m_reg = mn; mnC = -mn * C;
}
__device__ __forceinline__ void sm_scale(f32x16& p, float mnC) {
  constexpr float C = SCALE * 1.4426950408889634f;
#pragma unroll
  for (int r = 0; r < 16; ++r) p[r] = fmaf(p[r], C, mnC);
}
template <int LO, int HI> __device__ __forceinline__ void sm_exp(f32x16& p) {
#pragma unroll
  for (int r = LO; r < HI; ++r) p[r] = __builtin_amdgcn_exp2f(p[r]);
}
__device__ __forceinline__ void partialSM(f32x16& p0, f32x16& p1, float& m_reg, float& alpha) {
  float mnC; const float pm = sm_rowmax(p0, p1); sm_decide(pm, m_reg, mnC, alpha); sm_scale(p0, mnC); sm_scale(p1, mnC); sm_exp<0, 16>(p0);
}
__device__ __forceinline__ void finishSM(f32x16& p0, f32x16& p1, float alpha, float& l_reg, bf16x8& pa0, bf16x8& pa1, bf16x8& pa2, bf16x8& pa3) {
#pragma unroll
  for (int r = 0; r < 16; ++r) p1[r] = __builtin_amdgcn_exp2f(p1[r]);
  float ps = 0;
#pragma unroll
  for (int r = 0; r < 16; ++r) ps += p0[r];
#pragma unroll
  for (int r = 0; r < 16; ++r) ps += p1[r];
  { auto rr = __builtin_amdgcn_permlane32_swap(__float_as_uint(ps), __float_as_uint(ps), false, false);
    ps = __uint_as_float(rr[0]) + __uint_as_float(rr[1]); }
  l_reg = l_reg * alpha + ps;
#define PK4(P, BASE, OUT) do { unsigned a0 = cvtpk(P[BASE + 0], P[BASE + 1]), a1 = cvtpk(P[BASE + 2], P[BASE + 3]);   \
    unsigned b0 = cvtpk(P[BASE + 4], P[BASE + 5]), b1 = cvtpk(P[BASE + 6], P[BASE + 7]);                              \
    auto r0 = __builtin_amdgcn_permlane32_swap(a0, b0, false, false); auto r1 = __builtin_amdgcn_permlane32_swap(a1, b1, false, false); \
    v4u w = {r0[0], r1[0], r0[1], r1[1]}; OUT = *reinterpret_cast<bf16x8*>(&w); } while (0)
  PK4(p0, 0, pa0); PK4(p0, 8, pa1); PK4(p1, 0, pa2); PK4(p1, 8, pa3);
#undef PK4
}
template <int NQ> __device__ __forceinline__ void qkt(f32x16& p0, f32x16& p1, const LAS char* Ks  , const bf16x8 (&qr)[NQ], const LAS char* qpe) {
  p0 = f32x16{}; p1 = f32x16{};
#pragma unroll
  for (int d0 = 0; d0 < 12; ++d0) {
    bf16x8 b0 = *reinterpret_cast<const LAS bf16x8*>(Ks + d0 * 2048);
    bf16x8 b1 = *reinterpret_cast<const LAS bf16x8*>(Ks + d0 * 2048 + 1024);
    bf16x8 q;
    if (d0 < NQ) q = qr[d0]; else q = *reinterpret_cast<const LAS bf16x8*>(qpe + (d0 - NQ) * 1024);
    p0 = __builtin_amdgcn_mfma_f32_32x32x16_bf16(b0, q, p0, 0, 0, 0);
    p1 = __builtin_amdgcn_mfma_f32_32x32x16_bf16(b1, q, p1, 0, 0, 0); }
}
__device__ __forceinline__ int v_st(int k, int c) { const int kk = (k & ~0xC) | ((k & 4) << 1) | ((k & 8) >> 1); return ((kk >> 3) * 4 + (c >> 5)) * 512 + ((kk & 7) * 32 + (c & 31)) * 2; }
__device__ __forceinline__ int v_rd_base(int lane) { return ((lane & 3) << 3) | (((lane >> 2) & 3) << 6) | (((lane >> 4) & 1) << 5) | (((lane >> 5) & 1) << 8); }
constexpr int v_rd_off(int d0, int ks, int half) { return d0 * 512 + ks * 4096 + half * 2048; }
template <int OFF> __device__ __forceinline__ s16x4 tr_read(int vb) {
  s16x4 r; asm volatile("ds_read_b64_tr_b16 %0, %1 offset:%2" : "=&v"(r) : "v"(vb), "i"(OFF) : "memory"); return r;
}
template <int D0> __device__ __forceinline__ void pv_one(f32x16& od, int vb, bf16x8 pa0, bf16x8 pa1, bf16x8 pa2, bf16x8 pa3) {
  const s16x4 l0 = tr_read<v_rd_off(D0, 0, 0)>(vb), h0 = tr_read<v_rd_off(D0, 0, 1)>(vb), l1 = tr_read<v_rd_off(D0, 1, 0)>(vb), h1 = tr_read<v_rd_off(D0, 1, 1)>(vb);
  const s16x4 l2 = tr_read<v_rd_off(D0, 2, 0)>(vb), h2 = tr_read<v_rd_off(D0, 2, 1)>(vb), l3 = tr_read<v_rd_off(D0, 3, 0)>(vb), h3 = tr_read<v_rd_off(D0, 3, 1)>(vb);
  asm volatile("s_waitcnt lgkmcnt(0)" ::: "memory"); SBAR();
#define PK(L, H) (bf16x8){L[0], L[1], L[2], L[3], H[0], H[1], H[2], H[3]}
  od = __builtin_amdgcn_mfma_f32_32x32x16_bf16(pa0, PK(l0, h0), od, 0, 0, 0);
  od = __builtin_amdgcn_mfma_f32_32x32x16_bf16(pa1, PK(l1, h1), od, 0, 0, 0);
  od = __builtin_amdgcn_mfma_f32_32x32x16_bf16(pa2, PK(l2, h2), od, 0, 0, 0);
  od = __builtin_amdgcn_mfma_f32_32x32x16_bf16(pa3, PK(l3, h3), od, 0, 0, 0);
#undef PK
}
__device__ __forceinline__ void pv_d0(f32x16 (&o)[4], int vb, bf16x8 pa0, bf16x8 pa1, bf16x8 pa2, bf16x8 pa3) {
  pv_one<0>(o[0], vb, pa0, pa1, pa2, pa3); pv_one<1>(o[1], vb, pa0, pa1, pa2, pa3); pv_one<2>(o[2], vb, pa0, pa1, pa2, pa3); pv_one<3>(o[3], vb, pa0, pa1, pa2, pa3);
}
__device__ __forceinline__ void pv_sm(f32x16 (&o)[4], int vb, bf16x8 pa0, bf16x8 pa1, bf16x8 pa2, bf16x8 pa3, f32x16& pX0, f32x16& pX1, float& m_reg, float& alpha) {
  float mnC;
  pv_one<0>(o[0], vb, pa0, pa1, pa2, pa3); const float pm = sm_rowmax(pX0, pX1);
  pv_one<1>(o[1], vb, pa0, pa1, pa2, pa3); sm_decide(pm, m_reg, mnC, alpha); sm_scale(pX0, mnC);
  pv_one<2>(o[2], vb, pa0, pa1, pa2, pa3); sm_scale(pX1, mnC); sm_exp<0, 8>(pX0);
  pv_one<3>(o[3], vb, pa0, pa1, pa2, pa3); sm_exp<8, 16>(pX0);
}
#define KREAD(a, b, d0) asm volatile("ds_read_b128 %0, %2 offset:%3\n\tds_read_b128 %1, %2 offset:%4" : "=&v"(a), "=&v"(b) : "v"(kaddr), "i"((d0) * 2048), "i"((d0) * 2048 + 1024))
#define KWAIT(n, a, b) asm volatile("s_waitcnt lgkmcnt(" #n ")" : "+v"(a), "+v"(b))
__device__ __forceinline__ void qkt2(f32x16& p0, f32x16& p1, int kaddr, const bf16x8 (&qr)[12], const f32x16& cinit) {
  p0 = cinit; p1 = cinit;
#if ATT_KDEPTH == 2
  bf16x8 ka0, ka1, kb0, kb1, kc0, kc1;
  KREAD(ka0, ka1, 0); KREAD(kb0, kb1, 1);
#define KSTEP(x0, x1, d0) do { if ((d0) + 2 < 12) { KWAIT(4, x0, x1); } else if ((d0) + 1 < 12) { KWAIT(2, x0, x1); } else { KWAIT(0, x0, x1); } \
    p0 = __builtin_amdgcn_mfma_f32_32x32x16_bf16(x0, qr[d0], p0, 0, 0, 0); p1 = __builtin_amdgcn_mfma_f32_32x32x16_bf16(x1, qr[d0], p1, 0, 0, 0); } while (0)
#pragma unroll
  for (int d0 = 0; d0 < 12; d0 += 3) {
    KREAD(kc0, kc1, d0 + 2); KSTEP(ka0, ka1, d0);
    if (d0 + 3 < 12) KREAD(ka0, ka1, d0 + 3);
    KSTEP(kb0, kb1, d0 + 1);
    if (d0 + 4 < 12) KREAD(kb0, kb1, d0 + 4);
    KSTEP(kc0, kc1, d0 + 2);
  }
#undef KSTEP
#else
  bf16x8 ka0, ka1, kb0, kb1;
  KREAD(ka0, ka1, 0);
#pragma unroll
  for (int d0 = 0; d0 < 12; d0 += 2) {
    KREAD(kb0, kb1, d0 + 1); KWAIT(2, ka0, ka1);
    p0 = __builtin_amdgcn_mfma_f32_32x32x16_bf16(ka0, qr[d0], p0, 0, 0, 0); p1 = __builtin_amdgcn_mfma_f32_32x32x16_bf16(ka1, qr[d0], p1, 0, 0, 0);
    if (d0 + 2 < 12) { KREAD(ka0, ka1, d0 + 2); KWAIT(2, kb0, kb1); } else { KWAIT(0, kb0, kb1); }
    p0 = __builtin_amdgcn_mfma_f32_32x32x16_bf16(kb0, qr[d0 + 1], p0, 0, 0, 0); p1 = __builtin_amdgcn_mfma_f32_32x32x16_bf16(kb1, qr[d0 + 1], p1, 0, 0, 0);
  }
#endif
}
#undef KREAD
#undef KWAIT
template <int D0> __device__ __forceinline__ void pv_reads(s16x4 (&t)[8], int vb) {
  t[0] = tr_read<v_rd_off(D0, 0, 0)>(vb); t[1] = tr_read<v_rd_off(D0, 0, 1)>(vb); t[2] = tr_read<v_rd_off(D0, 1, 0)>(vb); t[3] = tr_read<v_rd_off(D0, 1, 1)>(vb);
  t[4] = tr_read<v_rd_off(D0, 2, 0)>(vb); t[5] = tr_read<v_rd_off(D0, 2, 1)>(vb); t[6] = tr_read<v_rd_off(D0, 3, 0)>(vb); t[7] = tr_read<v_rd_off(D0, 3, 1)>(vb);
}
__device__ __forceinline__ void pv_mma(f32x16& od, const s16x4 (&t)[8], bf16x8 pa0, bf16x8 pa1, bf16x8 pa2, bf16x8 pa3) {
#define PK(L, H) (bf16x8){L[0], L[1], L[2], L[3], H[0], H[1], H[2], H[3]}
  od = __builtin_amdgcn_mfma_f32_32x32x16_bf16(pa0, PK(t[0], t[1]), od, 0, 0, 0);
  od = __builtin_amdgcn_mfma_f32_32x32x16_bf16(pa1, PK(t[2], t[3]), od, 0, 0, 0);
  od = __builtin_amdgcn_mfma_f32_32x32x16_bf16(pa2, PK(t[4], t[5]), od, 0, 0, 0);
  od = __builtin_amdgcn_mfma_f32_32x32x16_bf16(pa3, PK(t[6], t[7]), od, 0, 0, 0);
#undef PK
}
#define PVW(n) do { asm volatile("s_waitcnt lgkmcnt(" #n ")" ::: "memory"); SBAR(); } while (0)
__device__ __forceinline__ void pv_sm2(f32x16 (&o)[4], int vb, bf16x8 pa0, bf16x8 pa1, bf16x8 pa2, bf16x8 pa3, f32x16& pX0, f32x16& pX1, float& m_reg, float& alpha) {
  float mnC; s16x4 ta[8], tb[8];
  pv_reads<0>(ta, vb);
  pv_reads<1>(tb, vb); PVW(8); pv_mma(o[0], ta, pa0, pa1, pa2, pa3); float pm = sm_rowmax(pX0, pX1); asm volatile("" : "+v"(pm));
  pv_reads<2>(ta, vb); PVW(8); pv_mma(o[1], tb, pa0, pa1, pa2, pa3); sm_decide(pm, m_reg, mnC, alpha); sm_scale(pX0, mnC); asm volatile("" : "+v"(pX0));
  pv_reads<3>(tb, vb); PVW(8); pv_mma(o[2], ta, pa0, pa1, pa2, pa3); sm_scale(pX1, mnC); sm_exp<0, 8>(pX0); asm volatile("" : "+v"(pX0), "+v"(pX1));
  PVW(0); pv_mma(o[3], tb, pa0, pa1, pa2, pa3); sm_exp<8, 16>(pX0); asm volatile("" : "+v"(pX0));
}
__device__ __forceinline__ void pv_sm3(f32x16 (&o)[4], int vb, bf16x8 pa0, bf16x8 pa1, bf16x8 pa2, bf16x8 pa3, f32x16& pX0, f32x16& pX1, float& m_reg, float& alpha, s16x4 (&ta)[8]) {
  float mnC; s16x4 tb[8];
  pv_reads<1>(tb, vb); PVW(8); pv_mma(o[0], ta, pa0, pa1, pa2, pa3); float pm = sm_rowmax(pX0, pX1); asm volatile("" : "+v"(pm));
  pv_reads<2>(ta, vb); PVW(8); pv_mma(o[1], tb, pa0, pa1, pa2, pa3); sm_decide(pm, m_reg, mnC, alpha); sm_scale(pX0, mnC); asm volatile("" : "+v"(pX0));
  pv_reads<3>(tb, vb); PVW(8); pv_mma(o[2], ta, pa0, pa1, pa2, pa3); sm_scale(pX1, mnC); sm_exp<0, 8>(pX0); asm volatile("" : "+v"(pX0), "+v"(pX1));
  PVW(0); pv_mma(o[3], tb, pa0, pa1, pa2, pa3); sm_exp<8, 16>(pX0); asm volatile("" : "+v"(pX0));
}
constexpr float THRL = THR * 1.4426950408889634f;
__device__ __forceinline__ void sm_grow(float pm, f32x16& p0, f32x16& p1, float& m_reg, float& alpha, f32x16& negm) {
  const bool grow = pm > THRL;
  alpha = 1.f;
  if (__any(grow)) {
    const float dl = grow ? pm : 0.f;
#pragma unroll
    for (int r = 0; r < 16; ++r) { p0[r] -= dl; p1[r] -= dl; }
    m_reg += dl; alpha = __builtin_amdgcn_exp2f(-dl);
    const float nm = -m_reg;
#pragma unroll
    for (int r = 0; r < 16; ++r) negm[r] = nm;
  }
}
__device__ __forceinline__ void pv_sm4(f32x16 (&o)[4], int vb, bf16x8 pa0, bf16x8 pa1, bf16x8 pa2, bf16x8 pa3, f32x16& pX0, f32x16& pX1, float& m_reg, float& alpha, f32x16& negm) {
  s16x4 ta[8], tb[8];
  pv_reads<0>(ta, vb);
  pv_reads<1>(tb, vb); PVW(8); pv_mma(o[0], ta, pa0, pa1, pa2, pa3); float pm = sm_rowmax(pX0, pX1); asm volatile("" : "+v"(pm));
  pv_reads<2>(ta, vb); PVW(8); pv_mma(o[1], tb, pa0, pa1, pa2, pa3); sm_grow(pm, pX0, pX1, m_reg, alpha, negm); sm_exp<0, 6>(pX0); asm volatile("" : "+v"(pX0));
  pv_reads<3>(tb, vb); PVW(8); pv_mma(o[2], ta, pa0, pa1, pa2, pa3); sm_exp<6, 12>(pX0); asm volatile("" : "+v"(pX0));
  PVW(0); pv_mma(o[3], tb, pa0, pa1, pa2, pa3); sm_exp<12, 16>(pX0); asm volatile("" : "+v"(pX0));
}
__device__ __forceinline__ void pv_sm5(f32x16 (&o)[4], int vb, bf16x8 pa0, bf16x8 pa1, bf16x8 pa2, bf16x8 pa3, f32x16& pX0, f32x16& pX1, float& m_reg, float& alpha, f32x16& negm, s16x4 (&ta)[8]) {
  s16x4 tb[8];
  pv_reads<1>(tb, vb); PVW(8); pv_mma(o[0], ta, pa0, pa1, pa2, pa3); float pm = sm_rowmax(pX0, pX1); asm volatile("" : "+v"(pm));
  pv_reads<2>(ta, vb); PVW(8); pv_mma(o[1], tb, pa0, pa1, pa2, pa3); sm_grow(pm, pX0, pX1, m_reg, alpha, negm); sm_exp<0, 6>(pX0); asm volatile("" : "+v"(pX0));
  pv_reads<3>(tb, vb); PVW(8); pv_mma(o[2], ta, pa0, pa1, pa2, pa3); sm_exp<6, 12>(pX0); asm volatile("" : "+v"(pX0));
  PVW(0); pv_mma(o[3], tb, pa0, pa1, pa2, pa3); sm_exp<12, 16>(pX0); asm volatile("" : "+v"(pX0));
}
__device__ __forceinline__ void pv_d02(f32x16 (&o)[4], int vb, bf16x8 pa0, bf16x8 pa1, bf16x8 pa2, bf16x8 pa3) {
  s16x4 ta[8], tb[8];
  pv_reads<0>(ta, vb);
  pv_reads<1>(tb, vb); PVW(8); pv_mma(o[0], ta, pa0, pa1, pa2, pa3);
  pv_reads<2>(ta, vb); PVW(8); pv_mma(o[1], tb, pa0, pa1, pa2, pa3);
  pv_reads<3>(tb, vb); PVW(8); pv_mma(o[2], ta, pa0, pa1, pa2, pa3);
  PVW(0); pv_mma(o[3], tb, pa0, pa1, pa2, pa3);
}
__device__ __forceinline__ int krow(int j, int b) { return j < 256 ? b * SEQ + 64 * j : M_LAT + b * CTXL + 64 * (j - 256); }

__device__ __forceinline__ void attn_unit(const bf16* __restrict__ Qb, const bf16* __restrict__ KNh, const bf16* __restrict__ KPE, const bf16* __restrict__ Vh, bf16* __restrict__ Ob, int b, LAS char* lds) {
  int tid_l = threadIdx.x; asm volatile("" : "+v"(tid_l));
  const int tid = tid_l, wid = __builtin_amdgcn_readfirstlane(tid >> 6), lane = tid & 63, r32 = lane & 31, hi = lane >> 5;
  LAS char* V_lds = lds; LAS char* K_lds = lds + ATT_OFF_K;
  LAS float* wsf = (LAS float*)(lds + ATT_OFF_WS) + wid * 64; LAS float* li_l = wsf; LAS float* al_l = wsf + 32;
  LAS char* ost = lds + ATT_OFF_OST + wid * 8192;
  LAS char* qpe = lds + ATT_OFF_QPE + wid * ((12 - NQR) * 1024) + lane * 16;
  float m_reg = -1e30f, l_reg = 0; f32x16 o[4] = {}; bf16x8 qr[NQR];
  const bf16* Qw = Qb + (size_t)(wid * 32 + r32) * 3072 + hi * 8;
#pragma unroll
  for (int d0 = 0; d0 < NQR; ++d0) qr[d0] = *reinterpret_cast<const bf16x8*>(Qw + d0 * 16);
#pragma unroll
  for (int d0 = NQR; d0 < 12; ++d0) *reinterpret_cast<LAS bf16x8*>(qpe + (d0 - NQR) * 1024) = *reinterpret_cast<const bf16x8*>(Qw + d0 * 16);
  const int sr = tid >> 4, sc = (tid & 15) * 8, vst0 = v_st(sr, sc), vst1 = v_st(32 + sr, sc);
  const int khalf = lane & 1, krl = (lane >> 1) & 3, kc8 = (lane >> 3) & 7, kswz = wid & 1;
  const int krow0 = 8 * wid + krl, krow1 = krow0 + 4, kcol = kc8 * 16 + khalf * 8;
  const int kst0 = kc8 * 2048 + krow0 * 32 + ((khalf ^ kswz) * 16), kst1 = kst0 + 128;
  const int prow = 8 * wid + 4 * (lane >> 5) + krl, pcol = ((lane >> 3) & 3) * 16 + khalf * 8, kst2 = (8 + ((lane >> 3) & 3)) * 2048 + prow * 32 + ((khalf ^ kswz) * 16);
  const LAS char* krd = K_lds + r32 * 32 + ((hi ^ ((r32 >> 3) & 1)) * 16);
  const int vb0 = (int)(unsigned)(uintptr_t)V_lds + v_rd_base(lane);
  bf16x8 vs0, vs1, ks0, ks1, kp;
  const unsigned ovs0 = (unsigned)(sr * D + sc) * 2u, okn0 = (unsigned)(krow0 * D + kcol) * 2u, okp = (unsigned)(prow * 64 + pcol) * 2u;
#define SLOAD(j) do { const unsigned rb_ = (unsigned)krow((j), b), rv_ = rb_ * (unsigned)(D * 2), rp_ = rb_ * 128u; \
    vs0 = *reinterpret_cast<const bf16x8*>(reinterpret_cast<const char*>(Vh) + (size_t)(rv_ + ovs0)); vs1 = *reinterpret_cast<const bf16x8*>(reinterpret_cast<const char*>(Vh) + (size_t)(rv_ + ovs0 + 32u * D * 2u)); \
    ks0 = *reinterpret_cast<const bf16x8*>(reinterpret_cast<const char*>(KNh) + (size_t)(rv_ + okn0)); ks1 = *reinterpret_cast<const bf16x8*>(reinterpret_cast<const char*>(KNh) + (size_t)(rv_ + okn0 + 4u * D * 2u)); \
    kp = *reinterpret_cast<const bf16x8*>(reinterpret_cast<const char*>(KPE) + (size_t)(rp_ + okp)); } while (0)
#define SWRITE(bb) do { *(LAS bf16x8*)(V_lds + (bb) * ATT_SHM_V + vst0) = vs0; *(LAS bf16x8*)(V_lds + (bb) * ATT_SHM_V + vst1) = vs1; \
    *(LAS bf16x8*)(K_lds + (bb) * ATT_SHM_K + kst0) = ks0; *(LAS bf16x8*)(K_lds + (bb) * ATT_SHM_K + kst1) = ks1; *(LAS bf16x8*)(K_lds + (bb) * ATT_SHM_K + kst2) = kp; } while (0)
#define SWAIT() asm volatile("s_waitcnt vmcnt(0)" ::: "memory")
#define RESC(a) do { if (__any((a) < 1.f)) { if (hi == 0) al_l[r32] = (a); asm volatile("s_waitcnt lgkmcnt(0)" ::: "memory"); \
    _Pragma("unroll") for (int d = 0; d < 4; ++d) _Pragma("unroll") for (int r = 0; r < 16; ++r) o[d][r] *= al_l[crow(r, hi)]; } } while (0)
  f32x16 pA0, pA1, pB0, pB1; float alA, alB; bf16x8 pa0, pa1, pa2, pa3;
  SLOAD(0); SWAIT(); SWRITE(0); __syncthreads();
  qkt<NQR>(pA0, pA1, krd, qr, qpe); partialSM(pA0, pA1, m_reg, alA);
  SLOAD(1);
  SWAIT(); SWRITE(1); __syncthreads();
  for (int j = 1; j + 1 < NT; j += 2) {
    SBAR(); qkt<NQR>(pB0, pB1, krd + ATT_SHM_K, qr, qpe);
    finishSM(pA0, pA1, alA, l_reg, pa0, pa1, pa2, pa3); SBAR();
    SLOAD(j + 1); SBAR();
    pv_sm(o, vb0, pa0, pa1, pa2, pa3, pB0, pB1, m_reg, alB);
    __syncthreads(); SWAIT(); SWRITE(0);
    RESC(alB); __syncthreads();
    SBAR(); qkt<NQR>(pA0, pA1, krd, qr, qpe);
    finishSM(pB0, pB1, alB, l_reg, pa0, pa1, pa2, pa3); SBAR();
    SLOAD(j + 2); SBAR();
    pv_sm(o, vb0 + ATT_SHM_V, pa0, pa1, pa2, pa3, pA0, pA1, m_reg, alA);
    __syncthreads(); SWAIT(); SWRITE(1);
    RESC(alA); __syncthreads();
  }
  SBAR(); qkt<NQR>(pB0, pB1, krd + ATT_SHM_K, qr, qpe);
  finishSM(pA0, pA1, alA, l_reg, pa0, pa1, pa2, pa3); SBAR();
  pv_sm(o, vb0, pa0, pa1, pa2, pa3, pB0, pB1, m_reg, alB);
  __syncthreads(); RESC(alB);
  finishSM(pB0, pB1, alB, l_reg, pa0, pa1, pa2, pa3); SBAR();
  pv_d0(o, vb0 + ATT_SHM_V, pa0, pa1, pa2, pa3);
  __syncthreads();
  if (hi == 0) li_l[r32] = l_reg; asm volatile("s_waitcnt lgkmcnt(0)" ::: "memory");
#pragma unroll
  for (int r = 0; r < 16; ++r) { const int orow = crow(r, hi); const float rl = __builtin_amdgcn_rcpf(li_l[orow]);
#pragma unroll
    for (int d0 = 0; d0 < 4; ++d0) *(LAS unsigned short*)(ost + orow * 256 + (d0 * 32 + r32) * 2) = (unsigned short)f2bf(o[d0][r] * rl); }
  asm volatile("s_waitcnt lgkmcnt(0)" ::: "memory");
#pragma unroll
  for (int i = 0; i < 8; ++i) { const int gidx = i * 64 + lane, row = gidx >> 4, cg = gidx & 15;
    const v4u v = *(const LAS v4u*)(ost + row * 256 + cg * 16);
    *(GAS v4u*)(Ob + (size_t)(wid * 32 + row) * D + cg * 8) = v; }
  __syncthreads();
#undef SLOAD
#undef SWRITE
#undef SWAIT
#undef RESC
}

#ifndef ATT_KDEPTH
#define ATT_KDEPTH 2
#endif
#ifndef ATT_EARLYTR
#define ATT_EARLYTR 0
#endif
#ifndef ATT_QKPIPE
#define ATT_QKPIPE 1
#endif
#ifndef ATT_PVPIPE
#define ATT_PVPIPE 1
#endif
#if ATT_PVPIPE
#define PVSM pv_sm2
#define PVD0 pv_d02
#else
#define PVSM pv_sm
#define PVD0 pv_d0
#endif
constexpr int DBUF = 40960, DOFF_K = 16384, DOFF_WS = 3 * DBUF, DOFF_QPE = DOFF_WS + NWAVES * 256, NQD = ATT_NQD;
static_assert(DOFF_QPE + NWAVES * (12 - NQD) * 1024 <= MISC_OFF, "attention (DMA variant) LDS map");

template <int S> __device__ __forceinline__ pg8::f32x4 sub_get(const f32x16& v) { return __builtin_shufflevector(v, v, 4 * S, 4 * S + 1, 4 * S + 2, 4 * S + 3); }
template <int S> __device__ __forceinline__ void sub_put(f32x16& v, pg8::f32x4 x) {
  const f32x16 w = __builtin_shufflevector(x, x, 0, 1, 2, 3, -1, -1, -1, -1, -1, -1, -1, -1, -1, -1, -1, -1);
  if constexpr (S == 0) v = __builtin_shufflevector(v, w, 16, 17, 18, 19, 4, 5, 6, 7, 8, 9, 10, 11, 12, 13, 14, 15);
  else if constexpr (S == 1) v = __builtin_shufflevector(v, w, 0, 1, 2, 3, 16, 17, 18, 19, 8, 9, 10, 11, 12, 13, 14, 15);
  else if constexpr (S == 2) v = __builtin_shufflevector(v, w, 0, 1, 2, 3, 4, 5, 6, 7, 16, 17, 18, 19, 12, 13, 14, 15);
  else v = __builtin_shufflevector(v, w, 0, 1, 2, 3, 4, 5, 6, 7, 8, 9, 10, 11, 16, 17, 18, 19);
}
#define M16(v, S, A, B) sub_put<S>(v, __builtin_amdgcn_mfma_f32_16x16x32_bf16(A, B, sub_get<S>(v), 0, 0, 0))
#define MKREAD(a, b, d0) asm volatile("ds_read_b128 %0, %2 offset:%3\n\tds_read_b128 %1, %2 offset:%4" : "=&v"(a), "=&v"(b) : "v"(kaddr), "i"((d0) * 2048), "i"((d0) * 2048 + 1024))
#define MKWAIT(n, a, b) asm volatile("s_waitcnt lgkmcnt(" #n ")" : "+v"(a), "+v"(b))
__device__ __forceinline__ void qkt16_mock(f32x16& p0, f32x16& p1, int kaddr, const bf16x8 (&qr)[12], const f32x16& cinit) {
  p0 = cinit; p1 = cinit;
  bf16x8 ka0, ka1, kb0, kb1;
  MKREAD(ka0, ka1, 0);
#pragma unroll
  for (int d0 = 0; d0 < 12; d0 += 2) {
    MKREAD(kb0, kb1, d0 + 1); MKWAIT(2, ka0, ka1);
    M16(p0, 0, ka0, qr[d0 % 6]); M16(p0, 1, ka1, qr[d0 % 6]); M16(p1, 0, ka0, qr[(d0 + 1) % 6]); M16(p1, 1, ka1, qr[(d0 + 1) % 6]);
    if (d0 + 2 < 12) { MKREAD(ka0, ka1, d0 + 2); MKWAIT(2, kb0, kb1); } else { MKWAIT(0, kb0, kb1); }
    M16(p0, 2, kb0, qr[(d0 + 1) % 6]); M16(p0, 3, kb1, qr[(d0 + 1) % 6]); M16(p1, 2, kb0, qr[d0 % 6]); M16(p1, 3, kb1, qr[d0 % 6]);
  }
}
#undef MKREAD
#undef MKWAIT
__device__ __forceinline__ void pv_mma16_mock(f32x16& od, const s16x4 (&t)[8], bf16x8 pa0, bf16x8 pa1, bf16x8 pa2, bf16x8 pa3) {
#define PK(L, H) (bf16x8){L[0], L[1], L[2], L[3], H[0], H[1], H[2], H[3]}
  M16(od, 0, pa0, PK(t[0], t[1])); M16(od, 1, pa0, PK(t[0], t[1])); M16(od, 2, pa1, PK(t[2], t[3])); M16(od, 3, pa1, PK(t[2], t[3]));
  M16(od, 0, pa2, PK(t[4], t[5])); M16(od, 1, pa2, PK(t[4], t[5])); M16(od, 2, pa3, PK(t[6], t[7])); M16(od, 3, pa3, PK(t[6], t[7]));
#undef PK
}
#undef M16
__device__ __forceinline__ void pv_sm4_mock(f32x16 (&o)[4], int vb, bf16x8 pa0, bf16x8 pa1, bf16x8 pa2, bf16x8 pa3, f32x16& pX0, f32x16& pX1, float& m_reg, float& alpha, f32x16& negm) {
  s16x4 ta[8], tb[8];
  pv_reads<0>(ta, vb);
  pv_reads<1>(tb, vb); PVW(8); pv_mma16_mock(o[0], ta, pa0, pa1, pa2, pa3); float pm = sm_rowmax(pX0, pX1); asm volatile("" : "+v"(pm));
  pv_reads<2>(ta, vb); PVW(8); pv_mma16_mock(o[1], tb, pa0, pa1, pa2, pa3); sm_grow(pm, pX0, pX1, m_reg, alpha, negm); sm_exp<0, 6>(pX0); asm volatile("" : "+v"(pX0));
  pv_reads<3>(tb, vb); PVW(8); pv_mma16_mock(o[2], ta, pa0, pa1, pa2, pa3); sm_exp<6, 12>(pX0); asm volatile("" : "+v"(pX0));
  PVW(0); pv_mma16_mock(o[3], tb, pa0, pa1, pa2, pa3); sm_exp<12, 16>(pX0); asm volatile("" : "+v"(pX0));
}
__device__ __forceinline__ void fsm_raw(f32x16& p0, f32x16& p1, bf16x8& pa0, bf16x8& pa1, bf16x8& pa2, bf16x8& pa3) {
  v4u w0 = {__float_as_uint(p0[0]), __float_as_uint(p0[1]), __float_as_uint(p0[2]), __float_as_uint(p0[3])}, w1 = {__float_as_uint(p0[8]), __float_as_uint(p0[9]), __float_as_uint(p0[10]), __float_as_uint(p0[15])};
  v4u w2 = {__float_as_uint(p1[0]), __float_as_uint(p1[1]), __float_as_uint(p1[2]), __float_as_uint(p1[3])}, w3 = {__float_as_uint(p1[8]), __float_as_uint(p1[9]), __float_as_uint(p1[10]), __float_as_uint(p1[15])};
  pa0 = *reinterpret_cast<bf16x8*>(&w0); pa1 = *reinterpret_cast<bf16x8*>(&w1); pa2 = *reinterpret_cast<bf16x8*>(&w2); pa3 = *reinterpret_cast<bf16x8*>(&w3);
}
__device__ __forceinline__ void qkt_noread(f32x16& p0, f32x16& p1, const bf16x8 (&qr)[12], const f32x16& cinit) {
  p0 = cinit; p1 = cinit;
#pragma unroll
  for (int d0 = 0; d0 < 12; ++d0) { p0 = __builtin_amdgcn_mfma_f32_32x32x16_bf16(qr[(d0 + 1) % 12], qr[d0], p0, 0, 0, 0); p1 = __builtin_amdgcn_mfma_f32_32x32x16_bf16(qr[(d0 + 2) % 12], qr[d0], p1, 0, 0, 0); }
}
__device__ __forceinline__ void qkt_nomma(f32x16& p0, f32x16& p1, int kaddr, const bf16x8 (&qr)[12], const f32x16& cinit) {
  p0 = cinit; p1 = cinit;
#pragma unroll
  for (int d0 = 0; d0 < 12; ++d0) { bf16x8 a, b2;
    asm volatile("ds_read_b128 %0, %2 offset:%3\n\tds_read_b128 %1, %2 offset:%4\n\ts_waitcnt lgkmcnt(0)" : "=&v"(a), "=&v"(b2) : "v"(kaddr), "i"(d0 * 2048), "i"(d0 * 2048 + 1024));
    p0[d0] += (float)a[0]; p1[d0] += (float)b2[0]; }
}
__device__ __forceinline__ void pv_sm4_noread(f32x16 (&o)[4], bf16x8 pa0, bf16x8 pa1, bf16x8 pa2, bf16x8 pa3, f32x16& pX0, f32x16& pX1, float& m_reg, float& alpha, f32x16& negm) {
#define PVM(od) do { od = __builtin_amdgcn_mfma_f32_32x32x16_bf16(pa0, pa1, od, 0, 0, 0); od = __builtin_amdgcn_mfma_f32_32x32x16_bf16(pa1, pa2, od, 0, 0, 0); od = __builtin_amdgcn_mfma_f32_32x32x16_bf16(pa2, pa3, od, 0, 0, 0); od = __builtin_amdgcn_mfma_f32_32x32x16_bf16(pa3, pa0, od, 0, 0, 0); } while (0)
  PVM(o[0]); float pm = sm_rowmax(pX0, pX1); asm volatile("" : "+v"(pm));
  PVM(o[1]); sm_grow(pm, pX0, pX1, m_reg, alpha, negm); sm_exp<0, 6>(pX0); asm volatile("" : "+v"(pX0));
  PVM(o[2]); sm_exp<6, 12>(pX0); asm volatile("" : "+v"(pX0));
  PVM(o[3]); sm_exp<12, 16>(pX0); asm volatile("" : "+v"(pX0));
#undef PVM
}
template <int ABL = 0> __device__ __forceinline__ void attn_unit_dma(const bf16* __restrict__ Qb, const bf16* __restrict__ KNh, const bf16* __restrict__ KPE, const bf16* __restrict__ Vh, bf16* __restrict__ Ob, int b, LAS char* lds) {
  int tid_l = threadIdx.x; asm volatile("" : "+v"(tid_l));
  const int tid = tid_l, wid = __builtin_amdgcn_readfirstlane(tid >> 6), lane = tid & 63, r32 = lane & 31, hi = lane >> 5;
  LAS float* wsf = (LAS float*)(lds + DOFF_WS) + wid * 64; LAS float* li_l = wsf; LAS float* al_l = wsf + 32;
  LAS char* ost = lds + wid * 8192;
  LAS char* qpe = lds + DOFF_QPE + wid * ((12 - NQD) * 1024) + lane * 16;
  float m_reg = -1e30f, l_reg = 0; f32x16 o[4] = {}; bf16x8 qr[NQD];
  const bf16* Qw = Qb + (size_t)(wid * 32 + r32) * 3072 + hi * 8;
#pragma unroll
  for (int d0 = 0; d0 < NQD; ++d0) qr[d0] = *reinterpret_cast<const bf16x8*>(Qw + d0 * 16);
#pragma unroll
  for (int d0 = NQD; d0 < 12; ++d0) *reinterpret_cast<LAS bf16x8*>(qpe + (d0 - NQD) * 1024) = *reinterpret_cast<const bf16x8*>(Qw + d0 * 16);
  unsigned ovs, okn, okp;
  { const int kk = 8 * (wid >> 1) + ((lane & 31) >> 2), k = (kk & ~0xC) | ((kk & 4) << 1) | ((kk & 8) >> 1), col = 32 * (2 * (wid & 1) + (lane >> 5)) + 8 * (lane & 3);
    ovs = (unsigned)(k * D + col) * 2u;
    const int row = 32 * (wid & 1) + (lane >> 1), half = (lane & 1) ^ ((row >> 3) & 1);
    okn = (unsigned)(row * D + (wid >> 1) * 16 + half * 8) * 2u; okp = (unsigned)(row * 64 + (wid >> 1) * 16 + half * 8) * 2u; }
  const int krd0 = r32 * 32 + ((hi ^ ((r32 >> 3) & 1)) * 16) + DOFF_K;
  const int vrd0 = (int)(unsigned)(uintptr_t)lds + v_rd_base(lane);
#define DMA_TILE(j, boff) do { const unsigned rb_ = (unsigned)krow((j), b), rv_ = rb_ * (unsigned)(D * 2), rp_ = rb_ * 128u; LAS char* d_ = lds + (boff) + wid * 1024; \
    __builtin_amdgcn_global_load_lds((const unsigned*)(reinterpret_cast<const char*>(Vh) + (size_t)(rv_ + ovs)), (LAS unsigned*)d_, 16, 0, 0); \
    __builtin_amdgcn_global_load_lds((const unsigned*)(reinterpret_cast<const char*>(Vh) + (size_t)(rv_ + ovs + 32u * D * 2u)), (LAS unsigned*)(d_ + 8192), 16, 0, 0); \
    __builtin_amdgcn_global_load_lds((const unsigned*)(reinterpret_cast<const char*>(KNh) + (size_t)(rv_ + okn)), (LAS unsigned*)(d_ + DOFF_K), 16, 0, 0); \
    __builtin_amdgcn_global_load_lds((const unsigned*)(reinterpret_cast<const char*>(KNh) + (size_t)(rv_ + okn + 128u)), (LAS unsigned*)(d_ + DOFF_K + 8192), 16, 0, 0); \
    __builtin_amdgcn_global_load_lds((const unsigned*)(reinterpret_cast<const char*>(KPE) + (size_t)(rp_ + okp)), (LAS unsigned*)(d_ + DOFF_K + 16384), 16, 0, 0); } while (0)
#if ATT_QKPIPE
#define QKT(x0, x1) do { if constexpr (ABL == 7) qkt16_mock(x0, x1, (int)(unsigned)(uintptr_t)lds + o_cur + krd0, qr, negm); else if constexpr (ABL == 2) qkt_noread(x0, x1, qr, negm); else if constexpr (ABL == 6) qkt_nomma(x0, x1, (int)(unsigned)(uintptr_t)lds + o_cur + krd0, qr, negm); else qkt2(x0, x1, (int)(unsigned)(uintptr_t)lds + o_cur + krd0, qr, negm); } while (0)
#else
#define QKT(x0, x1) qkt<NQD>(x0, x1, lds + o_cur + krd0, qr, qpe)
#endif
#if ATT_EARLYTR
#define EARLY_TR() pv_reads<0>(tr0, vrd0 + o_prev)
#define PVSM3(x0, x1, al) pv_sm5(o, vrd0 + o_prev, pa0, pa1, pa2, pa3, x0, x1, m_reg, al, negm, tr0)
#else
#define EARLY_TR() do { } while (0)
#define PVSM3(x0, x1, al) do { if constexpr (ABL == 7) pv_sm4_mock(o, vrd0 + o_prev, pa0, pa1, pa2, pa3, x0, x1, m_reg, al, negm); else if constexpr (ABL == 1) { al = 1.f; pv_d02(o, vrd0 + o_prev, pa0, pa1, pa2, pa3); } else if constexpr (ABL == 2) pv_sm4_noread(o, pa0, pa1, pa2, pa3, x0, x1, m_reg, al, negm); else pv_sm4(o, vrd0 + o_prev, pa0, pa1, pa2, pa3, x0, x1, m_reg, al, negm); } while (0)
#endif
#define TILE_BAR() do { if constexpr (ABL == 4) { asm volatile("s_waitcnt lgkmcnt(0)" ::: "memory"); } else { asm volatile("s_waitcnt vmcnt(0) lgkmcnt(0)" ::: "memory"); __builtin_amdgcn_s_barrier(); asm volatile("" ::: "memory"); } } while (0)
#define RESC(a) do { if (__any((a) < 1.f)) { if (hi == 0) al_l[r32] = (a); asm volatile("s_waitcnt lgkmcnt(0)" ::: "memory"); \
    _Pragma("unroll") for (int d = 0; d < 4; ++d) _Pragma("unroll") for (int r = 0; r < 16; ++r) o[d][r] *= al_l[crow(r, hi)]; } } while (0)
#define FSM(x0, x1, al) do { if constexpr (ABL == 1) fsm_raw(x0, x1, pa0, pa1, pa2, pa3); else finishSM(x0, x1, al, l_reg, pa0, pa1, pa2, pa3); } while (0)
#define ROT() do { const int t_ = o_prev; o_prev = o_cur; o_cur = o_next; o_next = t_; } while (0)
  f32x16 pA0, pA1, pB0, pB1; float alA, alB; bf16x8 pa0, pa1, pa2, pa3; s16x4 tr0[8];
  int o_prev = 2 * DBUF, o_cur = 0, o_next = DBUF;
  DMA_TILE(0, 0); DMA_TILE(1, DBUF);
  asm volatile("s_waitcnt vmcnt(5) lgkmcnt(0)" ::: "memory"); __builtin_amdgcn_s_barrier(); asm volatile("" ::: "memory");
  f32x16 negm = {};
  QKT(pA0, pA1);
  { const float pm0 = sm_rowmax(pA0, pA1); m_reg = pm0; alA = 1.f;
#pragma unroll
    for (int r = 0; r < 16; ++r) { pA0[r] -= pm0; pA1[r] -= pm0; negm[r] = -pm0; }
    sm_exp<0, 16>(pA0); }
  TILE_BAR(); DMA_TILE(2, 2 * DBUF); ROT();
  for (int j = 1; j + 1 < NT; j += 2) {
    SBAR(); QKT(pB0, pB1); EARLY_TR();
    FSM(pA0, pA1, alA); SBAR();
    PVSM3(pB0, pB1, alB);
    TILE_BAR(); if (ABL != 4 && j + 2 < NT) DMA_TILE(j + 2, o_prev); ROT();
    RESC(alB);
    SBAR(); QKT(pA0, pA1); EARLY_TR();
    FSM(pB0, pB1, alB); SBAR();
    PVSM3(pA0, pA1, alA);
    TILE_BAR(); if (ABL != 4 && j + 3 < NT) DMA_TILE(j + 3, o_prev); ROT();
    RESC(alA);
  }
  SBAR(); QKT(pB0, pB1); EARLY_TR();
  FSM(pA0, pA1, alA); SBAR();
  PVSM3(pB0, pB1, alB);
  RESC(alB);
  FSM(pB0, pB1, alB); SBAR();
  PVD0(o, vrd0 + o_cur, pa0, pa1, pa2, pa3);
  TILE_BAR();
  if (hi == 0) li_l[r32] = l_reg; asm volatile("s_waitcnt lgkmcnt(0)" ::: "memory");
#pragma unroll
  for (int r = 0; r < 16; ++r) { const int orow = crow(r, hi); const float rl = __builtin_amdgcn_rcpf(li_l[orow]);
#pragma unroll
    for (int d0 = 0; d0 < 4; ++d0) *(LAS unsigned short*)(ost + orow * 256 + (d0 * 32 + r32) * 2) = (unsigned short)f2bf(o[d0][r] * rl); }
  asm volatile("s_waitcnt lgkmcnt(0)" ::: "memory");
#pragma unroll
  for (int i = 0; i < 8; ++i) { const int gidx = i * 64 + lane, row = gidx >> 4, cg = gidx & 15;
    const v4u v = *(const LAS v4u*)(ost + row * 256 + cg * 16);
    *(GAS v4u*)(Ob + (size_t)(wid * 32 + row) * D + cg * 8) = v; }
  TILE_BAR();
#undef DMA_TILE
#undef EARLY_TR
#undef PVSM3
#undef QKT
#undef TILE_BAR
#undef RESC
#undef ROT
#undef FSM
}

constexpr int PP_VB = 16384, PP_KB = 24576, PP_KRING = 3 * PP_VB;
static_assert(PP_KRING + 3 * PP_KB <= DOFF_WS, "attention (ping-pong variant) LDS map");
__device__ __forceinline__ void attn_unit_pp(const bf16* __restrict__ Qb, const bf16* __restrict__ KNh, const bf16* __restrict__ KPE, const bf16* __restrict__ Vh, bf16* __restrict__ Ob, int b, LAS char* lds, int hot = 0) {
  int tid_l = threadIdx.x; asm volatile("" : "+v"(tid_l));
  const int tid = tid_l, wid = __builtin_amdgcn_readfirstlane(tid >> 6), lane = tid & 63, r32 = lane & 31, hi = lane >> 5;
  const bool late = wid >= 4;
  LAS float* wsf = (LAS float*)(lds + DOFF_WS) + wid * 64; LAS float* li_l = wsf; LAS float* al_l = wsf + 32;
  LAS char* ost = lds + wid * 8192;
  float m_reg = -1e30f, l_reg = 0; f32x16 o[4] = {}; bf16x8 qr[12];
  const bf16* Qw = Qb + (size_t)(wid * 32 + r32) * 3072 + hi * 8;
#pragma unroll
  for (int d0 = 0; d0 < 12; ++d0) qr[d0] = *reinterpret_cast<const bf16x8*>(Qw + d0 * 16);
  unsigned ovs, okn, okp;
  { const int kk = 8 * (wid >> 1) + ((lane & 31) >> 2), k = (kk & ~0xC) | ((kk & 4) << 1) | ((kk & 8) >> 1), col = 32 * (2 * (wid & 1) + (lane >> 5)) + 8 * (lane & 3);
    ovs = (unsigned)(k * D + col) * 2u;
    const int row = 32 * (wid & 1) + (lane >> 1), half = (lane & 1) ^ ((row >> 3) & 1);
    okn = (unsigned)(row * D + (wid >> 1) * 16 + half * 8) * 2u; okp = (unsigned)(row * 64 + (wid >> 1) * 16 + half * 8) * 2u; }
  const int krd0 = (int)(unsigned)(uintptr_t)lds + r32 * 32 + ((hi ^ ((r32 >> 3) & 1)) * 16) + PP_KRING;
  const int vrd0 = (int)(unsigned)(uintptr_t)lds + v_rd_base(lane);
#define DMA_V(j, voff) do { const unsigned rv_ = (unsigned)krow(hot ? ((j) & 3) : (j), b) * (unsigned)(D * 2); LAS char* d_ = lds + (voff) + wid * 1024; \
    __builtin_amdgcn_global_load_lds((const unsigned*)(reinterpret_cast<const char*>(Vh) + (size_t)(rv_ + ovs)), (LAS unsigned*)d_, 16, 0, 0); \
    __builtin_amdgcn_global_load_lds((const unsigned*)(reinterpret_cast<const char*>(Vh) + (size_t)(rv_ + ovs + 32u * D * 2u)), (LAS unsigned*)(d_ + 8192), 16, 0, 0); } while (0)
#define DMA_K(j, koff) do { const unsigned rb_ = (unsigned)krow(hot ? ((j) & 3) : (j), b), rv_ = rb_ * (unsigned)(D * 2), rp_ = rb_ * 128u; LAS char* d_ = lds + PP_KRING + (koff) + wid * 1024; \
    __builtin_amdgcn_global_load_lds((const unsigned*)(reinterpret_cast<const char*>(KNh) + (size_t)(rv_ + okn)), (LAS unsigned*)d_, 16, 0, 0); \
    __builtin_amdgcn_global_load_lds((const unsigned*)(reinterpret_cast<const char*>(KNh) + (size_t)(rv_ + okn + 128u)), (LAS unsigned*)(d_ + 8192), 16, 0, 0); \
    __builtin_amdgcn_global_load_lds((const unsigned*)(reinterpret_cast<const char*>(KPE) + (size_t)(rp_ + okp)), (LAS unsigned*)(d_ + 16384), 16, 0, 0); } while (0)
#define QKT(x0, x1) qkt2(x0, x1, krd0 + k_cur, qr, negm)
#define PVSM3(x0, x1, al) pv_sm4(o, vrd0 + v_prev, pa0, pa1, pa2, pa3, x0, x1, m_reg, al, negm)
#define HBAR(n) do { asm volatile("s_waitcnt vmcnt(" #n ") lgkmcnt(0)" ::: "memory"); __builtin_amdgcn_s_barrier(); asm volatile("" ::: "memory"); } while (0)
#define RESC(a) do { if (__any((a) < 1.f)) { if (hi == 0) al_l[r32] = (a); asm volatile("s_waitcnt lgkmcnt(0)" ::: "memory"); \
    _Pragma("unroll") for (int d = 0; d < 4; ++d) _Pragma("unroll") for (int r = 0; r < 16; ++r) o[d][r] *= al_l[crow(r, hi)]; } } while (0)
#define ROTK() do { const int t_ = k_prev; k_prev = k_cur; k_cur = k_next; k_next = t_; } while (0)
#define ROTV() do { const int t_ = v_prev; v_prev = v_cur; v_cur = v_next; v_next = t_; } while (0)
  f32x16 pA0, pA1, pB0, pB1; float alA, alB; bf16x8 pa0, pa1, pa2, pa3;
  int k_prev = 2 * PP_KB, k_cur = 0, k_next = PP_KB, v_prev = 2 * PP_VB, v_cur = 0, v_next = PP_VB;
  DMA_K(0, 0); DMA_K(1, PP_KB);
  HBAR(3);
  if (late) { __builtin_amdgcn_s_barrier(); asm volatile("" ::: "memory"); }
  f32x16 negm = {};
  DMA_V(0, v_cur); DMA_K(2, k_prev); SBAR();
  QKT(pA0, pA1);
  HBAR(5); ROTK();
  { const float pm0 = sm_rowmax(pA0, pA1); m_reg = pm0; alA = 1.f;
#pragma unroll
    for (int r = 0; r < 16; ++r) { pA0[r] -= pm0; pA1[r] -= pm0; negm[r] = -pm0; }
    sm_exp<0, 16>(pA0); }
  HBAR(3); ROTV();
  for (int j = 1; j + 1 < NT; j += 2) {
    DMA_V(j, v_cur); DMA_K(j + 2 < NT ? j + 2 : NT - 1, k_prev); SBAR();
    QKT(pB0, pB1);
    finishSM(pA0, pA1, alA, l_reg, pa0, pa1, pa2, pa3); SBAR();
    HBAR(5); ROTK();
    PVSM3(pB0, pB1, alB);
    HBAR(3); ROTV();
    RESC(alB);
    DMA_V(j + 1, v_cur); DMA_K(j + 3 < NT ? j + 3 : NT - 1, k_prev); SBAR();
    QKT(pA0, pA1);
    finishSM(pB0, pB1, alB, l_reg, pa0, pa1, pa2, pa3); SBAR();
    HBAR(5); ROTK();
    PVSM3(pA0, pA1, alA);
    HBAR(3); ROTV();
    RESC(alA);
  }
  DMA_V(NT - 1, v_cur); SBAR();
  QKT(pB0, pB1);
  finishSM(pA0, pA1, alA, l_reg, pa0, pa1, pa2, pa3); SBAR();
  HBAR(0); ROTK();
  PVSM3(pB0, pB1, alB);
  HBAR(0); ROTV();
  RESC(alB);
  finishSM(pB0, pB1, alB, l_reg, pa0, pa1, pa2, pa3); SBAR();
  HBAR(0);
  pv_d02(o, vrd0 + v_prev, pa0, pa1, pa2, pa3);
  HBAR(0);
  if (!late) { __builtin_amdgcn_s_barrier(); asm volatile("" ::: "memory"); }
  if (hi == 0) li_l[r32] = l_reg; asm volatile("s_waitcnt lgkmcnt(0)" ::: "memory");
#pragma unroll
  for (int r = 0; r < 16; ++r) { const int orow = crow(r, hi); const float rl = __builtin_amdgcn_rcpf(li_l[orow]);
#pragma unroll
    for (int d0 = 0; d0 < 4; ++d0) *(LAS unsigned short*)(ost + orow * 256 + (d0 * 32 + r32) * 2) = (unsigned short)f2bf(o[d0][r] * rl); }
  asm volatile("s_waitcnt lgkmcnt(0)" ::: "memory");
#pragma unroll
  for (int i = 0; i < 8; ++i) { const int gidx = i * 64 + lane, row = gidx >> 4, cg = gidx & 15;
    const v4u v = *(const LAS v4u*)(ost + row * 256 + cg * 16);
    *(GAS v4u*)(Ob + (size_t)(wid * 32 + row) * D + cg * 8) = v; }
  HBAR(0);
#undef DMA_V
#undef DMA_K
#undef QKT
#undef PVSM3
#undef HBAR
#undef RESC
#undef ROTK
#undef ROTV
}

struct S16 { pg8::f32x4 a[4][2]; };
#define K16READ(a, b, d) asm volatile("ds_read_b128 %0, %2 offset:%3\n\tds_read_b128 %1, %2 offset:%4" : "=&v"(a), "=&v"(b) : "v"(kaddr), "i"(((d) >> 1) * 4096 + ((d) & 1) * 2048), "i"(((d) >> 1) * 4096 + ((d) & 1) * 2048 + 1024))
#define K16WAIT(n, a, b) asm volatile("s_waitcnt lgkmcnt(" #n ")" : "+v"(a), "+v"(b))
#define MF16(A, B, C) __builtin_amdgcn_mfma_f32_16x16x32_bf16(A, B, C, 0, 0, 0)
__device__ __forceinline__ void qkt16(S16& p, int kaddr, const bf16x8 (&qr)[6][2], const pg8::f32x4 (&negm)[2]) {
#pragma unroll
  for (int kb = 0; kb < 4; ++kb) { p.a[kb][0] = negm[0]; p.a[kb][1] = negm[1]; }
  bf16x8 ka0, ka1, kb0, kb1, kc0, kc1;
  K16READ(ka0, ka1, 0); K16READ(kb0, kb1, 1);
#define K16STEP(x0, x1, d) do { if ((d) + 2 < 12) { K16WAIT(4, x0, x1); } else if ((d) + 1 < 12) { K16WAIT(2, x0, x1); } else { K16WAIT(0, x0, x1); } \
    p.a[2 * ((d) & 1)][0] = MF16(x0, qr[(d) >> 1][0], p.a[2 * ((d) & 1)][0]); p.a[2 * ((d) & 1)][1] = MF16(x0, qr[(d) >> 1][1], p.a[2 * ((d) & 1)][1]); \
    p.a[2 * ((d) & 1) + 1][0] = MF16(x1, qr[(d) >> 1][0], p.a[2 * ((d) & 1) + 1][0]); p.a[2 * ((d) & 1) + 1][1] = MF16(x1, qr[(d) >> 1][1], p.a[2 * ((d) & 1) + 1][1]); } while (0)
#pragma unroll
  for (int d0 = 0; d0 < 12; d0 += 3) {
    K16READ(kc0, kc1, d0 + 2); K16STEP(ka0, ka1, d0);
    if (d0 + 3 < 12) K16READ(ka0, ka1, d0 + 3);
    K16STEP(kb0, kb1, d0 + 1);
    if (d0 + 4 < 12) K16READ(kb0, kb1, d0 + 4);
    K16STEP(kc0, kc1, d0 + 2);
  }
#undef K16STEP
}
#undef K16READ
#undef K16WAIT
__device__ __forceinline__ void sm16_pmax(const S16& p, float (&pm)[2]) {
#pragma unroll
  for (int qb = 0; qb < 2; ++qb) { float m = p.a[0][qb][0];
#pragma unroll
    for (int kb = 0; kb < 4; ++kb)
#pragma unroll
      for (int i = 0; i < 4; ++i) if (kb | i) m = fmaxf(m, p.a[kb][qb][i]);
    pm[qb] = m; }
}
__device__ __forceinline__ float rowmax4(float v) {
  auto a = __builtin_amdgcn_permlane16_swap(__float_as_uint(v), __float_as_uint(v), false, false); const float m = fmaxf(__uint_as_float(a[0]), __uint_as_float(a[1]));
  auto c = __builtin_amdgcn_permlane32_swap(__float_as_uint(m), __float_as_uint(m), false, false); return fmaxf(__uint_as_float(c[0]), __uint_as_float(c[1])); }
__device__ __forceinline__ float rowsum4(float v) {
  auto a = __builtin_amdgcn_permlane16_swap(__float_as_uint(v), __float_as_uint(v), false, false); const float m = __uint_as_float(a[0]) + __uint_as_float(a[1]);
  auto c = __builtin_amdgcn_permlane32_swap(__float_as_uint(m), __float_as_uint(m), false, false); return __uint_as_float(c[0]) + __uint_as_float(c[1]); }
__device__ __forceinline__ void sm16_grow(const float (&pm)[2], S16& p, float (&m_reg)[2], float (&alpha)[2], pg8::f32x4 (&negm)[2]) {
  alpha[0] = 1.f; alpha[1] = 1.f;
  if (__any((pm[0] > THRL) || (pm[1] > THRL))) {
#pragma unroll
    for (int qb = 0; qb < 2; ++qb) { const float r = rowmax4(pm[qb]); const float dl = (r > THRL) ? r : 0.f;
#pragma unroll
      for (int kb = 0; kb < 4; ++kb)
#pragma unroll
        for (int i = 0; i < 4; ++i) p.a[kb][qb][i] -= dl;
      m_reg[qb] += dl; alpha[qb] = __builtin_amdgcn_exp2f(-dl); const float nm = -m_reg[qb]; negm[qb] = (pg8::f32x4){nm, nm, nm, nm}; }
  }
}
template <int KB> __device__ __forceinline__ void sm16_exp(S16& p) {
#pragma unroll
  for (int qb = 0; qb < 2; ++qb)
#pragma unroll
    for (int i = 0; i < 4; ++i) p.a[KB][qb][i] = __builtin_amdgcn_exp2f(p.a[KB][qb][i]);
}
#define PIN16(p, KB) asm volatile("" : "+v"(p.a[KB][0]), "+v"(p.a[KB][1]))
__device__ __forceinline__ void finish16(S16& p, const float (&alpha)[2], float (&l_reg)[2], bf16x8 (&pa)[2][2]) {
  sm16_exp<2>(p); sm16_exp<3>(p);
#pragma unroll
  for (int qb = 0; qb < 2; ++qb) { float ps = 0;
#pragma unroll
    for (int kb = 0; kb < 4; ++kb)
#pragma unroll
      for (int i = 0; i < 4; ++i) ps += p.a[kb][qb][i];
    l_reg[qb] = l_reg[qb] * alpha[qb] + ps;
#pragma unroll
    for (int s = 0; s < 2; ++s) { const pg8::f32x4 lo = p.a[2 * s][qb], hi = p.a[2 * s + 1][qb];
      v4u w = {cvtpk(lo[0], lo[1]), cvtpk(lo[2], lo[3]), cvtpk(hi[0], hi[1]), cvtpk(hi[2], hi[3])}; pa[qb][s] = *reinterpret_cast<bf16x8*>(&w); } }
}
constexpr int v16_off(int s, int db, int hi) { return s * 8192 + hi * 4096 + db * 256; }
template <int DB> __device__ __forceinline__ void pv16_reads(s16x4 (&t)[4], int vb) {
  t[0] = tr_read<v16_off(0, DB, 0)>(vb); t[1] = tr_read<v16_off(0, DB, 1)>(vb); t[2] = tr_read<v16_off(1, DB, 0)>(vb); t[3] = tr_read<v16_off(1, DB, 1)>(vb);
}
template <int DB> __device__ __forceinline__ void pv16_mma(pg8::f32x4 (&o)[2][8], const s16x4 (&t)[4], const bf16x8 (&pa)[2][2]) {
#define PK(L, H) (bf16x8){L[0], L[1], L[2], L[3], H[0], H[1], H[2], H[3]}
  { const bf16x8 B = PK(t[0], t[1]); o[0][DB] = MF16(pa[0][0], B, o[0][DB]); o[1][DB] = MF16(pa[1][0], B, o[1][DB]); }
  { const bf16x8 B = PK(t[2], t[3]); o[0][DB] = MF16(pa[0][1], B, o[0][DB]); o[1][DB] = MF16(pa[1][1], B, o[1][DB]); }
#undef PK
}
__device__ __forceinline__ void pv16_sm(pg8::f32x4 (&o)[2][8], int vb, const bf16x8 (&pa)[2][2], S16& pX, float (&m_reg)[2], float (&alpha)[2], pg8::f32x4 (&negm)[2]) {
  s16x4 ta[4], tb[4]; float pm[2];
  pv16_reads<0>(ta, vb);
  pv16_reads<1>(tb, vb); PVW(4); pv16_mma<0>(o, ta, pa);
  pv16_reads<2>(ta, vb); PVW(4); pv16_mma<1>(o, tb, pa); sm16_pmax(pX, pm); asm volatile("" : "+v"(pm[0]), "+v"(pm[1]));
  pv16_reads<3>(tb, vb); PVW(4); pv16_mma<2>(o, ta, pa);
  pv16_reads<4>(ta, vb); PVW(4); pv16_mma<3>(o, tb, pa); sm16_grow(pm, pX, m_reg, alpha, negm); sm16_exp<0>(pX); PIN16(pX, 0);
  pv16_reads<5>(tb, vb); PVW(4); pv16_mma<4>(o, ta, pa);
  pv16_reads<6>(ta, vb); PVW(4); pv16_mma<5>(o, tb, pa); sm16_exp<1>(pX); PIN16(pX, 1);
  pv16_reads<7>(tb, vb); PVW(4); pv16_mma<6>(o, ta, pa);
  PVW(0); pv16_mma<7>(o, tb, pa);
}
__device__ __forceinline__ void pv16_d0(pg8::f32x4 (&o)[2][8], int vb, const bf16x8 (&pa)[2][2]) {
  s16x4 ta[4], tb[4];
  pv16_reads<0>(ta, vb);
  pv16_reads<1>(tb, vb); PVW(4); pv16_mma<0>(o, ta, pa);
  pv16_reads<2>(ta, vb); PVW(4); pv16_mma<1>(o, tb, pa);
  pv16_reads<3>(tb, vb); PVW(4); pv16_mma<2>(o, ta, pa);
  pv16_reads<4>(ta, vb); PVW(4); pv16_mma<3>(o, tb, pa);
  pv16_reads<5>(tb, vb); PVW(4); pv16_mma<4>(o, ta, pa);
  pv16_reads<6>(ta, vb); PVW(4); pv16_mma<5>(o, tb, pa);
  pv16_reads<7>(tb, vb); PVW(4); pv16_mma<6>(o, ta, pa);
  PVW(0); pv16_mma<7>(o, tb, pa);
}
__device__ __forceinline__ void sm16_sum(const S16& p, int qb, float alpha, float& l) { float ps = 0;
#pragma unroll
  for (int kb = 0; kb < 4; ++kb)
#pragma unroll
    for (int i = 0; i < 4; ++i) ps += p.a[kb][qb][i];
  l = l * alpha + ps; }
__device__ __forceinline__ void sm16_pack(const S16& p, bf16x8 (&pn)[2][2]) {
#pragma unroll
  for (int qb = 0; qb < 2; ++qb)
#pragma unroll
    for (int s = 0; s < 2; ++s) { const pg8::f32x4 lo = p.a[2 * s][qb], hi = p.a[2 * s + 1][qb];
      v4u w = {cvtpk(lo[0], lo[1]), cvtpk(lo[2], lo[3]), cvtpk(hi[0], hi[1]), cvtpk(hi[2], hi[3])}; pn[qb][s] = *reinterpret_cast<bf16x8*>(&w); }
}
__device__ __forceinline__ void pv16_smf(pg8::f32x4 (&o)[2][8], int vb, const bf16x8 (&pa)[2][2], S16& pX, float (&m_reg)[2], float (&alpha)[2], float (&l_reg)[2], pg8::f32x4 (&negm)[2], bf16x8 (&pn)[2][2]) {
  s16x4 ta[4], tb[4]; float pm[2];
  pv16_reads<0>(ta, vb);
  pv16_reads<1>(tb, vb); PVW(4); pv16_mma<0>(o, ta, pa); sm16_pmax(pX, pm); asm volatile("" : "+v"(pm[0]), "+v"(pm[1]));
  pv16_reads<2>(ta, vb); PVW(4); pv16_mma<1>(o, tb, pa); sm16_grow(pm, pX, m_reg, alpha, negm); sm16_exp<0>(pX); PIN16(pX, 0);
  pv16_reads<3>(tb, vb); PVW(4); pv16_mma<2>(o, ta, pa); sm16_exp<1>(pX); PIN16(pX, 1);
  pv16_reads<4>(ta, vb); PVW(4); pv16_mma<3>(o, tb, pa); sm16_exp<2>(pX); PIN16(pX, 2);
  pv16_reads<5>(tb, vb); PVW(4); pv16_mma<4>(o, ta, pa); sm16_exp<3>(pX); PIN16(pX, 3);
  pv16_reads<6>(ta, vb); PVW(4); pv16_mma<5>(o, tb, pa); sm16_sum(pX, 0, alpha[0], l_reg[0]); asm volatile("" : "+v"(l_reg[0]));
  pv16_reads<7>(tb, vb); PVW(4); pv16_mma<6>(o, ta, pa); sm16_sum(pX, 1, alpha[1], l_reg[1]); asm volatile("" : "+v"(l_reg[1]));
  PVW(0); pv16_mma<7>(o, tb, pa); sm16_pack(pX, pn);
}
#define K16R(a, b, ks, H) asm volatile("ds_read_b128 %0, %2 offset:%3\n\tds_read_b128 %1, %2 offset:%4" : "=&v"(a), "=&v"(b) : "v"(kaddr), "i"((ks) * 4096 + (H) * 2048), "i"((ks) * 4096 + (H) * 2048 + 1024))
#define K16W(n, a, b) asm volatile("s_waitcnt lgkmcnt(" #n ")" : "+v"(a), "+v"(b))
#define K16M(x0, x1, ks, H) do { p.a[2 * (H)][0] = MF16(x0, qr[ks][0], p.a[2 * (H)][0]); p.a[2 * (H)][1] = MF16(x0, qr[ks][1], p.a[2 * (H)][1]); \
    p.a[2 * (H) + 1][0] = MF16(x1, qr[ks][0], p.a[2 * (H) + 1][0]); p.a[2 * (H) + 1][1] = MF16(x1, qr[ks][1], p.a[2 * (H) + 1][1]); } while (0)
__device__ __forceinline__ float amax3(float a, float b, float c) { float r; asm("v_max3_f32 %0, %1, %2, %3" : "=v"(r) : "v"(a), "v"(b), "v"(c)); return r; }
__device__ __forceinline__ float amax2(float a, float b) { float r; asm("v_max_f32 %0, %1, %2" : "=v"(r) : "v"(a), "v"(b)); return r; }
template <int H> __device__ __forceinline__ void sm16_pmaxh(const S16& p, float (&pm)[2]) {
#pragma unroll
  for (int qb = 0; qb < 2; ++qb) { const pg8::f32x4 a = p.a[2 * H][qb], c = p.a[2 * H + 1][qb];
    float m = amax3(a[0], a[1], a[2]); m = amax3(m, a[3], c[0]); m = amax3(m, c[1], c[2]); pm[qb] = amax2(m, c[3]); }
}
__device__ __forceinline__ void sm16_grow_h0(const float (&pm)[2], S16& p, float (&m_reg)[2], float (&alpha)[2], pg8::f32x4 (&negm)[2]) {
  alpha[0] = 1.f; alpha[1] = 1.f;
  if (__any(amax2(pm[0], pm[1]) > THRL)) {
#pragma unroll
    for (int qb = 0; qb < 2; ++qb) { const float r = rowmax4(pm[qb]); const float dl = (r > THRL) ? r : 0.f;
#pragma unroll
      for (int kb = 0; kb < 4; ++kb)
#pragma unroll
        for (int i = 0; i < 4; ++i) p.a[kb][qb][i] -= dl;
      m_reg[qb] += dl; alpha[qb] = __builtin_amdgcn_exp2f(-dl); const float nm = -m_reg[qb]; negm[qb] = (pg8::f32x4){nm, nm, nm, nm}; }
  }
}
__device__ __forceinline__ void sm16_grow_h1(const float (&pm)[2], S16& p, float (&m_reg)[2], float (&alpha)[2], pg8::f32x4 (&negm)[2], float (&ps)[2]) {
  if (__any(amax2(pm[0], pm[1]) > THRL)) {
#pragma unroll
    for (int qb = 0; qb < 2; ++qb) { const float r = rowmax4(pm[qb]); const float dl = (r > THRL) ? r : 0.f; const float a2 = __builtin_amdgcn_exp2f(-dl);
#pragma unroll
      for (int i = 0; i < 4; ++i) { p.a[2][qb][i] -= dl; p.a[3][qb][i] -= dl; p.a[0][qb][i] *= a2; p.a[1][qb][i] *= a2; }
      ps[qb] *= a2; m_reg[qb] += dl; alpha[qb] *= a2; const float nm = -m_reg[qb]; negm[qb] = (pg8::f32x4){nm, nm, nm, nm}; }
  }
}
template <int H> __device__ __forceinline__ void sm16_sumh(const S16& p, float (&ps)[2]) {
#pragma unroll
  for (int qb = 0; qb < 2; ++qb)
#pragma unroll
    for (int kb = 2 * H; kb < 2 * H + 2; ++kb)
#pragma unroll
      for (int i = 0; i < 4; ++i) ps[qb] += p.a[kb][qb][i];
}
__device__ __forceinline__ void qkt16_sm(S16& p, int kaddr, const bf16x8 (&qr)[6][2], float (&m_reg)[2], float (&alpha)[2], pg8::f32x4 (&negm)[2], float (&ps)[2]) {
#pragma unroll
  for (int kb = 0; kb < 4; ++kb) { p.a[kb][0] = negm[0]; p.a[kb][1] = negm[1]; }
  bf16x8 ka0, ka1, kb0, kb1, kc0, kc1; float pm[2];
  K16R(ka0, ka1, 0, 0); K16R(kb0, kb1, 1, 0);
  K16R(kc0, kc1, 2, 0); K16W(4, ka0, ka1); K16M(ka0, ka1, 0, 0);
  K16R(ka0, ka1, 3, 0); K16W(4, kb0, kb1); K16M(kb0, kb1, 1, 0);
  K16R(kb0, kb1, 4, 0); K16W(4, kc0, kc1); K16M(kc0, kc1, 2, 0);
  K16R(kc0, kc1, 5, 0); K16W(4, ka0, ka1); K16M(ka0, ka1, 3, 0);
  K16R(ka0, ka1, 0, 1); K16W(4, kb0, kb1); K16M(kb0, kb1, 4, 0);
  K16R(kb0, kb1, 1, 1); K16W(4, kc0, kc1); K16M(kc0, kc1, 5, 0);
  K16R(kc0, kc1, 2, 1); K16W(4, ka0, ka1); K16M(ka0, ka1, 0, 1);
  K16R(ka0, ka1, 3, 1); K16W(4, kb0, kb1); K16M(kb0, kb1, 1, 1); sm16_pmaxh<0>(p, pm); asm volatile("" : "+v"(pm[0]), "+v"(pm[1]));
  K16R(kb0, kb1, 4, 1); K16W(4, kc0, kc1); K16M(kc0, kc1, 2, 1); sm16_grow_h0(pm, p, m_reg, alpha, negm); sm16_exp<0>(p); PIN16(p, 0);
  K16R(kc0, kc1, 5, 1); K16W(4, ka0, ka1); K16M(ka0, ka1, 3, 1); sm16_exp<1>(p); PIN16(p, 1);
  K16W(2, kb0, kb1); K16M(kb0, kb1, 4, 1); ps[0] = 0.f; ps[1] = 0.f; sm16_sumh<0>(p, ps); asm volatile("" : "+v"(ps[0]), "+v"(ps[1]));
  K16W(0, kc0, kc1); K16M(kc0, kc1, 5, 1);
}
#undef K16R
#undef K16W
#undef K16M
__device__ __forceinline__ void pv16_smh(pg8::f32x4 (&o)[2][8], int vb, const bf16x8 (&pa)[2][2], S16& pX, float (&m_reg)[2], float (&alpha)[2], float (&l_reg)[2], pg8::f32x4 (&negm)[2], float (&ps)[2], bf16x8 (&pn)[2][2]) {
  s16x4 ta[4], tb[4]; float pm[2];
  pv16_reads<0>(ta, vb);
  pv16_reads<1>(tb, vb); PVW(4); pv16_mma<0>(o, ta, pa); sm16_pmaxh<1>(pX, pm); asm volatile("" : "+v"(pm[0]), "+v"(pm[1]));
  pv16_reads<2>(ta, vb); PVW(4); pv16_mma<1>(o, tb, pa); sm16_grow_h1(pm, pX, m_reg, alpha, negm, ps); sm16_exp<2>(pX); PIN16(pX, 2);
  pv16_reads<3>(tb, vb); PVW(4); pv16_mma<2>(o, ta, pa); sm16_exp<3>(pX); PIN16(pX, 3);
  pv16_reads<4>(ta, vb); PVW(4); pv16_mma<3>(o, tb, pa); sm16_sumh<1>(pX, ps); l_reg[0] = l_reg[0] * alpha[0] + ps[0]; l_reg[1] = l_reg[1] * alpha[1] + ps[1]; asm volatile("" : "+v"(l_reg[0]), "+v"(l_reg[1]));
  pv16_reads<5>(tb, vb); PVW(4); pv16_mma<4>(o, ta, pa);
  pv16_reads<6>(ta, vb); PVW(4); pv16_mma<5>(o, tb, pa); sm16_pack(pX, pn); asm volatile("" : "+v"(pn[0][0]), "+v"(pn[0][1]), "+v"(pn[1][0]), "+v"(pn[1][1]));
  pv16_reads<7>(tb, vb); PVW(4); pv16_mma<6>(o, ta, pa);
  PVW(0); pv16_mma<7>(o, tb, pa);
}
__device__ __forceinline__ void attn_unit16(const bf16* __restrict__ Qb, const bf16* __restrict__ KNh, const bf16* __restrict__ KPE, const bf16* __restrict__ Vh, bf16* __restrict__ Ob, int b, LAS char* lds) {
  int tid_l = threadIdx.x; asm volatile("" : "+v"(tid_l));
  const int tid = tid_l, wid = __builtin_amdgcn_readfirstlane(tid >> 6), lane = tid & 63, i16 = lane & 15, g = lane >> 4;
  LAS float* wsf = (LAS float*)(lds + DOFF_WS) + wid * 64; LAS float* li_l = wsf; LAS float* al_l = wsf + 32;
  LAS char* ost = lds + wid * 8192;
  float m_reg[2] = {-1e30f, -1e30f}, l_reg[2] = {0.f, 0.f}; pg8::f32x4 o[2][8]; bf16x8 qr[6][2];
#pragma unroll
  for (int qb = 0; qb < 2; ++qb)
#pragma unroll
    for (int db = 0; db < 8; ++db) o[qb][db] = (pg8::f32x4){0.f, 0.f, 0.f, 0.f};
#pragma unroll
  for (int ks = 0; ks < 6; ++ks)
#pragma unroll
    for (int qb = 0; qb < 2; ++qb) qr[ks][qb] = *reinterpret_cast<const bf16x8*>(Qb + (size_t)(wid * 32 + 16 * qb + i16) * 3072 + 32 * ks + 8 * g);
  unsigned ovs, okn, okp;
  { const int key = 8 * (wid >> 1) + ((lane & 15) >> 1), col = 16 * (4 * (wid & 1) + (lane >> 4)) + 8 * (lane & 1);
    ovs = (unsigned)(key * D + col) * 2u;
    const int kin = lane >> 2, kk = 16 * (wid & 3) + kin, gg = (lane & 3) ^ (2 * ((kin >> 3) & 1));
    okn = (unsigned)(kk * D + 32 * (wid >> 2) + 8 * gg) * 2u; okp = (unsigned)(kk * 64 + 32 * (wid >> 2) + 8 * gg) * 2u; }
  const int krd0 = i16 * 64 + ((g ^ (2 * ((i16 >> 3) & 1))) * 16) + DOFF_K;
  const int vrd0 = (int)(unsigned)(uintptr_t)lds + (g >> 1) * 2048 + (4 * (g & 1) + (i16 >> 2)) * 32 + (i16 & 3) * 8;
#define DMA_TILE(j, boff) do { const unsigned rb_ = (unsigned)krow((j), b), rv_ = rb_ * (unsigned)(D * 2), rp_ = rb_ * 128u; LAS char* d_ = lds + (boff) + wid * 1024; \
    __builtin_amdgcn_global_load_lds((const unsigned*)(reinterpret_cast<const char*>(Vh) + (size_t)(rv_ + ovs)), (LAS unsigned*)d_, 16, 0, 0); \
    __builtin_amdgcn_global_load_lds((const unsigned*)(reinterpret_cast<const char*>(Vh) + (size_t)(rv_ + ovs + 32u * D * 2u)), (LAS unsigned*)(d_ + 8192), 16, 0, 0); \
    __builtin_amdgcn_global_load_lds((const unsigned*)(reinterpret_cast<const char*>(KNh) + (size_t)(rv_ + okn)), (LAS unsigned*)(d_ + DOFF_K), 16, 0, 0); \
    __builtin_amdgcn_global_load_lds((const unsigned*)(reinterpret_cast<const char*>(KNh) + (size_t)(rv_ + okn + 128u)), (LAS unsigned*)(d_ + DOFF_K + 8192), 16, 0, 0); \
    __builtin_amdgcn_global_load_lds((const unsigned*)(reinterpret_cast<const char*>(KPE) + (size_t)(rp_ + okp)), (LAS unsigned*)(d_ + DOFF_K + 16384), 16, 0, 0); } while (0)
#define QKT(x) qkt16(x, (int)(unsigned)(uintptr_t)lds + o_cur + krd0, qr, negm)
#define TILE_BAR() do { asm volatile("s_waitcnt vmcnt(0) lgkmcnt(0)" ::: "memory"); __builtin_amdgcn_s_barrier(); asm volatile("" ::: "memory"); } while (0)
#define RESC(a) do { if (__any((a[0] < 1.f) || (a[1] < 1.f))) { if (g == 0) { al_l[i16] = a[0]; al_l[16 + i16] = a[1]; } asm volatile("s_waitcnt lgkmcnt(0)" ::: "memory"); \
    _Pragma("unroll") for (int qb = 0; qb < 2; ++qb) { const pg8::f32x4 av = *(const LAS pg8::f32x4*)(al_l + 16 * qb + 4 * g); \
      _Pragma("unroll") for (int db = 0; db < 8; ++db) o[qb][db] *= av; } } } while (0)
#define ROT() do { const int t_ = o_prev; o_prev = o_cur; o_cur = o_next; o_next = t_; } while (0)
  S16 p; float al[2]; bf16x8 paA[2][2], paB[2][2];
  int o_prev = 2 * DBUF, o_cur = 0, o_next = DBUF;
  DMA_TILE(0, 0); DMA_TILE(1, DBUF);
  asm volatile("s_waitcnt vmcnt(5) lgkmcnt(0)" ::: "memory"); __builtin_amdgcn_s_barrier(); asm volatile("" ::: "memory");
  pg8::f32x4 negm[2] = {{0.f, 0.f, 0.f, 0.f}, {0.f, 0.f, 0.f, 0.f}};
  QKT(p);
  { float pm[2]; sm16_pmax(p, pm); al[0] = 1.f; al[1] = 1.f;
#pragma unroll
    for (int qb = 0; qb < 2; ++qb) { const float r = rowmax4(pm[qb]); m_reg[qb] = r; negm[qb] = (pg8::f32x4){-r, -r, -r, -r};
#pragma unroll
      for (int kb = 0; kb < 4; ++kb)
#pragma unroll
        for (int i = 0; i < 4; ++i) p.a[kb][qb][i] -= r; }
    sm16_exp<0>(p); sm16_exp<1>(p); sm16_exp<2>(p); sm16_exp<3>(p);
    sm16_sum(p, 0, 1.f, l_reg[0]); sm16_sum(p, 1, 1.f, l_reg[1]); sm16_pack(p, paA); }
  TILE_BAR(); DMA_TILE(2, 2 * DBUF); ROT();
  float ps[2];
#define QKTS() qkt16_sm(p, (int)(unsigned)(uintptr_t)lds + o_cur + krd0, qr, m_reg, al, negm, ps)
  for (int j = 1; j + 1 < NT; j += 2) {
    SBAR(); QKTS(); SBAR();
    pv16_smh(o, vrd0 + o_prev, paA, p, m_reg, al, l_reg, negm, ps, paB);
    TILE_BAR(); if (j + 2 < NT) DMA_TILE(j + 2, o_prev); ROT();
    RESC(al);
    SBAR(); QKTS(); SBAR();
    pv16_smh(o, vrd0 + o_prev, paB, p, m_reg, al, l_reg, negm, ps, paA);
    TILE_BAR(); if (j + 3 < NT) DMA_TILE(j + 3, o_prev); ROT();
    RESC(al);
  }
  SBAR(); QKTS(); SBAR();
  pv16_smh(o, vrd0 + o_prev, paA, p, m_reg, al, l_reg, negm, ps, paB);
  RESC(al);
#undef QKTS
  pv16_d0(o, vrd0 + o_cur, paB);
  TILE_BAR();
  { const float l0 = rowsum4(l_reg[0]), l1 = rowsum4(l_reg[1]); if (g == 0) { li_l[i16] = l0; li_l[16 + i16] = l1; } }
  asm volatile("s_waitcnt lgkmcnt(0)" ::: "memory");
#pragma unroll
  for (int qb = 0; qb < 2; ++qb) { const pg8::f32x4 lv = *(const LAS pg8::f32x4*)(li_l + 16 * qb + 4 * g);
#pragma unroll
    for (int i = 0; i < 4; ++i) { const float rl = __builtin_amdgcn_rcpf(lv[i]); const int orow = 16 * qb + 4 * g + i;
#pragma unroll
      for (int db = 0; db < 8; ++db) *(LAS unsigned short*)(ost + orow * 256 + (db * 16 + i16) * 2) = (unsigned short)f2bf(o[qb][db][i] * rl); } }
  asm volatile("s_waitcnt lgkmcnt(0)" ::: "memory");
#pragma unroll
  for (int i = 0; i < 8; ++i) { const int gidx = i * 64 + lane, row = gidx >> 4, cg = gidx & 15;
    const v4u v = *(const LAS v4u*)(ost + row * 256 + cg * 16);
    *(GAS v4u*)(Ob + (size_t)(wid * 32 + row) * D + cg * 8) = v; }
  TILE_BAR();
#undef DMA_TILE
#undef QKT
#undef TILE_BAR
#undef RESC
#undef ROT
}
#undef MF16
#undef PIN16
#undef SBAR
}

#ifndef MK_SPLIT
#define MK_SPLIT 0
#endif
#if MK_SPLIT
#define GRID_BAR() do { } while (0)
#else
#define GRID_BAR() xcd_barrier(bar)
#endif
#define IN(k) (lo <= (k) && (k) < hi)
#ifndef ATTN_MAIN
#define ATTN_MAIN attn_unit16
#endif
#ifndef ATTN_FN
#define ATTN_FN attn_unit_pp
#endif
#ifndef GU_WGM
#define GU_WGM 8
#endif
#ifndef DN_WGM
#define DN_WGM 4
#endif
#ifndef PROBE_PH
#define PROBE_PH (-1)
#define PROBE_N 1
#endif
#define REPEAT(k) _Pragma("unroll") for (int rep_ = 0; rep_ < ((k) == PROBE_PH ? PROBE_N : 1); ++rep_)
#define SEAM(k) do { if (IN(k) && IN((k) + 1)) GRID_BAR(); } while (0)
template <int l> __device__ __forceinline__ void layer_body(Frame& F, const Args& args, const int lo, const int hi, const XcdBarrier& bar) {
    unsigned char* ws = args.ws;
    float* X = args.out;
    float* Yc = (float*)(ws + WS_Y) - (size_t)M_LAT * D;
    float* PARTc = (float*)(ws + WS_F) - (size_t)M_LAT * D;
    const float* XinC = args.in[2] - (size_t)M_LAT * D;
    bf16* XN = (bf16*)args.out;
    bf16* XB = (bf16*)(ws + WS_XB);
    bf16* Hb = (bf16*)(ws + WS_BIG);
    const float* MOD = (const float*)(ws + WS_MOD);
    const float* ROPEt = (const float*)(ws + WS_ROPE);
    (void)XinC; (void)ROPEt;
        const int pb = l == 0 ? 2 : 12;
        const float* modl = MOD + (size_t)l * 3 * NMODV;
        const float* ng = args.in[6] + (size_t)l * 3 * D;
        if (IN(pb + 0)) { REPEAT(pb + 0) { if constexpr (l == 0) ph_norm<true>(F, args.in[0], XinC, M_ALL, ng, modl, 0, XN); else ph_norm<false, CTX_P>(F, XB, Yc, M_ALL, ng, modl, 0, XN, PARTc, Yc); } } SEAM(pb + 0);
#if defined(DRY_GU)
        if (l == 0 && IN(pb + 1)) { for (int rr = 0; rr < DRY_GU; ++rr) { pg8::Gemm g{XN, (const bf16*)(ws + WS_WGU), M_ALL, NGU, D, D}; pg8::StaticOrder S; S.init(M_ALL, NGU, F.G, (int)blockIdx.x, GU_WGM);
            EpiNull E; pg8::gemm_phase<EpiNull, pg8::StaticOrder, true, true>(F.lds + RING_OFF, g, S, E); __syncthreads(); } }
#endif
        if (IN(pb + 1)) REPEAT(pb + 1) {
            pg8::Gemm g{XN, (const bf16*)(ws + WS_WGU + (size_t)(l * 2) * SZ_WGU), M_ALL, NGU, D, D}; pg8::StaticOrder S; S.init(M_ALL, NGU, F.G, (int)blockIdx.x, GU_WGM);
            EpiSwiGLU E{Hb};
            pg8::gemm_phase<EpiSwiGLU, pg8::StaticOrder, true, true>(F.lds + RING_OFF, g, S, E);
        } SEAM(pb + 1);
#if defined(DRY_DN)
        if (l == 0 && IN(pb + 2)) { for (int rr = 0; rr < DRY_DN; ++rr) { pg8::Gemm g{Hb, (const bf16*)(ws + WS_WD), M_LAT, D, FF, FF}; pg8::StaticOrder S; S.init(M_LAT, D, F.G, (int)blockIdx.x, DN_WGM);
            EpiNull E; pg8::gemm_phase<EpiNull, pg8::StaticOrder, true, true>(F.lds + RING_OFF, g, S, E); __syncthreads(); } }
#endif
        if (IN(pb + 2)) REPEAT(pb + 2) {
#ifdef CTX_CHECK
            if constexpr (l == 0) {
                const float* Ysrc = (const float*)(ws + WS_Y); float* Y2 = (float*)(ws + WS_F + 64 * MiB);
                for (size_t i = (size_t)blockIdx.x * 512 + threadIdx.x; i < (size_t)M_CTX * D; i += (size_t)F.G * 512) Y2[i] = Ysrc[i];
            }
#endif
            {   pg8::Gemm g{Hb, (const bf16*)(ws + WS_WD + (size_t)(l * 2) * SZ_WD), M_LAT, D, FF, FF}; pg8::StaticOrder S; S.init(M_LAT, D, F.G, (int)blockIdx.x, DN_WGM);
                if constexpr (l == 0) { EpiResidF32 E{args.in[0], XB, modl + 2 * D, 0.5f}; pg8::gemm_phase<EpiResidF32, pg8::StaticOrder, true, true>(F.lds + RING_OFF, g, S, E); }
                else { EpiResid E{XB, XB, modl + 2 * D, 0.5f}; pg8::gemm_phase<EpiResid, pg8::StaticOrder, true, true>(F.lds + RING_OFF, g, S, E); } }
            __syncthreads();
            {   pg8::Gemm g{Hb, (const bf16*)(ws + WS_WD + (size_t)(l * 2) * SZ_WD), M_CTX, D, FF / CTX_P, FF}; ClaimOrder S{D / 256, CTX_P, (FF / CTX_P) * 2, (unsigned*)(ws + 944 * 1024 + l * 64), (volatile LAS unsigned*)(F.lds + MISC_OFF) + 40};
                EpiPartial E{PARTc, modl + 2 * D, 0.5f, (FF / CTX_P) * 2};
                pg8::gemm_phase<EpiPartial, ClaimOrder, true, true>(F.lds + RING_OFF, g, S, E); }
#ifdef CTX_CHECK
            if constexpr (l == 0) {
                __syncthreads();
                pg8::Gemm g{Hb, (const bf16*)(ws + WS_WD + (size_t)(l * 2) * SZ_WD), M_CTX, D, FF, FF}; SplitKOrder S{D / 256, 1, 0, F.G, (int)blockIdx.x};
                EpiResidAtomic E{(float*)(ws + WS_F + 64 * MiB) - (size_t)M_LAT * D, modl + 2 * D, 0.5f};
                pg8::gemm_phase<EpiResidAtomic, SplitKOrder, true, true>(F.lds + RING_OFF, g, S, E);
            }
#endif
        } SEAM(pb + 2);
        if (IN(pb + 3)) { ph_norm<false, CTX_P>(F, XB, Yc, M_ALL, ng + D, modl, 1, XN, PARTc, Yc); } SEAM(pb + 3);
#ifdef CTX_CHECK
        if constexpr (l == 0) {
            const float* Ysrc = (const float*)(ws + WS_Y); const float* Y2 = (const float*)(ws + WS_F + 64 * MiB); float md = 0.f, mv = 0.f;
            for (size_t i = (size_t)blockIdx.x * 512 + threadIdx.x; i < (size_t)M_CTX * D; i += (size_t)F.G * 512) {
                const float a = __builtin_nontemporal_load(Ysrc + i), c = __builtin_nontemporal_load(Y2 + i); md = fmaxf(md, fabsf(a - c) / (fabsf(a) + 1.0f)); mv = fmaxf(mv, fabsf(a - args.in[2][i])); }
            atomicMax((unsigned*)(ws + 940 * 1024), __float_as_uint(md)); atomicMax((unsigned*)(ws + 940 * 1024 + 4), __float_as_uint(mv));
        }
#endif
        int pn2;
        if constexpr (l == 0) {
            bf16* Ub = (bf16*)(ws + WS_U); bf16* Vb = (bf16*)(ws + WS_V); float* stats = (float*)(ws + WS_STATS);
            if (IN(6)) {
                pg8::Gemm g{XN, (const bf16*)(ws + WS_GMIN), M_ALL, 4096, D, D}; pg8::StaticOrder S; S.init(M_ALL, 4096, F.G, (int)blockIdx.x);
                EpiGeluUV E{Ub, Vb, stats};
                pg8::gemm_phase<EpiGeluUV, pg8::StaticOrder, true, true>(F.lds + RING_OFF, g, S, E);
            } SEAM(6);
            if (IN(7)) { REPEAT(7) { ph_gm_mix(F, Ub, Vb, stats, args.in[11], args.in[12], args.in[13], args.in[14], (PROBE_PH == 7 && rep_ + 1 < PROBE_N) ? (bf16*)(ws + WS_VV) : nullptr); } } SEAM(7);
            if (IN(8)) {
                {   pg8::Gemm g{Ub, (const bf16*)(ws + WS_GMOUT), M_LAT, D, D, D}; pg8::StaticOrder S; S.init(M_LAT, D, F.G, (int)blockIdx.x);
                    EpiResid E{XB, XB, modl + 5 * D, 1.0f};
                    pg8::gemm_phase<EpiResid, pg8::StaticOrder, true, true>(F.lds + RING_OFF, g, S, E); }
                __syncthreads();
                {   pg8::Gemm g{Ub, (const bf16*)(ws + WS_GMOUT), M_CTX, D, D / 4, D}; SplitKOrder S{D / 256, 4, (D / 4) * 2, F.G, (int)blockIdx.x};
                    EpiResidAtomic E{Yc, modl + 5 * D, 1.0f};
                    pg8::gemm_phase<EpiResidAtomic, SplitKOrder, true, true>(F.lds + RING_OFF, g, S, E); }
            } SEAM(8);
            pn2 = 9;
        } else {
            float* Fm = (float*)(ws + WS_F); bf16* CQ = (bf16*)(ws + WS_CQ); bf16* CKV = (bf16*)(ws + WS_CKV); bf16* KPE = (bf16*)(ws + WS_KPE);
            bf16* Qb = (bf16*)(ws + WS_Q); bf16* KN = (bf16*)(ws + WS_KN); bf16* VV = (bf16*)(ws + WS_VV); bf16* Ob = XN;
            if (IN(16)) {
                pg8::Gemm g{XN, (const bf16*)(ws + WS_WDQKV), M_ALL, NDQKV, D, D}; pg8::StaticOrder S; S.init(M_ALL, NDQKV, F.G, (int)blockIdx.x);
                EpiF32 E{Fm, NDQKV};
                pg8::gemm_phase<EpiF32, pg8::StaticOrder, true, true>(F.lds + RING_OFF, g, S, E);
            } SEAM(16);
            if (IN(17)) { ph_mla_norm(F, Fm, args.in[17], args.in[20], ROPEt, CQ, CKV, KPE); } SEAM(17);
            if (IN(18)) REPEAT(18) {
                {   pg8::Gemm g{CQ, (const bf16*)(ws + WS_WUQ), M_LAT, 3072, KQ, KQ}; pg8::StaticOrder S; S.init(M_LAT, 3072, F.G, (int)blockIdx.x);
                    EpiQRope E{Qb, ROPEt};
                    pg8::gemm_phase<EpiQRope, pg8::StaticOrder, true, true>(F.lds + RING_OFF, g, S, E); }
                __syncthreads();
                {   pg8::Gemm g{CKV, (const bf16*)(ws + WS_WUKV), M_ALL, 4096, KKV, KKV}; pg8::StaticOrder S; S.init(M_ALL, 4096, F.G, (int)blockIdx.x);
                    EpiKV E{KN, VV};
                    pg8::gemm_phase<EpiKV, pg8::StaticOrder, true, true>(F.lds + RING_OFF, g, S, E); }
            } SEAM(18);
            if (IN(19)) REPEAT(19) {
#ifdef CLK_PROBE
                const unsigned long long ct0_ = __builtin_amdgcn_s_memtime(), cr0_ = __builtin_amdgcn_s_memrealtime();
#endif
                __syncthreads();
                for (int L = F.vcu; L < NB * NHEAD * (SEQ / 256); L += F.G) {
                    const int qb = L & 63, bh = L >> 6, b = bh >> 4, h = bh & 15;
#ifdef ATT_ABL
                    if (PROBE_PH == 19 && rep_ + 1 < PROBE_N) att::attn_unit_dma<ATT_ABL>(Qb + (size_t)(b * SEQ + qb * 256) * 3072 + h * DQK, KN + h * DVH, KPE, VV + h * DVH, Ob + (size_t)(b * SEQ + qb * 256) * D + h * DVH, b, (LAS char*)F.lds);
                    else
#endif
                    att::ATTN_MAIN(Qb + (size_t)(b * SEQ + qb * 256) * 3072 + h * DQK, KN + h * DVH, KPE, VV + h * DVH, Ob + (size_t)(b * SEQ + qb * 256) * D + h * DVH, b, (LAS char*)F.lds);
                }
                __syncthreads();
#ifdef CLK_PROBE
                if (blockIdx.x == CLK_PROBE && threadIdx.x == 0) { const unsigned long long dt_ = __builtin_amdgcn_s_memtime() - ct0_, dr_ = __builtin_amdgcn_s_memrealtime() - cr0_;
                    const int q_ = (int)((dt_ + dr_ / 2) / dr_); __hip_atomic_store((int*)(args.ws + 950 * 1024), (dt_ * 10 >= dr_ * 190) ? 20000 : 10000, __ATOMIC_RELAXED, __HIP_MEMORY_SCOPE_AGENT); }
#endif
            } SEAM(19);
            if (IN(20)) {
                pg8::Gemm g{Ob, (const bf16*)(ws + WS_WO), M_LAT, D, D, D}; pg8::StaticOrder S; S.init(M_LAT, D, F.G, (int)blockIdx.x);
                EpiResid E{XB, XB, modl + 5 * D, 1.0f};
                pg8::gemm_phase<EpiResid, pg8::StaticOrder, true, true>(F.lds + RING_OFF, g, S, E);
            } SEAM(20);
            pn2 = 21;
        }
        const int M2 = l == 0 ? M_ALL : M_LAT;
        if (IN(pn2)) { ph_norm<false>(F, XB, Yc, M2, ng + 2 * D, modl, 2, XN); } SEAM(pn2);
        if (IN(pn2 + 1)) {
            pg8::Gemm g{XN, (const bf16*)(ws + WS_WGU + (size_t)(l * 2 + 1) * SZ_WGU), M2, NGU, D, D}; pg8::StaticOrder S; S.init(M2, NGU, F.G, (int)blockIdx.x, GU_WGM);
            EpiSwiGLU E{Hb};
            pg8::gemm_phase<EpiSwiGLU, pg8::StaticOrder, true, true>(F.lds + RING_OFF, g, S, E);
        } SEAM(pn2 + 1);
        if (IN(pn2 + 2)) {
            {   pg8::Gemm g{Hb, (const bf16*)(ws + WS_WD + (size_t)(l * 2 + 1) * SZ_WD), M_LAT, D, FF, FF}; pg8::StaticOrder S; S.init(M_LAT, D, F.G, (int)blockIdx.x, DN_WGM);
                EpiResid E{XB, XB, modl + 8 * D, 0.5f};
                pg8::gemm_phase<EpiResid, pg8::StaticOrder, true, true>(F.lds + RING_OFF, g, S, E); }
            if constexpr (l == 0) {
                __syncthreads();
                pg8::Gemm g{Hb, (const bf16*)(ws + WS_WD + (size_t)(l * 2 + 1) * SZ_WD), M_CTX, D, FF / CTX_P, FF}; ClaimOrder S{D / 256, CTX_P, (FF / CTX_P) * 2, (unsigned*)(ws + 944 * 1024 + 128), (volatile LAS unsigned*)(F.lds + MISC_OFF) + 40};
                EpiPartial E{PARTc, modl + 8 * D, 0.5f, (FF / CTX_P) * 2};
                pg8::gemm_phase<EpiPartial, ClaimOrder, true, true>(F.lds + RING_OFF, g, S, E);
            }
        } SEAM(pn2 + 2);
    }

__global__ void __launch_bounds__(NWAVES * 64, 2) mk_fwd(Args args) {
    extern __shared__ __attribute__((aligned(16))) unsigned char lds[];
    Frame F;
    F.lds = (LAS unsigned char*)lds;
    F.wave = __builtin_amdgcn_readfirstlane((int)threadIdx.x >> 6);
    F.G = gridDim.x; { const int bx = blockIdx.x; F.vcu = (F.G % 8 == 0) ? (bx % 8) * (F.G / 8) + bx / 8 : bx; }
    unsigned char* ws = args.ws;
    F.ctl = (gu32*)(ws + WS_CTL);
    volatile LAS unsigned* MISC = (volatile LAS unsigned*)(F.lds + MISC_OFF);
    for (int u = threadIdx.x; u < (LDS_BYTES - MISC_OFF) / 4; u += NWAVES * 64) ((LAS unsigned*)(F.lds + MISC_OFF))[u] = 0u;
    __syncthreads();
#if MK_SPLIT
    XcdBarrier bar; bar.bar = (unsigned*)(F.ctl + CW_BAR); bar.x = 0; bar.st = nullptr;
#else
    XcdBarrier bar = xcd_barrier_post((unsigned*)(F.ctl + CW_BAR), MISC + 8);
#endif
    const int lo = args.ph_lo, hi = args.ph_hi;

    float* X = args.out;
    float* Yc = (float*)(ws + WS_Y) - (size_t)M_LAT * D;
    const float* XinC = args.in[2] - (size_t)M_LAT * D;
    bf16* XN = (bf16*)args.out;
    bf16* XB = (bf16*)(ws + WS_XB);
    bf16* Hb = (bf16*)(ws + WS_BIG);
    const float* MOD = (const float*)(ws + WS_MOD);
    const float* ROPEt = (const float*)(ws + WS_ROPE);

#ifdef CLK_PROBE0
    const unsigned long long ct00_ = __builtin_amdgcn_s_memtime(), cr00_ = __builtin_amdgcn_s_memrealtime();
#endif
    if (IN(0)) { REPEAT(0) { ph_prologue(F, args); __syncthreads(); } }
#ifdef CLK_PROBE0
    if (blockIdx.x == CLK_PROBE && threadIdx.x == 0) { const unsigned long long dt_ = __builtin_amdgcn_s_memtime() - ct00_, dr_ = __builtin_amdgcn_s_memrealtime() - cr00_;
        __hip_atomic_store((int*)(args.ws + 950 * 1024 + 64), (dt_ * 10 >= dr_ * CLK_PROBE0) ? 20000 : 10000, __ATOMIC_RELAXED, __HIP_MEMORY_SCOPE_AGENT); }
#endif
    SEAM(0);
    if (IN(1)) { ph_modreduce(F, args); } SEAM(1);

    layer_body<0>(F, args, lo, hi, bar);
    layer_body<1>(F, args, lo, hi, bar);
    if (IN(24)) { ph_final(F, (const bf16*)(ws + WS_XB), args.out, args.in[23]); }
#ifdef CTX_CHECK
    GRID_BAR();
    if (blockIdx.x == 0 && threadIdx.x == 0) {
        const float md = __uint_as_float(__hip_atomic_load((unsigned*)(args.ws + 940 * 1024), __ATOMIC_RELAXED, __HIP_MEMORY_SCOPE_AGENT));
        const float mv = __uint_as_float(__hip_atomic_load((unsigned*)(args.ws + 940 * 1024 + 4), __ATOMIC_RELAXED, __HIP_MEMORY_SCOPE_AGENT));
        args.out[7] = (md < 1e-3f) ? ((mv > 1e-2f) ? 1000.0f : 5000.0f) : 9000.0f; }
#endif
#ifdef CLK_PROBE
    GRID_BAR();
    if (blockIdx.x == 0 && threadIdx.x == 0) {
#ifdef CLK_PROBE0
        const int v = __hip_atomic_load((int*)(args.ws + 950 * 1024 + 64), __ATOMIC_RELAXED, __HIP_MEMORY_SCOPE_AGENT);
#else
        const int v = __hip_atomic_load((int*)(args.ws + 950 * 1024), __ATOMIC_RELAXED, __HIP_MEMORY_SCOPE_AGENT);
#endif
        args.out[7] = (float)v; }
#endif
#undef IN
#undef SEAM
#undef GRID_BAR
}

extern "C" void kernel_launch(void* const* d_in, const int* in_sizes, int n_in, void* d_out, int out_size, void* d_ws, size_t ws_size, hipStream_t stream) {
    static int grid = 0;
    if (grid == 0) {
        if (n_in != 24 || in_sizes[0] != M_LAT * D || out_size != M_LAT * D || ws_size < WS_END) {
            fprintf(stderr, "kernel_launch: shape mismatch: n_in %d in0 %d out %d ws %zu (need %zu)\n", n_in, n_in > 0 ? in_sizes[0] : -1, out_size, ws_size, (size_t)WS_END); grid = -1; return; }
        int dev = 0, cus = 0, per_cu = 0;
        if (hipGetDevice(&dev) != hipSuccess || hipDeviceGetAttribute(&cus, hipDeviceAttributeMultiprocessorCount, dev) != hipSuccess) { grid = -1; return; }
        if (hipFuncSetAttribute((const void*)mk_fwd, hipFuncAttributeMaxDynamicSharedMemorySize, LDS_BYTES) != hipSuccess) { fprintf(stderr, "kernel_launch: hipFuncSetAttribute failed\n"); grid = -1; return; }
        if (hipOccupancyMaxActiveBlocksPerMultiprocessor(&per_cu, (const void*)mk_fwd, NWAVES * 64, LDS_BYTES) != hipSuccess || per_cu < 1)
            fprintf(stderr, "kernel_launch: note: occupancy query reports %d workgroups per CU\n", per_cu);
        (void)hipGetLastError();
        grid = cus;
    }
    if (grid < 0) return;
    if (hipMemsetAsync((char*)d_ws + WS_CTL, 0, CTL_ZERO_BYTES, stream) != hipSuccess) { fprintf(stderr, "kernel_launch: memset failed\n"); return; }
    Args a{};
    for (int i = 0; i < 24; ++i) a.in[i] = (const float*)d_in[i];
    a.out = (float*)d_out; a.ws = (unsigned char*)d_ws;
#if MK_SPLIT
    for (int p = 0; p < N_PHASES; ++p) { a.ph_lo = p; a.ph_hi = p + 1;
        hipLaunchKernelGGL(mk_fwd, dim3(grid), dim3(NWAVES * 64), LDS_BYTES, stream, a); }
#else
    a.ph_lo = 0; a.ph_hi = N_PHASES;
    hipLaunchKernelGGL(mk_fwd, dim3(grid), dim3(NWAVES * 64), LDS_BYTES, stream, a);
#endif
    const hipError_t le = hipPeekAtLastError();
    if (le != hipSuccess) fprintf(stderr, "kernel_launch: launch failed: %s\n", hipGetErrorName(le));
}
```

```cpp
#include <hip/hip_runtime.h>
#include <cstdio>
#include <cstdint>

namespace pg8 {
#define PG8_LAS __attribute__((address_space(3)))
typedef unsigned short bf16_t;
typedef short bf16x8 __attribute__((ext_vector_type(8)));
typedef float f32x4 __attribute__((ext_vector_type(4)));
typedef unsigned u32x4 __attribute__((ext_vector_type(4)));
constexpr int BM = 256, BK = 64, HALF = 128, HTB = HALF * BK * 2  , STAGE_BYTES = 8 * HTB, NXCD = 8, WGM = 8;

__host__ __device__ __forceinline__ int lds_byte(int r, int c) { const int st = (r >> 4) * 2 + (c >> 5), rr = r & 15, cc = c & 31, ob = rr * 64 + cc * 2; return st * 1024 + (ob ^ (((ob >> 9) & 1) << 5)); }
__host__ __device__ __forceinline__ void stage_rc(int b, int& R, int& C) { const int st = b / 1024, sb = b % 1024, swz = sb ^ (((sb >> 9) & 1) << 5); R = (st >> 1) * 16 + swz / 64; C = (st & 1) * 32 + (swz % 64) / 2; }
__host__ __device__ __forceinline__ int perm32(int rho) { const int n = rho >> 4, i = rho & 15; return 8 * (i >> 2) + 4 * n + (i & 3); }

struct Unit { int pm, pn, kofs; };
struct Gemm { const bf16_t* A; const bf16_t* Bt; int M, N, K, ld; };

struct StaticOrder {
    int nM, nN, nwg, G, c, wgm;
    __host__ __device__ void init(int M, int N, int G_, int c_, int wgm_ = WGM) { nM = M / BM; nN = N / BM; nwg = nM * nN; G = G_; c = c_; wgm = wgm_; }
    __host__ __device__ bool next(int i, Unit& u) const {
        const long L = (long)i * G + c; if (L >= nwg) return false;
        int wgid = (int)L; { const int q = nwg / NXCD, r = nwg % NXCD, xcd = wgid % NXCD, off = wgid / NXCD; wgid = (xcd < r ? xcd * (q + 1) : r * (q + 1) + (xcd - r) * q) + off; }
        const int nig = wgm * nN, gid = wgid / nig, fm = gid * wgm, gsz = (nM - fm) < wgm ? (nM - fm) : wgm;
        u.pm = fm + ((wgid % nig) % gsz); u.pn = (wgid % nig) / gsz; u.kofs = 0; return true;
    }
    __device__ __forceinline__ void a_ready(const Unit&) const {}
    __device__ __forceinline__ void done(const Unit&) const {}
};

__device__ __forceinline__ unsigned cvt_pk_bf16(float lo, float hi) { unsigned r; asm volatile("v_cvt_pk_bf16_f32 %0, %1, %2" : "=v"(r) : "v"(lo), "v"(hi)); return r; }
typedef float f32x2 __attribute__((ext_vector_type(2)));
template <class Epi, class Sched, bool ALIGN_EPI = false, bool SP2 = false>
__device__ __forceinline__ void gemm_phase(PG8_LAS unsigned char* lds, const Gemm g, const Sched& S, const Epi& E) {
    int tid_l = threadIdx.x; asm volatile("" : "+v"(tid_l));
    const int tid = tid_l, wid = __builtin_amdgcn_readfirstlane(tid >> 6), lane = tid & 63, wr = wid >> 2, wc = wid & 3, fr = lane & 15, fq = lane >> 4;
    const int K = g.K, nt = K / BK, LD = g.ld;
    unsigned voffA[2], voffB[2];
#pragma unroll
    for (int i = 0; i < 2; ++i) { int R, C; stage_rc(tid * 16 + i * 8192, R, C); const int Rb = Epi::PERM ? ((R & ~31) + perm32(R & 31)) : R;
        voffA[i] = (unsigned)(R * LD + C) * 2u; voffB[i] = (unsigned)(Rb * LD + C) * 2u; }
    const size_t kstep = (size_t)(BK * 2);
    const size_t hstep = (size_t)HALF * LD * 2;
    const size_t tstep = 2 * hstep;
    const unsigned ldsw = (unsigned)wid * 1024u;
    const int aoff = lds_byte(wr * 64 + fr, fq * 8), boff = lds_byte(wc * 32 + fr, fq * 8);
#define PG8_SA(b, h) (((b) * 2 + (h)) * HTB)
#define PG8_SB(b, h) ((4 + (b) * 2 + (h)) * HTB)
#define PG8_STAGE(bufoff, gbase, voff) do { _Pragma("unroll") for (int _i = 0; _i < 2; ++_i) \
        __builtin_amdgcn_global_load_lds((const unsigned*)((const char*)(gbase) + (voff)[_i]), (PG8_LAS unsigned*)(lds + (bufoff) + ldsw + _i * 8192), 16, 0, 0); } while (0)
#define PG8_LDA(dst, b, h) do { _Pragma("unroll") for (int m = 0; m < 4; ++m) _Pragma("unroll") for (int k = 0; k < 2; ++k) dst[m][k] = *(const PG8_LAS bf16x8*)(lds + PG8_SA(b, h) + aoff + m * 2048 + k * 1024); } while (0)
#define PG8_LDB(dst, b, h) do { _Pragma("unroll") for (int n = 0; n < 2; ++n) _Pragma("unroll") for (int k = 0; k < 2; ++k) dst[n][k] = *(const PG8_LAS bf16x8*)(lds + PG8_SB(b, h) + boff + n * 2048 + k * 1024); } while (0)
#define PG8_MMA(ai, bj, At, Bt) do { __builtin_amdgcn_s_setprio(1); _Pragma("unroll") for (int m = 0; m < 4; ++m) _Pragma("unroll") for (int n = 0; n < 2; ++n) _Pragma("unroll") for (int k = 0; k < 2; ++k) \
        acc[ai][bj][m][n] = __builtin_amdgcn_mfma_f32_16x16x32_bf16(Bt[n][k], At[m][k], acc[ai][bj][m][n], 0, 0, 0); __builtin_amdgcn_s_setprio(0); } while (0)
#define PG8_WAIT_V(n) asm volatile("s_waitcnt vmcnt(" #n ")" ::: "memory")
#define PG8_WAIT_L(n) asm volatile("s_waitcnt lgkmcnt(" #n ")" ::: "memory")
#define PG8_BAR __builtin_amdgcn_s_barrier()
#define PG8_SCHED __builtin_amdgcn_sched_barrier(0)
    Unit cur, nxt; int ui = 0;
    if (!S.next(0, cur)) return;
    f32x4 acc[2][2][4][2];
#pragma unroll
    for (int a = 0; a < 2; ++a)
#pragma unroll
        for (int b = 0; b < 2; ++b)
#pragma unroll
            for (int m = 0; m < 4; ++m)
#pragma unroll
                for (int n = 0; n < 2; ++n) acc[a][b][m][n] = (f32x4){0.f, 0.f, 0.f, 0.f};
    bf16x8 At[4][2], B0[2][2], B1[2][2];
    const char* cA = (const char*)g.A + (size_t)cur.pm * tstep + cur.kofs; const char* cB = (const char*)g.Bt + (size_t)cur.pn * tstep + cur.kofs;
    S.a_ready(cur);
    if constexpr (SP2) {
        PG8_STAGE(PG8_SB(0, 0), cB, voffB); PG8_STAGE(PG8_SB(0, 1), cB + hstep, voffB); PG8_STAGE(PG8_SA(0, 0), cA, voffA); PG8_STAGE(PG8_SA(0, 1), cA + hstep, voffA);
        if (wr == 1) PG8_BAR;
        PG8_WAIT_V(2); PG8_BAR;
        PG8_STAGE(PG8_SB(1, 0), cB + kstep, voffB); PG8_STAGE(PG8_SA(1, 0), cA + kstep, voffA); PG8_STAGE(PG8_SB(1, 1), cB + hstep + kstep, voffB);
        PG8_WAIT_V(6); PG8_BAR;
    } else {
        PG8_STAGE(PG8_SB(0, 0), cB, voffB); PG8_STAGE(PG8_SA(0, 0), cA, voffA); PG8_STAGE(PG8_SB(0, 1), cB + hstep, voffB); PG8_STAGE(PG8_SA(0, 1), cA + hstep, voffA);
        if (wr == 1) PG8_BAR;
        PG8_WAIT_V(4); PG8_BAR;
        PG8_STAGE(PG8_SB(1, 0), cB + kstep, voffB); PG8_STAGE(PG8_SA(1, 0), cA + kstep, voffA); PG8_STAGE(PG8_SB(1, 1), cB + hstep + kstep, voffB);
        PG8_WAIT_V(6); PG8_BAR;
    }
    for (;;) {
        const bool has_next = S.next(ui + 1, nxt);
        const char* nA = has_next ? (const char*)g.A + (size_t)nxt.pm * tstep + nxt.kofs : cA; const char* nB = has_next ? (const char*)g.Bt + (size_t)nxt.pn * tstep + nxt.kofs : cB;
        for (int t = 0; t < nt; t += 2) {
            const bool last = (t == nt - 2);
            const char* a1 = cA + (size_t)(t + 1) * kstep;
            const char* a2 = last ? nA : cA + (size_t)(t + 2) * kstep; const char* b2 = last ? nB : cB + (size_t)(t + 2) * kstep;
            const char* a3 = a2 + kstep; const char* b3 = b2 + kstep;
            if (last && has_next) S.a_ready(nxt);
            if constexpr (SP2) {
            PG8_LDB(B0, 0, 0); PG8_LDB(B1, 0, 1); PG8_SCHED; PG8_LDA(At, 0, 0); PG8_STAGE(PG8_SA(1, 1), a1 + hstep, voffA);
            PG8_WAIT_V(8); PG8_WAIT_L(0); PG8_BAR; PG8_MMA(0, 0, At, B0); PG8_MMA(0, 1, At, B1); PG8_BAR; PG8_SCHED;
            PG8_LDA(At, 0, 1); PG8_STAGE(PG8_SB(0, 0), b2, voffB); PG8_STAGE(PG8_SB(0, 1), b2 + hstep, voffB); PG8_STAGE(PG8_SA(0, 0), a2, voffA);
            PG8_WAIT_V(8); PG8_WAIT_L(0); PG8_BAR; PG8_MMA(1, 0, At, B0); PG8_MMA(1, 1, At, B1); PG8_BAR; PG8_SCHED;
            PG8_LDB(B0, 1, 0); PG8_LDB(B1, 1, 1); PG8_SCHED; PG8_LDA(At, 1, 0); PG8_STAGE(PG8_SA(0, 1), a2 + hstep, voffA);
            PG8_WAIT_V(8); PG8_WAIT_L(0); PG8_BAR; PG8_MMA(0, 0, At, B0); PG8_MMA(0, 1, At, B1); PG8_BAR; PG8_SCHED;
            PG8_LDA(At, 1, 1); PG8_STAGE(PG8_SB(1, 0), b3, voffB); PG8_STAGE(PG8_SB(1, 1), b3 + hstep, voffB); PG8_STAGE(PG8_SA(1, 0), a3, voffA);
            PG8_WAIT_V(8); PG8_WAIT_L(0); PG8_BAR; PG8_MMA(1, 0, At, B0); PG8_MMA(1, 1, At, B1); PG8_BAR; PG8_SCHED;
            } else {
            PG8_LDB(B0, 0, 0); PG8_SCHED; PG8_LDA(At, 0, 0); PG8_STAGE(PG8_SA(1, 1), a1 + hstep, voffA);
            PG8_WAIT_L(8); PG8_BAR; PG8_WAIT_L(0); PG8_MMA(0, 0, At, B0); PG8_BAR; PG8_SCHED;
            PG8_LDB(B1, 0, 1); PG8_STAGE(PG8_SB(0, 0), b2, voffB);
            PG8_BAR; PG8_WAIT_L(0); PG8_MMA(0, 1, At, B1); PG8_BAR;
            PG8_LDA(At, 0, 1); PG8_STAGE(PG8_SA(0, 0), a2, voffA);
            PG8_BAR; PG8_WAIT_L(0); PG8_MMA(1, 0, At, B0); PG8_BAR; PG8_SCHED;
            PG8_STAGE(PG8_SB(0, 1), b2 + hstep, voffB);
            PG8_WAIT_V(6); PG8_BAR; PG8_MMA(1, 1, At, B1); PG8_BAR;
            PG8_LDB(B0, 1, 0); PG8_SCHED; PG8_LDA(At, 1, 0); PG8_STAGE(PG8_SA(0, 1), a2 + hstep, voffA);
            PG8_WAIT_L(8); PG8_BAR; PG8_WAIT_L(0); PG8_MMA(0, 0, At, B0); PG8_BAR; PG8_SCHED;
            PG8_LDB(B1, 1, 1); PG8_STAGE(PG8_SB(1, 0), b3, voffB);
            PG8_BAR; PG8_WAIT_L(0); PG8_MMA(0, 1, At, B1); PG8_BAR;
            PG8_LDA(At, 1, 1); PG8_STAGE(PG8_SA(1, 0), a3, voffA);
            PG8_BAR; PG8_WAIT_L(0); PG8_MMA(1, 0, At, B0); PG8_BAR; PG8_SCHED;
            PG8_STAGE(PG8_SB(1, 1), b3 + hstep, voffB);
            PG8_WAIT_V(6); PG8_BAR; PG8_MMA(1, 1, At, B1); PG8_BAR;
            }
        }
        if constexpr (ALIGN_EPI) { if (wr == 0) PG8_BAR; }
        if constexpr (!Epi::AFTER_DRAIN) { E(acc, cur, wr, wc, fr, fq); S.done(cur); }
        if (!has_next) break;
#pragma unroll
        for (int a = 0; a < 2; ++a)
#pragma unroll
            for (int b = 0; b < 2; ++b)
#pragma unroll
                for (int m = 0; m < 4; ++m)
#pragma unroll
                    for (int n = 0; n < 2; ++n) acc[a][b][m][n] = (f32x4){0.f, 0.f, 0.f, 0.f};
        cur = nxt; cA = nA; cB = nB; ++ui;
        if constexpr (ALIGN_EPI) { if (wr == 1) PG8_BAR; }
    }
    PG8_WAIT_V(0);
    if constexpr (!ALIGN_EPI) { if (wr == 0) PG8_BAR; }
    PG8_BAR;
    if constexpr (Epi::AFTER_DRAIN) { E.fused(acc, cur, wr, wc, fr, fq, lds, wid, lane); S.done(cur); }
#undef PG8_SA
#undef PG8_SB
#undef PG8_STAGE
#undef PG8_LDA
#undef PG8_LDB
#undef PG8_MMA
#undef PG8_WAIT_V
#undef PG8_WAIT_L
#undef PG8_BAR
#undef PG8_SCHED
}
}
#define GAS __attribute__((address_space(1)))
#define LAS __attribute__((address_space(3)))
typedef unsigned short bf16;
typedef unsigned v4u __attribute__((ext_vector_type(4)));
typedef float f32x4 __attribute__((ext_vector_type(4)));
typedef short bf16x8 __attribute__((ext_vector_type(8)));
typedef GAS unsigned gu32;
typedef GAS unsigned long long gu64;
#define RLX_AGENT __ATOMIC_RELAXED, __HIP_MEMORY_SCOPE_AGENT
#define LDS_WAIT() asm volatile("s_waitcnt lgkmcnt(0)" ::: "memory")
#define VM_WAIT() asm volatile("s_waitcnt vmcnt(0)" ::: "memory")
__device__ __forceinline__ unsigned long long rt() { return __builtin_amdgcn_s_memrealtime(); }
__device__ __forceinline__ unsigned f2bf(float f) { unsigned u = __builtin_bit_cast(unsigned, f); return (u + 0x7fffu + ((u >> 16) & 1u)) >> 16; }
__device__ __forceinline__ unsigned pk2(float lo, float hi) { return f2bf(lo) | (f2bf(hi) << 16); }

#define XB_TMO      128
#define XB_XCNT(j)  (256  + 64 * (j))
#define XB_XSUB(j)  (1280 + 64 * (j))
#define XB_XGEN(j)  (2304 + 64 * (j))
#define XB_TOP      3328
#define XB_TOPGEN   3392
#define XCD_BAR_WORDS 3456
#define XB_SPIN_CAP (1u << 18)

__device__ __forceinline__ unsigned xb_ld(unsigned* p)              { return __hip_atomic_load(p, __ATOMIC_RELAXED, __HIP_MEMORY_SCOPE_AGENT); }
__device__ __forceinline__ unsigned xb_add(unsigned* p, unsigned v) { return __hip_atomic_fetch_add(p, v, __ATOMIC_RELAXED, __HIP_MEMORY_SCOPE_AGENT); }
__device__ __forceinline__ unsigned xb_xcc_id() { return (unsigned)__builtin_amdgcn_s_getreg((3 << 11) | 20) & 0xFu; }
#define XB_SPIN(cond, bar) do { unsigned _sp = 0; while (cond) { __builtin_amdgcn_s_sleep(1); \
    if ((++_sp & 255u) == 0u) { if (xb_ld(&(bar)[XB_TMO])) break; if (_sp > XB_SPIN_CAP) { atomicAdd(&(bar)[XB_TMO], 1u); break; } } } } while (0)

struct XcdBarrier {
    unsigned* bar; unsigned x;
    volatile LAS unsigned* st;
};

__device__ __forceinline__ XcdBarrier xcd_barrier_post(unsigned* bar, volatile LAS unsigned* st) {
    XcdBarrier b; b.bar = bar; b.x = xb_xcc_id(); b.st = st;
    if (threadIdx.x == 0) (void)xb_add(&bar[XB_XCNT(b.x)], 1u);
    return b;
}
__device__ __forceinline__ void xcd_barrier_complete(unsigned* bar, unsigned x, unsigned& nloc, unsigned& nx) {
    const unsigned G = gridDim.x * gridDim.y * gridDim.z;
    unsigned sum, cnt, mine, sp = 0u;
    for (;;) {
        sum = 0u; cnt = 0u; mine = 0u;
#pragma unroll
        for (unsigned j = 0; j < 16; ++j) { const unsigned c = xb_ld(&bar[XB_XCNT(j)]); sum += c; cnt += (c > 0u) ? 1u : 0u; mine = (j == x) ? c : mine; }
        if (sum == G) break;
        __builtin_amdgcn_s_sleep(1);
        if ((++sp & 255u) == 0u) { if (xb_ld(&bar[XB_TMO])) break; if (sp > XB_SPIN_CAP) { atomicAdd(&bar[XB_TMO], 1u); break; } }
    }
    nloc = mine > 0u ? mine : 1u; nx = cnt > 0u ? cnt : 1u;
}

__device__ __forceinline__ void xcd_barrier(const XcdBarrier& b) {
    asm volatile("s_waitcnt vmcnt(0)" ::: "memory");
    __syncthreads();
    if (threadIdx.x == 0) {
        unsigned* bar = b.bar;
        __builtin_amdgcn_s_waitcnt(0);
        unsigned nloc = b.st[0], nx = b.st[1];
        if (nloc == 0u) { xcd_barrier_complete(bar, b.x, nloc, nx); b.st[0] = nloc; b.st[1] = nx; }
        const unsigned old = xb_add(&bar[XB_XSUB(b.x)], 1u);
        const unsigned gen = old / nloc;
        if (old + 1u == (gen + 1u) * nloc) {
            __builtin_amdgcn_fence(__ATOMIC_RELEASE, "agent");
            asm volatile("s_waitcnt vmcnt(0)" ::: "memory");
            const unsigned og = xb_add(&bar[XB_TOP], 1u);
            const unsigned tg = og / nx;
            if (og + 1u == (tg + 1u) * nx) xb_add(&bar[XB_TOPGEN], 1u);
            else XB_SPIN(xb_ld(&bar[XB_TOPGEN]) == tg, bar);
            __builtin_amdgcn_fence(__ATOMIC_ACQUIRE, "agent");
            xb_add(&bar[XB_XGEN(b.x)], 1u);
            asm volatile("s_waitcnt vmcnt(0)" ::: "memory");
        } else {
            XB_SPIN(xb_ld(&bar[XB_XGEN(b.x)]) == gen, bar);
            __builtin_amdgcn_fence(__ATOMIC_ACQUIRE, "agent");
            asm volatile("s_waitcnt vmcnt(0)" ::: "memory");
        }
    }
    __syncthreads();
}

typedef float f32x16 __attribute__((ext_vector_type(16)));
typedef short s16x4 __attribute__((ext_vector_type(4)));
typedef unsigned u32x2 __attribute__((ext_vector_type(2)));

constexpr int D = 2048, FF = 5632, NGU = 2 * FF, SEQ = 16384, NB = 2, CTXL = 256;
constexpr int M_LAT = NB * SEQ;
constexpr int M_CTX = NB * CTXL;
constexpr int M_ALL = M_LAT + M_CTX;
constexpr int NMODV = 9 * D;
constexpr int QLORA = 448, KVLORA = 160, ROPE = 64, NHEAD = 16, DQK = 192, DVH = 128;
constexpr int NDQKV = 768;
constexpr int KQ = 512, KKV = 256;
constexpr float EPS = 1e-6f;
constexpr int KSPLIT = 14;
constexpr int NWAVES = 8;

constexpr size_t MiB = 1u << 20;
constexpr size_t WS_CTL = 0, CTL_ZERO_BYTES = 1 * MiB;
constexpr size_t WS_STATS = 512 * 1024;
constexpr size_t WS_MOD = 1 * MiB;
constexpr size_t WS_ROPE = 2 * MiB;
constexpr size_t WS_MODP = 3 * MiB;
constexpr size_t WS_WGU = 10 * MiB;
constexpr size_t SZ_WGU = 44 * MiB;
constexpr size_t WS_WD = WS_WGU + 4 * SZ_WGU;
constexpr size_t SZ_WD = 22 * MiB;
constexpr size_t WS_GMIN = WS_WD + 4 * SZ_WD;
constexpr size_t WS_GMOUT = WS_GMIN + 16 * MiB;
constexpr size_t WS_WDQKV = WS_GMOUT + 8 * MiB;
constexpr size_t WS_WUQ = WS_WDQKV + 3 * MiB;
constexpr size_t WS_WUKV = WS_WUQ + 3 * MiB;
constexpr size_t WS_WO = WS_WUKV + 2 * MiB;
constexpr size_t WS_Y = WS_WO + 8 * MiB;
constexpr size_t WS_XB = WS_Y + 4 * MiB;
constexpr size_t WS_XN = WS_XB;
constexpr size_t WS_BIG = WS_XN + 130 * MiB;
constexpr size_t WS_U = WS_BIG, WS_V = WS_BIG + 130 * MiB;
constexpr size_t WS_Q = WS_BIG, WS_KN = WS_BIG + 192 * MiB, WS_VV = WS_KN + 130 * MiB, WS_F = WS_VV + 130 * MiB;
constexpr size_t WS_CQ = WS_F + 98 * MiB, WS_CKV = WS_CQ + 33 * MiB, WS_KPE = WS_CKV + 17 * MiB, WS_END = WS_KPE + 5 * MiB;
static_assert((size_t)M_ALL * D * 2 <= 130 * MiB && (size_t)M_ALL * FF * 2 <= 358 * MiB && (size_t)M_LAT * 3072 * 2 <= 192 * MiB, "ws map");
static_assert((size_t)M_ALL * NDQKV * 4 <= 98 * MiB && (size_t)M_ALL * KQ * 2 <= 33 * MiB && (size_t)M_ALL * KKV * 2 <= 17 * MiB && (size_t)M_ALL * 64 * 2 <= 5 * MiB, "ws map 2");
static_assert(WS_STATS + (size_t)M_ALL * 8 <= CTL_ZERO_BYTES, "stats inside the zeroed region");
constexpr int CW_TMO = 0, CW_CODE = 1, CW_BAR = 4096;

constexpr int RING_OFF = 0, RING_BYTES = 131072;
constexpr int ATT_SHM_V = 64 * 256, ATT_SHM_K = 64 * 384;
constexpr int ATT_OFF_K = 2 * ATT_SHM_V, ATT_OFF_WS = ATT_OFF_K + 2 * ATT_SHM_K, ATT_OFF_QPE = ATT_OFF_WS + NWAVES * 256, ATT_NQR = 5, ATT_END = ATT_OFF_QPE + NWAVES * (12 - ATT_NQR) * 1024, ATT_OFF_OST = 0;
static_assert(NWAVES * 8192 <= ATT_OFF_WS, "O stage overlays the K/V buffers");
constexpr int ATT_NQD = 12;
constexpr int MISC_OFF = 149504, LDS_BYTES = 149504 + 512;
static_assert(ATT_END <= MISC_OFF && RING_BYTES <= MISC_OFF && MISC_OFF + 128 <= LDS_BYTES, "LDS map");

enum Phase { PH_PRO = 0, PH_MOD, PH_L0 = 2,
             PH_END = 27 };
constexpr int N_PHASES = 25;

struct Args { const float* in[24]; float* out; unsigned char* ws; int ph_lo, ph_hi; };
static_assert(sizeof(Args) == 24 * 8 + 8 + 8 + 8, "Args has no padding");

struct Frame {
    LAS unsigned char* lds;
    gu32* ctl;
    int wave, vcu, G;
};
__device__ __forceinline__ int mk_lane() { int l; asm volatile("v_mbcnt_lo_u32_b32 %0, -1, 0\n\tv_mbcnt_hi_u32_b32 %0, -1, %0" : "=v"(l)); return l; }

__device__ __forceinline__ float wave_sum(float v) {
#pragma unroll
    for (int o = 1; o < 64; o <<= 1) v += __shfl_xor(v, o);
    return v;
}
__device__ __forceinline__ float silu_f(float x) { return x * __builtin_amdgcn_rcpf(1.0f + __builtin_amdgcn_exp2f(-1.4426950408889634f * x)); }
__device__ __forceinline__ float gelu_tanh_f(float x) {
    const float z = 0.7978845608028654f * (x + 0.044715f * x * x * x);
    return x * __builtin_amdgcn_rcpf(1.0f + __builtin_amdgcn_exp2f(-2.0f * 1.4426950408889634f * z));
}
__device__ __forceinline__ int cond_of_row(int r) { return r < SEQ ? 0 : (r < M_LAT ? 1 : 2); }

typedef float f32x2 __attribute__((ext_vector_type(2)));
constexpr float GATE_SCALE = 1.4426950408889634f, UP_SCALE = 0.6931471805599453f;
struct EpiSwiGLU {
    static constexpr bool PERM = true, AFTER_DRAIN = false;
    pg8::bf16_t* H;
    __device__ __forceinline__ void operator()(const pg8::f32x4 (&acc)[2][2][4][2], const pg8::Unit& u, int wr, int wc, int fr, int fq) const {
        asm volatile("" : "+v"(fr), "+v"(fq));
        const int row0 = u.pm * 256 + wr * 64 + fr, col0 = u.pn * 128 + wc * 32 + 8 * fq;
#pragma unroll
        for (int ai = 0; ai < 2; ++ai)
#pragma unroll
            for (int m = 0; m < 4; ++m) {
                pg8::bf16_t* rowp = H + (size_t)(row0 + ai * 128 + m * 16) * FF + col0;
                f32x2 hp[4];
#pragma unroll
                for (int n = 0; n < 2; ++n)
#pragma unroll
                    for (int j = 0; j < 4; j += 2) {
                        const f32x2 g2 = {acc[ai][0][m][n][j], acc[ai][0][m][n][j + 1]}, u2 = {acc[ai][1][m][n][j], acc[ai][1][m][n][j + 1]};
                        f32x2 e2 = {__builtin_amdgcn_exp2f(-g2.x), __builtin_amdgcn_exp2f(-g2.y)};
                        e2 = e2 + 1.0f;
                        const f32x2 r2 = {__builtin_amdgcn_rcpf(e2.x), __builtin_amdgcn_rcpf(e2.y)};
                        hp[n * 2 + (j >> 1)] = (g2 * u2) * r2; }
                pg8::u32x4 w; w.x = pg8::cvt_pk_bf16(hp[0].x, hp[0].y); w.y = pg8::cvt_pk_bf16(hp[1].x, hp[1].y); w.z = pg8::cvt_pk_bf16(hp[2].x, hp[2].y); w.w = pg8::cvt_pk_bf16(hp[3].x, hp[3].y);
                *(pg8::u32x4*)rowp = w;
            }
    }
};
typedef _Float16 h16x4 __attribute__((ext_vector_type(4)));
__device__ __forceinline__ pg8::f32x4 bf4_to_f32(u32x2 w) { const h16x4 h = __builtin_bit_cast(h16x4, w); return __builtin_convertvector(h, pg8::f32x4); }
__device__ __forceinline__ u32x2 f32_to_bf4(pg8::f32x4 v) { const h16x4 h = __builtin_convertvector(v, h16x4); return __builtin_bit_cast(u32x2, h); }
template <bool BASE_F32> struct EpiResidT {
    static constexpr bool PERM = true, AFTER_DRAIN = false;
    const void* base; pg8::bf16_t* out;
    const float* gate;
    float coef;
    __device__ __forceinline__ void operator()(const pg8::f32x4 (&acc)[2][2][4][2], const pg8::Unit& u, int wr, int wc, int fr, int fq) const {
        asm volatile("" : "+v"(fr), "+v"(fq));
        typedef _Float16 h16x8 __attribute__((ext_vector_type(8)));
        typedef float f32x8v __attribute__((ext_vector_type(8)));
        const int row0 = u.pm * 256 + wr * 64 + fr, col0 = u.pn * 256 + wc * 32 + 8 * fq;
        const int cond = u.pm < 64 ? 0 : 1;
        const float* gv = gate + (size_t)cond * NMODV + col0;
        pg8::f32x4 g[2][2];
#pragma unroll
        for (int bj = 0; bj < 2; ++bj)
#pragma unroll
            for (int n = 0; n < 2; ++n) g[bj][n] = *(const pg8::f32x4*)(gv + bj * 128 + 4 * n) * coef;
#pragma unroll
        for (int ai = 0; ai < 2; ++ai) {
            pg8::f32x4 bv[4][2][2];
#pragma unroll
            for (int m = 0; m < 4; ++m)
#pragma unroll
                for (int bj = 0; bj < 2; ++bj) { const size_t off = (size_t)(row0 + ai * 128 + m * 16) * D + col0 + bj * 128;
                    if constexpr (BASE_F32) { bv[m][bj][0] = *(const pg8::f32x4*)((const float*)base + off); bv[m][bj][1] = *(const pg8::f32x4*)((const float*)base + off + 4); }
                    else { const h16x8 h = __builtin_bit_cast(h16x8, *(const pg8::u32x4*)((const pg8::bf16_t*)base + off)); const f32x8v f = __builtin_convertvector(h, f32x8v);
                        bv[m][bj][0] = (pg8::f32x4){f[0], f[1], f[2], f[3]}; bv[m][bj][1] = (pg8::f32x4){f[4], f[5], f[6], f[7]}; } }
#pragma unroll
            for (int m = 0; m < 4; ++m)
#pragma unroll
                for (int bj = 0; bj < 2; ++bj) {
                    const pg8::f32x4 o0 = bv[m][bj][0] + g[bj][0] * acc[ai][bj][m][0], o1 = bv[m][bj][1] + g[bj][1] * acc[ai][bj][m][1];
                    const f32x8v f = {o0[0], o0[1], o0[2], o0[3], o1[0], o1[1], o1[2], o1[3]};
                    *(pg8::u32x4*)(out + (size_t)(row0 + ai * 128 + m * 16) * D + col0 + bj * 128) = __builtin_bit_cast(pg8::u32x4, __builtin_convertvector(f, h16x8));
                }
        }
    }
};
typedef EpiResidT<false> EpiResid;
typedef EpiResidT<true> EpiResidF32;
struct EpiResidAtomic {
    static constexpr bool PERM = false, AFTER_DRAIN = false;
    float* outC;
    const float* gate;
    float coef;
    __device__ __forceinline__ void operator()(const pg8::f32x4 (&acc)[2][2][4][2], const pg8::Unit& u, int wr, int wc, int fr, int fq) const {
        asm volatile("" : "+v"(fr), "+v"(fq));
        const int row0 = u.pm * 256 + wr * 64 + fr, col0 = u.pn * 256 + wc * 32 + 4 * fq;
        const float* gv = gate + (size_t)2 * NMODV + col0;
        pg8::f32x4 g[2][2];
#pragma unroll
        for (int bj = 0; bj < 2; ++bj)
#pragma unroll
            for (int n = 0; n < 2; ++n) g[bj][n] = *(const pg8::f32x4*)(gv + bj * 128 + n * 16) * coef;
#pragma unroll
        for (int ai = 0; ai < 2; ++ai)
#pragma unroll
            for (int m = 0; m < 4; ++m) {
                float* op = outC + (size_t)(row0 + ai * 128 + m * 16) * D + col0;
#pragma unroll
                for (int bj = 0; bj < 2; ++bj)
#pragma unroll
                    for (int n = 0; n < 2; ++n) {
                        const pg8::f32x4 v = g[bj][n] * acc[ai][bj][m][n];
#pragma unroll
                        for (int j = 0; j < 4; ++j) unsafeAtomicAdd(op + bj * 128 + n * 16 + j, v[j]);
                    }
            }
    }
};
struct EpiPartial {
    static constexpr bool PERM = false, AFTER_DRAIN = false;
    float* part;
    const float* gate; float coef; int kslice_bytes;
    __device__ __forceinline__ void operator()(const pg8::f32x4 (&acc)[2][2][4][2], const pg8::Unit& u, int wr, int wc, int fr, int fq) const {
        asm volatile("" : "+v"(fr), "+v"(fq));
        const int row0 = u.pm * 256 + wr * 64 + fr, col0 = u.pn * 256 + wc * 32 + 4 * fq;
        const float* gv = gate + (size_t)2 * NMODV + col0;
        float* pbase = part + (size_t)(u.kofs / kslice_bytes) * ((size_t)M_CTX * D);
        pg8::f32x4 g[2][2];
#pragma unroll
        for (int bj = 0; bj < 2; ++bj)
#pragma unroll
            for (int n = 0; n < 2; ++n) g[bj][n] = *(const pg8::f32x4*)(gv + bj * 128 + n * 16) * coef;
#pragma unroll
        for (int ai = 0; ai < 2; ++ai)
#pragma unroll
            for (int m = 0; m < 4; ++m) {
                float* op = pbase + (size_t)(row0 + ai * 128 + m * 16) * D + col0;
#pragma unroll
                for (int bj = 0; bj < 2; ++bj)
#pragma unroll
                    for (int n = 0; n < 2; ++n) *(pg8::f32x4*)(op + bj * 128 + n * 16) = g[bj][n] * acc[ai][bj][m][n];
            }
    }
};
constexpr int CTX_P = 11;
static_assert(FF % (CTX_P * 128) == 0, "every K slice must be an even number of 64-wide K tiles");
struct SplitKOrder {
    int nN, P, kslice_bytes, G, c;
    __device__ __forceinline__ bool next(int i, pg8::Unit& u) const {
        const int L = i * G + c; if (L >= 2 * nN * P) return false;
        const int part = L / (2 * nN), t = L % (2 * nN);
        u.pm = 128 + (t & 1); u.pn = t >> 1; u.kofs = part * kslice_bytes; return true;
    }
    __device__ __forceinline__ void a_ready(const pg8::Unit&) const {}
    __device__ __forceinline__ void done(const pg8::Unit&) const {}
};
struct ClaimOrder {
    int nN, P, kslice_bytes; unsigned* ctr; volatile LAS unsigned* mb;
    __device__ __forceinline__ bool next(int i, pg8::Unit& u) const {
        if (i > 0) return false;
        if (threadIdx.x == 0) *mb = atomicAdd(ctr, 1u);
        __syncthreads();
        const int L = (int)*mb; if (L >= 2 * nN * P) return false;
        const int part = L / (2 * nN), t = L % (2 * nN);
        u.pm = 128 + (t & 1); u.pn = t >> 1; u.kofs = part * kslice_bytes; return true;
    }
    __device__ __forceinline__ void a_ready(const pg8::Unit&) const {}
    __device__ __forceinline__ void done(const pg8::Unit&) const {}
};
static_assert(2 * (D / 256) * CTX_P <= 256 && 2 * (NGU / 256) <= 256, "ClaimOrder: one unit per workgroup");
struct EpiGeluUV {
    static constexpr bool PERM = true, AFTER_DRAIN = false;
    pg8::bf16_t* U; pg8::bf16_t* V; float* stats;
    __device__ __forceinline__ void operator()(const pg8::f32x4 (&acc)[2][2][4][2], const pg8::Unit& u, int wr, int wc, int fr, int fq) const {
        asm volatile("" : "+v"(fr), "+v"(fq));
        const int row0 = u.pm * 256 + wr * 64 + fr;
        const bool isv = u.pn >= 8;
        pg8::bf16_t* base = isv ? V : U;
        const int col0 = (u.pn & 7) * 256 + wc * 32 + 8 * fq;
#pragma unroll
        for (int ai = 0; ai < 2; ++ai)
#pragma unroll
            for (int m = 0; m < 4; ++m) {
                const int row = row0 + ai * 128 + m * 16;
                pg8::bf16_t* rowp = base + (size_t)row * D + col0;
                float s = 0.f, q = 0.f;
#pragma unroll
                for (int bj = 0; bj < 2; ++bj) {
                    float z[8];
#pragma unroll
                    for (int n = 0; n < 2; ++n)
#pragma unroll
                        for (int j = 0; j < 4; ++j) { const float t = gelu_tanh_f(acc[ai][bj][m][n][j]); z[n * 4 + j] = t; s += t; q += t * t; }
                    pg8::u32x4 w; w.x = pg8::cvt_pk_bf16(z[0], z[1]); w.y = pg8::cvt_pk_bf16(z[2], z[3]); w.z = pg8::cvt_pk_bf16(z[4], z[5]); w.w = pg8::cvt_pk_bf16(z[6], z[7]);
                    *(pg8::u32x4*)(rowp + bj * 128) = w;
                }
                if (isv) {
                    s += __shfl_xor(s, 16); s += __shfl_xor(s, 32); q += __shfl_xor(q, 16); q += __shfl_xor(q, 32);
                    if (fq == 0) { atomicAdd(stats + 2 * row, s); atomicAdd(stats + 2 * row + 1, q); }
                }
            }
    }
};
struct EpiF32 {
    static constexpr bool PERM = false, AFTER_DRAIN = false;
    float* C; int ldc;
    __device__ __forceinline__ void operator()(const pg8::f32x4 (&acc)[2][2][4][2], const pg8::Unit& u, int wr, int wc, int fr, int fq) const {
        asm volatile("" : "+v"(fr), "+v"(fq));
        const int row0 = u.pm * 256 + wr * 64 + fr, col0 = u.pn * 256 + wc * 32 + 4 * fq;
#pragma unroll
        for (int ai = 0; ai < 2; ++ai)
#pragma unroll
            for (int m = 0; m < 4; ++m) { float* rowp = C + (size_t)(row0 + ai * 128 + m * 16) * ldc + col0;
#pragma unroll
                for (int bj = 0; bj < 2; ++bj)
#pragma unroll
                    for (int n = 0; n < 2; ++n) *(pg8::f32x4*)(rowp + bj * 128 + n * 16) = acc[ai][bj][m][n]; }
    }
};
constexpr float QPRESCALE = 0.07216878364870322f * 1.4426950408889634f;
struct EpiQRope {
    static constexpr bool PERM = true, AFTER_DRAIN = false;
    pg8::bf16_t* Q; const float* rope;
    __device__ __forceinline__ void operator()(const pg8::f32x4 (&acc)[2][2][4][2], const pg8::Unit& u, int wr, int wc, int fr, int fq) const {
        asm volatile("" : "+v"(fr), "+v"(fq));
        const int row0 = u.pm * 256 + wr * 64 + fr;
#pragma unroll
        for (int bj = 0; bj < 2; ++bj) {
            const int g32 = u.pn * 8 + bj * 4 + wc, gh = g32 % 6;
            const int col0 = g32 * 32 + 8 * fq;
#pragma unroll
            for (int ai = 0; ai < 2; ++ai)
#pragma unroll
                for (int m = 0; m < 4; ++m) {
                    const int row = row0 + ai * 128 + m * 16;
                    float x[8];
#pragma unroll
                    for (int n = 0; n < 2; ++n)
#pragma unroll
                        for (int j = 0; j < 4; ++j) x[n * 4 + j] = acc[ai][bj][m][n][j];
                    if (gh >= 4) {
                        const int t = row & (SEQ - 1), pos = (gh == 4) ? (t >> 6) : (t & 63);
                        const float* cp = rope + pos * 16 + 8 * (fq & 1); const float* sp = cp + 256 * 16;
                        const float sgn = (fq & 2) ? 1.f : -1.f;
#pragma unroll
                        for (int e = 0; e < 8; ++e) { const float p = __shfl_xor(x[e], 32); x[e] = x[e] * cp[e] + sgn * p * sp[e]; }
                    }
#pragma unroll
                    for (int e = 0; e < 8; ++e) x[e] *= QPRESCALE;
                    pg8::u32x4 w; w.x = pg8::cvt_pk_bf16(x[0], x[1]); w.y = pg8::cvt_pk_bf16(x[2], x[3]); w.z = pg8::cvt_pk_bf16(x[4], x[5]); w.w = pg8::cvt_pk_bf16(x[6], x[7]);
                    *(pg8::u32x4*)(Q + (size_t)row * 3072 + col0) = w;
                }
        }
    }
};
struct EpiKV {
    static constexpr bool PERM = true, AFTER_DRAIN = false;
    pg8::bf16_t* KN; pg8::bf16_t* V;
    __device__ __forceinline__ void operator()(const pg8::f32x4 (&acc)[2][2][4][2], const pg8::Unit& u, int wr, int wc, int fr, int fq) const {
        asm volatile("" : "+v"(fr), "+v"(fq));
        const int row0 = u.pm * 256 + wr * 64 + fr, col0 = u.pn * 128 + wc * 32 + 8 * fq;
#pragma unroll
        for (int ai = 0; ai < 2; ++ai)
#pragma unroll
            for (int m = 0; m < 4; ++m) {
                const size_t off = (size_t)(row0 + ai * 128 + m * 16) * D + col0;
#pragma unroll
                for (int bj = 0; bj < 2; ++bj) {
                    const pg8::f32x4 v0 = acc[ai][bj][m][0], v1 = acc[ai][bj][m][1];
                    pg8::u32x4 w; w.x = pg8::cvt_pk_bf16(v0[0], v0[1]); w.y = pg8::cvt_pk_bf16(v0[2], v0[3]); w.z = pg8::cvt_pk_bf16(v1[0], v1[1]); w.w = pg8::cvt_pk_bf16(v1[2], v1[3]);
                    *(pg8::u32x4*)((bj ? V : KN) + off) = w;
                }
            }
    }
};

__device__ __forceinline__ void transpose_item(const float* W, int K, int N, bf16* WT, int Kd, int drow0, int k0, int n0, LAS float* scr, int lane, float scale = 1.0f) {
    float wv[32];
#pragma unroll
    for (int i = 0; i < 32; ++i) { const int kk = 2 * i + (lane >> 5), k = k0 + kk; wv[i] = (k < K) ? W[(size_t)k * N + n0 + (lane & 31)] : 0.f; }
    if (scale != 1.0f) {
#pragma unroll
        for (int i = 0; i < 32; ++i) wv[i] *= scale; }
#pragma unroll
    for (int i = 0; i < 32; ++i) { const int kk = 2 * i + (lane >> 5); scr[kk * 33 + (lane & 31)] = wv[i]; }
    LDS_WAIT(); asm volatile("" ::: "memory");
    const int c = lane & 7;
#pragma unroll
    for (int j = 0; j < 4; ++j) { const int n = (lane >> 3) + 8 * j; const LAS float* s = scr + (8 * c) * 33 + n;
        v4u o; o.x = pk2(s[0 * 33], s[1 * 33]); o.y = pk2(s[2 * 33], s[3 * 33]); o.z = pk2(s[4 * 33], s[5 * 33]); o.w = pk2(s[6 * 33], s[7 * 33]);
        *(GAS v4u*)(WT + (size_t)(drow0 + n) * Kd + k0 + 8 * c) = o; }
    LDS_WAIT(); asm volatile("" ::: "memory");
}
__device__ __forceinline__ void transpose_mat(const float* W, int K, int N, bf16* WT, int Kd, int drow_off, int r, LAS float* scr, int lane) {
    const int nblk = N / 32, kb = r / nblk, nb = r % nblk;
    transpose_item(W, K, N, WT, Kd, drow_off + 32 * nb, 64 * kb, 32 * nb, scr, lane);
}

__device__ __forceinline__ void ph_prologue(Frame& F, const Args& a) {
    unsigned char* ws = a.ws; const int lane_ = mk_lane(), tid_ = F.wave * 64 + lane_;
    const int gw = F.vcu * NWAVES + F.wave, NGW = F.G * NWAVES;
    LAS float* stab = (LAS float*)(F.lds + 98304);
    for (int k = tid_; k < D; k += NWAVES * 64) {
        pg8::f32x4 s; s.x = silu_f(a.in[1][k]); s.y = silu_f(a.in[1][D + k]); s.z = silu_f(a.in[3][k]); s.w = 0.f;
        *(LAS pg8::f32x4*)(stab + 4 * k) = s;
    }
    __syncthreads();
    {
        constexpr int NT = 2 * 72 * KSPLIT;
        for (int t = gw; t < NT; t += NGW) {
            const int ks = t % KSPLIT, cb = (t / KSPLIT) % 72, l = t / (KSPLIT * 72);
            const int kbeg = ks * D / KSPLIT, kend = (ks + 1) * D / KSPLIT, col = cb * 256 + 4 * lane_;
            const float* w = a.in[4] + ((size_t)l * D + kbeg) * NMODV + col;
            pg8::f32x4 a0 = {0.f, 0.f, 0.f, 0.f}, a1 = a0, a2 = a0;
#pragma unroll 16
            for (int k = kbeg; k < kend; ++k) {
                const pg8::f32x4 wv = *(const pg8::f32x4*)w; w += NMODV;
                const pg8::f32x4 s = *(LAS pg8::f32x4*)(stab + 4 * k);
                a0 += wv * s.x; a1 += wv * s.y; a2 += wv * s.z;
            }
            float* p = (float*)(ws + WS_MODP) + ((size_t)(ks * 2 + l) * 3) * NMODV + col;
            *(pg8::f32x4*)p = a0; *(pg8::f32x4*)(p + NMODV) = a1; *(pg8::f32x4*)(p + 2 * NMODV) = a2;
        }
    }
    for (int i = blockIdx.x * (NWAVES * 64) + tid_; i < 256 * 16; i += F.G * NWAVES * 64) {
        const int pos = i >> 4, f = i & 15;
        const float inv = __builtin_amdgcn_exp2f(-(float)f * (13.287712379549449f / 16.0f));
        const float rev = (float)pos * inv * 0.15915494309189535f;
        float* rp = (float*)(ws + WS_ROPE);
        rp[i] = __builtin_amdgcn_cosf(rev); rp[4096 + i] = __builtin_amdgcn_sinf(rev);
    }
    { const GAS v4u* src = (const GAS v4u*)a.in[2]; GAS v4u* dst = (GAS v4u*)(ws + WS_Y);
      for (int i = blockIdx.x * (NWAVES * 64) + tid_; i < M_CTX * D / 4; i += F.G * NWAVES * 64) dst[i] = src[i]; }
    { v4u z = {0u, 0u, 0u, 0u}; GAS v4u* p = (GAS v4u*)(ws + WS_WDQKV + (size_t)672 * D * 2);
      for (int i = blockIdx.x * (NWAVES * 64) + tid_; i < 96 * D * 2 / 16; i += F.G * NWAVES * 64) p[i] = z; }
    LAS float* scr = (LAS float*)(F.lds + F.wave * 8448);
    constexpr int IT_FFN = 5632, N_FFN = 12 * IT_FFN;
    constexpr int I_GMIN = 32 * 128, I_GMOUT = 32 * 64, I_WO = 32 * 64, I_DQ = 32 * 14, I_DKV = 32 * 7, I_UQ = 8 * 96, I_UKV = 4 * 128;
    constexpr int NITEMS = N_FFN + I_GMIN + I_GMOUT + I_WO + I_DQ + I_DKV + I_UQ + I_UKV;
    for (int it = gw; it < NITEMS; it += NGW) {
        int r = it;
        if (r < N_FFN) {
            const int idx = r / IT_FFN, sub = idx / 3, kind = idx % 3; r -= idx * IT_FFN;
            if (kind < 2) {
                const float* W = a.in[7 + kind] + (size_t)sub * D * FF;
                const int nblk = FF / 32, kb = r / nblk, nb = r % nblk, n0 = 32 * nb;
                transpose_item(W, D, FF, (bf16*)(ws + WS_WGU + sub * SZ_WGU), D, (n0 >> 7) * 256 + kind * 128 + (n0 & 127), 64 * kb, n0, scr, lane_, kind == 0 ? GATE_SCALE : UP_SCALE);
            } else {
                transpose_mat(a.in[9] + (size_t)sub * FF * D, FF, D, (bf16*)(ws + WS_WD + sub * SZ_WD), FF, 0, r, scr, lane_);
            }
            continue;
        }
        r -= N_FFN;
        if (r < I_GMIN) { transpose_mat(a.in[10], D, 4096, (bf16*)(ws + WS_GMIN), D, 0, r, scr, lane_); continue; } r -= I_GMIN;
        if (r < I_GMOUT) { transpose_mat(a.in[15], D, D, (bf16*)(ws + WS_GMOUT), D, 0, r, scr, lane_); continue; } r -= I_GMOUT;
        if (r < I_WO) { transpose_mat(a.in[22], D, D, (bf16*)(ws + WS_WO), D, 0, r, scr, lane_); continue; } r -= I_WO;
        if (r < I_DQ) { transpose_mat(a.in[16], D, QLORA, (bf16*)(ws + WS_WDQKV), D, 0, r, scr, lane_); continue; } r -= I_DQ;
        if (r < I_DKV) { transpose_mat(a.in[19], D, KVLORA + ROPE, (bf16*)(ws + WS_WDQKV), D, QLORA, r, scr, lane_); continue; } r -= I_DKV;
        if (r < I_UQ) { transpose_mat(a.in[18], QLORA, 3072, (bf16*)(ws + WS_WUQ), KQ, 0, r, scr, lane_); continue; } r -= I_UQ;
        transpose_mat(a.in[21], KVLORA, 4096, (bf16*)(ws + WS_WUKV), KKV, 0, r, scr, lane_);
    }
}
__device__ __forceinline__ void ph_modreduce(Frame& F, const Args& a) {
    const int tid_ = F.wave * 64 + mk_lane();
    const float* mp = (const float*)(a.ws + WS_MODP); float* mod = (float*)(a.ws + WS_MOD);
    for (int i = blockIdx.x * (NWAVES * 64) + tid_; i < 2 * 3 * NMODV; i += F.G * NWAVES * 64) {
        const int n = i % NMODV, l = i / (3 * NMODV);
        float s = a.in[5][l * NMODV + n];
#pragma unroll
        for (int ks = 0; ks < KSPLIT; ++ks) s += mp[(size_t)ks * 2 * 3 * NMODV + i];
        mod[i] = s;
    }
}
template <bool LAT_F32, int P = 0> __device__ __forceinline__ void ph_norm(Frame& F, const void* srcL  , const float* srcC  , int M, const float* g, const float* modl  , int k, bf16* XN, const float* part = nullptr  , float* Ywr = nullptr  ) {
    typedef _Float16 h16x8 __attribute__((ext_vector_type(8)));
    typedef float f32x8v __attribute__((ext_vector_type(8)));
    const int gw = F.vcu * NWAVES + F.wave, NGW = F.G * NWAVES, lane_ = mk_lane();
    int cur = -1; f32x8v A[4], B[4];
    auto do_row = [&](const int r) {
        const int cond = cond_of_row(r);
        if (cond != cur) {
            cur = cond;
            const float* sh = modl + (size_t)cond * NMODV + (3 * k) * D; const float* sc = sh + D;
#pragma unroll
            for (int j = 0; j < 4; ++j) { const int c = 8 * lane_ + 512 * j; const f32x8v gg = *(const f32x8v*)(g + c), s1 = *(const f32x8v*)(sc + c);
                A[j] = gg * (s1 + 1.0f); B[j] = *(const f32x8v*)(sh + c); }
        }
        f32x8v v[4]; float ss = 0.f;
        if (LAT_F32 || r >= M_LAT) {
            const float* xr = (r < M_LAT ? (const float*)srcL : srcC) + (size_t)r * D + 8 * lane_;
#pragma unroll
            for (int j = 0; j < 4; ++j) v[j] = *(const GAS f32x8v*)(xr + 512 * j);
            if (P > 0 && r >= M_LAT) {
                const float* pr = part + (size_t)r * D + 8 * lane_;
#pragma unroll
                for (int p0 = 0; p0 < P; p0 += 3) {
                    f32x8v t[3][4];
#pragma unroll
                    for (int pp = 0; pp < 3; ++pp)
#pragma unroll
                        for (int j = 0; j < 4; ++j) if (p0 + pp < P) t[pp][j] = *(const GAS f32x8v*)(pr + (size_t)(p0 + pp) * ((size_t)M_CTX * D) + 512 * j);
#pragma unroll
                    for (int pp = 0; pp < 3; ++pp)
#pragma unroll
                        for (int j = 0; j < 4; ++j) if (p0 + pp < P) v[j] += t[pp][j]; }
                float* yw = Ywr + (size_t)r * D + 8 * lane_;
#pragma unroll
                for (int j = 0; j < 4; ++j) *(GAS f32x8v*)(yw + 512 * j) = v[j];
            }
        } else {
            const bf16* xr = (const bf16*)srcL + (size_t)r * D + 8 * lane_;
#pragma unroll
            for (int j = 0; j < 4; ++j) v[j] = __builtin_convertvector(__builtin_bit_cast(h16x8, *(const GAS v4u*)(xr + 512 * j)), f32x8v);
        }
#pragma unroll
        for (int j = 0; j < 4; ++j) { const f32x8v q = v[j] * v[j]; ss += ((q[0] + q[1]) + (q[2] + q[3])) + ((q[4] + q[5]) + (q[6] + q[7])); }
        const float rstd = __builtin_amdgcn_rsqf(wave_sum(ss) * (1.0f / D) + EPS);
        GAS v4u* o = (GAS v4u*)(XN + (size_t)r * D + 8 * lane_);
#pragma unroll
        for (int j = 0; j < 4; ++j) { const f32x8v y = v[j] * rstd * A[j] + B[j]; v4u w; w.x = pg8::cvt_pk_bf16(y[0], y[1]); w.y = pg8::cvt_pk_bf16(y[2], y[3]); w.z = pg8::cvt_pk_bf16(y[4], y[5]); w.w = pg8::cvt_pk_bf16(y[6], y[7]); o[64 * j] = w; }
    };
    for (int r = gw; r < (M < M_LAT ? M : M_LAT); r += NGW) do_row(r);
    if (M > M_LAT) {
        const int S = NGW >= M_CTX ? NGW / M_CTX : 1;
        if (gw % S == 0) for (int jr = gw / S; jr < M - M_LAT; jr += NGW / S) do_row(M_LAT + jr);
    }
}
__device__ __forceinline__ void ph_final(Frame& F, const bf16* XB, float* out, const float* g) {
    typedef _Float16 h16x8 __attribute__((ext_vector_type(8)));
    typedef float f32x8v __attribute__((ext_vector_type(8)));
    const int gw = F.vcu * NWAVES + F.wave, NGW = F.G * NWAVES, lane_ = mk_lane();
    f32x8v A[4];
#pragma unroll
    for (int j = 0; j < 4; ++j) A[j] = *(const f32x8v*)(g + 8 * lane_ + 512 * j);
    for (int r = gw; r < M_LAT; r += NGW) {
        const bf16* xr = XB + (size_t)r * D + 8 * lane_; float* orow = out + (size_t)r * D + 8 * lane_;
        f32x8v v[4]; float ss = 0.f;
#pragma unroll
        for (int j = 0; j < 4; ++j) { v[j] = __builtin_convertvector(__builtin_bit_cast(h16x8, *(const GAS v4u*)(xr + 512 * j)), f32x8v); const f32x8v q = v[j] * v[j]; ss += ((q[0] + q[1]) + (q[2] + q[3])) + ((q[4] + q[5]) + (q[6] + q[7])); }
        const float rstd = __builtin_amdgcn_rsqf(wave_sum(ss) * (1.0f / D) + EPS);
#pragma unroll
        for (int j = 0; j < 4; ++j) *(GAS f32x8v*)(orow + 512 * j) = v[j] * rstd * A[j];
    }
}
__device__ __forceinline__ void ph_mla_norm(Frame& F, const float* Fm, const float* qn, const float* kvn, const float* rope, bf16* CQ, bf16* CKV, bf16* KPE) {
    const int gw = F.vcu * NWAVES + F.wave, NGW = F.G * NWAVES, lane = mk_lane();
    for (int r = gw; r < M_ALL; r += NGW) {
        const float* fr = Fm + (size_t)r * NDQKV;
        float x[8]; float ss = 0.f;
        if (lane < 56) {
            const pg8::f32x4 a = *(const GAS pg8::f32x4*)(fr + 8 * lane), b = *(const GAS pg8::f32x4*)(fr + 8 * lane + 4);
            x[0] = a.x; x[1] = a.y; x[2] = a.z; x[3] = a.w; x[4] = b.x; x[5] = b.y; x[6] = b.z; x[7] = b.w;
#pragma unroll
            for (int e = 0; e < 8; ++e) ss += x[e] * x[e];
        } else {
#pragma unroll
            for (int e = 0; e < 8; ++e) x[e] = 0.f;
        }
        const float rq = __builtin_amdgcn_rsqf(wave_sum(ss) * (1.0f / QLORA) + EPS);
        {
            float y[8];
#pragma unroll
            for (int e = 0; e < 8; ++e) y[e] = (lane < 56) ? x[e] * rq * qn[8 * lane + e] : 0.f;
            v4u w; w.x = pg8::cvt_pk_bf16(y[0], y[1]); w.y = pg8::cvt_pk_bf16(y[2], y[3]); w.z = pg8::cvt_pk_bf16(y[4], y[5]); w.w = pg8::cvt_pk_bf16(y[6], y[7]);
            *(GAS v4u*)(CQ + (size_t)r * KQ + 8 * lane) = w;
        }
        float z[8]; float s2 = 0.f;
        if (lane < 20) {
            const pg8::f32x4 a = *(const GAS pg8::f32x4*)(fr + QLORA + 8 * lane), b = *(const GAS pg8::f32x4*)(fr + QLORA + 8 * lane + 4);
            z[0] = a.x; z[1] = a.y; z[2] = a.z; z[3] = a.w; z[4] = b.x; z[5] = b.y; z[6] = b.z; z[7] = b.w;
#pragma unroll
            for (int e = 0; e < 8; ++e) s2 += z[e] * z[e];
        } else if (lane >= 32 && lane < 40) {
            const int j = lane - 32;
            const pg8::f32x4 a = *(const GAS pg8::f32x4*)(fr + QLORA + KVLORA + 8 * j), b = *(const GAS pg8::f32x4*)(fr + QLORA + KVLORA + 8 * j + 4);
            z[0] = a.x; z[1] = a.y; z[2] = a.z; z[3] = a.w; z[4] = b.x; z[5] = b.y; z[6] = b.z; z[7] = b.w;
        } else {
#pragma unroll
            for (int e = 0; e < 8; ++e) z[e] = 0.f;
        }
        const float rk = __builtin_amdgcn_rsqf(wave_sum(s2) * (1.0f / KVLORA) + EPS);
        float pz[8];
#pragma unroll
        for (int e = 0; e < 8; ++e) pz[e] = __shfl_xor(z[e], 2);
        if (lane < 32) {
            float y[8];
#pragma unroll
            for (int e = 0; e < 8; ++e) y[e] = (lane < 20) ? z[e] * rk * kvn[8 * lane + e] : 0.f;
            v4u w; w.x = pg8::cvt_pk_bf16(y[0], y[1]); w.y = pg8::cvt_pk_bf16(y[2], y[3]); w.z = pg8::cvt_pk_bf16(y[4], y[5]); w.w = pg8::cvt_pk_bf16(y[6], y[7]);
            *(GAS v4u*)(CKV + (size_t)r * KKV + 8 * lane) = w;
        } else if (lane < 40) {
            const int j = lane - 32;
            float y[8];
            if (r < M_LAT) {
                const int t = r & (SEQ - 1), pos = (j < 4) ? (t >> 6) : (t & 63);
                const float* cp = rope + pos * 16 + 8 * (j & 1); const float* sp = cp + 4096;
                const float sgn = (j & 2) ? 1.f : -1.f;
#pragma unroll
                for (int e = 0; e < 8; ++e) y[e] = z[e] * cp[e] + sgn * pz[e] * sp[e];
            } else {
#pragma unroll
                for (int e = 0; e < 8; ++e) y[e] = z[e];
            }
            v4u w; w.x = pg8::cvt_pk_bf16(y[0], y[1]); w.y = pg8::cvt_pk_bf16(y[2], y[3]); w.z = pg8::cvt_pk_bf16(y[4], y[5]); w.w = pg8::cvt_pk_bf16(y[6], y[7]);
            *(GAS v4u*)(KPE + (size_t)r * 64 + 8 * j) = w;
        }
    }
}

__device__ __forceinline__ s16x4 tr_read_dyn(int addr) { s16x4 r; asm volatile("ds_read_b64_tr_b16 %0, %1" : "=&v"(r) : "v"(addr) : "memory"); return r; }
__device__ __forceinline__ void ph_gm_mix(Frame& F, bf16* U, const bf16* V, const float* stats, const float* lng, const float* lnb, const float* w_s, const float* b_s, bf16* Uout = nullptr) {
    if (Uout == nullptr) Uout = U;
    constexpr int WS_STRIDE = 272, VN_STRIDE = 528, VN_OFF = 128 * WS_STRIDE;
    const int lane = mk_lane(), wave = F.wave, tid = wave * 64 + lane, wp = wave >> 2, wd = wave & 3;
    LAS unsigned char* lw = F.lds; LAS unsigned char* lv = F.lds + VN_OFF;
    const int NU = (M_ALL / 128) * 8;
    for (int un = F.vcu; un < NU; un += F.G) {
        const int c = un >> 3, g = un & 7, R0 = 128 * c, F0 = 256 * g;
        __syncthreads();
        { const float* w = w_s + (size_t)g * 128 * 128;
#pragma unroll
          for (int i = 0; i < 8; ++i) { const int id = tid + 512 * i, p = id >> 5, q4 = (id & 31) * 4; const pg8::f32x4 v = *(const GAS pg8::f32x4*)(w + p * 128 + q4);
              u32x2 o; o.x = pg8::cvt_pk_bf16(v.x, v.y); o.y = pg8::cvt_pk_bf16(v.z, v.w); *(LAS u32x2*)(lw + p * WS_STRIDE + q4 * 2) = o; } }
        { const int dg = tid & 31; const float* gp = lng + F0 + 8 * dg; const float* bp = lnb + F0 + 8 * dg;
          const pg8::f32x4 g0 = *(const pg8::f32x4*)gp, g1 = *(const pg8::f32x4*)(gp + 4), b0 = *(const pg8::f32x4*)bp, b1 = *(const pg8::f32x4*)(bp + 4);
#pragma unroll
          for (int i = 0; i < 8; ++i) { const int q = (tid >> 5) + 16 * i, row = R0 + q;
              const v4u raw = *(const GAS v4u*)(V + (size_t)row * D + F0 + 8 * dg);
              const float s = stats[2 * row], ss = stats[2 * row + 1];
              const float mean = s * (1.0f / D), var = ss * (1.0f / D) - mean * mean, rstd = __builtin_amdgcn_rsqf(var + EPS);
              float x[8];
              x[0] = __uint_as_float(raw.x << 16); x[1] = __uint_as_float(raw.x & 0xffff0000u); x[2] = __uint_as_float(raw.y << 16); x[3] = __uint_as_float(raw.y & 0xffff0000u);
              x[4] = __uint_as_float(raw.z << 16); x[5] = __uint_as_float(raw.z & 0xffff0000u); x[6] = __uint_as_float(raw.w << 16); x[7] = __uint_as_float(raw.w & 0xffff0000u);
              float y[8];
              y[0] = (x[0] - mean) * rstd * g0.x + b0.x; y[1] = (x[1] - mean) * rstd * g0.y + b0.y; y[2] = (x[2] - mean) * rstd * g0.z + b0.z; y[3] = (x[3] - mean) * rstd * g0.w + b0.w;
              y[4] = (x[4] - mean) * rstd * g1.x + b1.x; y[5] = (x[5] - mean) * rstd * g1.y + b1.y; y[6] = (x[6] - mean) * rstd * g1.z + b1.z; y[7] = (x[7] - mean) * rstd * g1.w + b1.w;
              v4u o; o.x = pg8::cvt_pk_bf16(y[0], y[1]); o.y = pg8::cvt_pk_bf16(y[2], y[3]); o.z = pg8::cvt_pk_bf16(y[4], y[5]); o.w = pg8::cvt_pk_bf16(y[6], y[7]);
              *(LAS v4u*)(lv + q * VN_STRIDE + dg * 16) = o; } }
        __syncthreads();
        pg8::f32x4 acc[4][4];
#pragma unroll
        for (int mi = 0; mi < 4; ++mi)
#pragma unroll
            for (int ni = 0; ni < 4; ++ni) acc[mi][ni] = (pg8::f32x4){0.f, 0.f, 0.f, 0.f};
        const int G4 = lane >> 4, i16 = lane & 15, ta = i16 >> 2, tb = i16 & 3;
        const int vbase = (int)(unsigned)(uintptr_t)lv + (8 * G4 + ta) * VN_STRIDE + (wd * 64 + 4 * tb) * 2;
#pragma unroll
        for (int ks = 0; ks < 4; ++ks) {
            pg8::bf16x8 Bw[4], Av[4];
#pragma unroll
            for (int mi = 0; mi < 4; ++mi) Bw[mi] = *(const LAS pg8::bf16x8*)(lw + (wp * 64 + 16 * mi + i16) * WS_STRIDE + (32 * ks + 8 * G4) * 2);
#pragma unroll
            for (int ni = 0; ni < 4; ++ni) { const int ad = vbase + 32 * ks * VN_STRIDE + ni * 32;
                const s16x4 lo = tr_read_dyn(ad), hi = tr_read_dyn(ad + 4 * VN_STRIDE);
                Av[ni] = (pg8::bf16x8){lo[0], lo[1], lo[2], lo[3], hi[0], hi[1], hi[2], hi[3]}; }
            asm volatile("s_waitcnt lgkmcnt(0)" ::: "memory"); __builtin_amdgcn_sched_barrier(0);
#pragma unroll
            for (int mi = 0; mi < 4; ++mi)
#pragma unroll
                for (int ni = 0; ni < 4; ++ni) acc[mi][ni] = __builtin_amdgcn_mfma_f32_16x16x32_bf16(Av[ni], Bw[mi], acc[mi][ni], 0, 0, 0);
        }
        u32x2 uall[4][4];
#pragma unroll
        for (int mi = 0; mi < 4; ++mi)
#pragma unroll
            for (int ni = 0; ni < 4; ++ni) uall[mi][ni] = *(const GAS u32x2*)(U + (size_t)(R0 + wp * 64 + 16 * mi + i16) * D + F0 + wd * 64 + 16 * ni + 4 * G4);
#pragma unroll
        for (int mi = 0; mi < 4; ++mi) {
            const int p = wp * 64 + 16 * mi + i16; const float bias = b_s[g * 128 + p];
#pragma unroll
            for (int ni = 0; ni < 4; ++ni) {
                GAS u32x2* up = (GAS u32x2*)(Uout + (size_t)(R0 + p) * D + F0 + wd * 64 + 16 * ni + 4 * G4);
                const u32x2 uu = uall[mi][ni];
                const float u0 = __uint_as_float(uu.x << 16), u1 = __uint_as_float(uu.x & 0xffff0000u), u2 = __uint_as_float(uu.y << 16), u3 = __uint_as_float(uu.y & 0xffff0000u);
                u32x2 o; o.x = pg8::cvt_pk_bf16(u0 * (acc[mi][ni][0] + bias), u1 * (acc[mi][ni][1] + bias)); o.y = pg8::cvt_pk_bf16(u2 * (acc[mi][ni][2] + bias), u3 * (acc[mi][ni][3] + bias));
                *up = o;
            }
        }
    }
    __syncthreads();
}

namespace att {
constexpr float SCALE = 0.07216878364870322f;
#ifndef ATT_THR
#define ATT_THR 8.f
#endif
constexpr float THR = ATT_THR;
constexpr int NT = (SEQ + CTXL) / 64;
constexpr int NQR = ATT_NQR;
#define SBAR() __builtin_amdgcn_sched_barrier(0)
__device__ __forceinline__ int crow(int r, int hi) { return (r & 3) + 8 * (r >> 2) + 4 * hi; }
__device__ __forceinline__ unsigned cvtpk(float lo, float hi) { unsigned r; asm volatile("v_cvt_pk_bf16_f32 %0, %1, %2" : "=v"(r) : "v"(lo), "v"(hi)); return r; }
__device__ __forceinline__ float sm_rowmax(const f32x16& p0, const f32x16& p1) {
  float pmax = p0[0];
#pragma unroll
  for (int r = 1; r < 16; ++r) pmax = fmaxf(pmax, p0[r]);
#pragma unroll
  for (int r = 0; r < 16; ++r) pmax = fmaxf(pmax, p1[r]);
  auto rr = __builtin_amdgcn_permlane32_swap(__float_as_uint(pmax), __float_as_uint(pmax), false, false);
  return fmaxf(__uint_as_float(rr[0]), __uint_as_float(rr[1]));
}
__device__ __forceinline__ void sm_decide(float pmax, float& m_reg, float& mnC, float& alpha) {
  constexpr float C = SCALE * 1.4426950408889634f;
  const bool grow = (pmax - m_reg) > (THR / SCALE);
  const float mn = grow ? pmax : m_reg;
  const float a = __builtin_amdgcn_exp2f((m_reg - mn) * C);
  alpha = grow ? a : 1.f; m_reg = mn; mnC = -mn * C;
}
__device__ __forceinline__ void sm_scale(f32x16& p, float mnC) {
  constexpr float C = SCALE * 1.4426950408889634f;
#pragma unroll
  for (int r = 0; r < 16; ++r) p[r] = fmaf(p[r], C, mnC);
}
template <int LO, int HI> __device__ __forceinline__ void sm_exp(f32x16& p) {
#pragma unroll
  for (int r = LO; r < HI; ++r) p[r] = __builtin_amdgcn_exp2f(p[r]);
}
__device__ __forceinline__ void partialSM(f32x16& p0, f32x16& p1, float& m_reg, float& alpha) {
  float mnC; const float pm = sm_rowmax(p0, p1); sm_decide(pm, m_reg, mnC, alpha); sm_scale(p0, mnC); sm_scale(p1, mnC); sm_exp<0, 16>(p0);
}
__device__ __forceinline__ void finishSM(f32x16& p0, f32x16& p1, float alpha, float& l_reg, bf16x8& pa0, bf16x8& pa1, bf16x8& pa2, bf16x8& pa3) {
#pragma unroll
  for (int r = 0; r < 16; ++r) p1[r] = __builtin_amdgcn_exp2f(p1[r]);
  float ps = 0;
#pragma unroll
  for (int r = 0; r < 16; ++r) ps += p0[r];
#pragma unroll
  for (int r = 0; r < 16; ++r) ps += p1[r];
  { auto rr = __builtin_amdgcn_permlane32_swap(__float_as_uint(ps), __float_as_uint(ps), false, false);
    ps = __uint_as_float(rr[0]) + __uint_as_float(rr[1]); }
  l_reg = l_reg * alpha + ps;
#define PK4(P, BASE, OUT) do { unsigned a0 = cvtpk(P[BASE + 0], P[BASE + 1]), a1 = cvtpk(P[BASE + 2], P[BASE + 3]);   \
    unsigned b0 = cvtpk(P[BASE + 4], P[BASE + 5]), b1 = cvtpk(P[BASE + 6], P[BASE + 7]);                              \
    auto r0 = __builtin_amdgcn_permlane32_swap(a0, b0, false, false); auto r1 = __builtin_amdgcn_permlane32_swap(a1, b1, false, false); \
    v4u w = {r0[0], r1[0], r0[1], r1[1]}; OUT = *reinterpret_cast<bf16x8*>(&w); } while (0)
  PK4(p0, 0, pa0); PK4(p0, 8, pa1); PK4(p1, 0, pa2); PK4(p1, 8, pa3);
#undef PK4
}
template <int NQ> __device__ __forceinline__ void qkt(f32x16& p0, f32x16& p1, const LAS char* Ks  , const bf16x8 (&qr)[NQ], const LAS char* qpe) {
  p0 = f32x16{}; p1 = f32x16{};
#pragma unroll
  for (int d0 = 0; d0 < 12; ++d0) {
    bf16x8 b0 = *reinterpret_cast<const LAS bf16x8*>(Ks + d0 * 2048);
    bf16x8 b1 = *reinterpret_cast<const LAS bf16x8*>(Ks + d0 * 2048 + 1024);
    bf16x8 q;
    if (d0 < NQ) q = qr[d0]; else q = *reinterpret_cast<const LAS bf16x8*>(qpe + (d0 - NQ) * 1024);
    p0 = __builtin_amdgcn_mfma_f32_32x32x16_bf16(b0, q, p0, 0, 0, 0);
    p1 = __builtin_amdgcn_mfma_f32_32x32x16_bf16(b1, q, p1, 0, 0, 0); }
}
__device__ __forceinline__ int v_st(int k, int c) { const int kk = (k & ~0xC) | ((k & 4) << 1) | ((k & 8) >> 1); return ((kk >> 3) * 4 + (c >> 5)) * 512 + ((kk & 7) * 32 + (c & 31)) * 2; }
__device__ __forceinline__ int v_rd_base(int lane) { return ((lane & 3) << 3) | (((lane >> 2) & 3) << 6) | (((lane >> 4) & 1) << 5) | (((lane >> 5) & 1) << 8); }
constexpr int v_rd_off(int d0, int ks, int half) { return d0 * 512 + ks * 4096 + half * 2048; }
template <int OFF> __device__ __forceinline__ s16x4 tr_read(int vb) {
  s16x4 r; asm volatile("ds_read_b64_tr_b16 %0, %1 offset:%2" : "=&v"(r) : "v"(vb), "i"(OFF) : "memory"); return r;
}
template <int D0> __device__ __forceinline__ void pv_one(f32x16& od, int vb, bf16x8 pa0, bf16x8 pa1, bf16x8 pa2, bf16x8 pa3) {
  const s16x4 l0 = tr_read<v_rd_off(D0, 0, 0)>(vb), h0 = tr_read<v_rd_off(D0, 0, 1)>(vb), l1 = tr_read<v_rd_off(D0, 1, 0)>(vb), h1 = tr_read<v_rd_off(D0, 1, 1)>(vb);
  const s16x4 l2 = tr_read<v_rd_off(D0, 2, 0)>(vb), h2 = tr_read<v_rd_off(D0, 2, 1)>(vb), l3 = tr_read<v_rd_off(D0, 3, 0)>(vb), h3 = tr_read<v_rd_off(D0, 3, 1)>(vb);
  asm volatile("s_waitcnt lgkmcnt(0)" ::: "memory"); SBAR();
#define PK(L, H) (bf16x8){L[0], L[1], L[2], L[3], H[0], H[1], H[2], H[3]}
  od = __builtin_amdgcn_mfma_f32_32x32x16_bf16(pa0, PK(l0, h0), od, 0, 0, 0);
  od = __builtin_amdgcn_mfma_f32_32x32x16_bf16(pa1, PK(l1, h1), od, 0, 0, 0);
  od = __builtin_amdgcn_mfma_f32_32x32x16_bf16(pa2, PK(l2, h2), od, 0, 0, 0);
  od = __builtin_amdgcn_mfma_f32_32x32x16_bf16(pa3, PK(l3, h3), od, 0, 0, 0);
#undef PK
}
__device__ __forceinline__ void pv_d0(f32x16 (&o)[4], int vb, bf16x8 pa0, bf16x8 pa1, bf16x8 pa2, bf16x8 pa3) {
  pv_one<0>(o[0], vb, pa0, pa1, pa2, pa3); pv_one<1>(o[1], vb, pa0, pa1, pa2, pa3); pv_one<2>(o[2], vb, pa0, pa1, pa2, pa3); pv_one<3>(o[3], vb, pa0, pa1, pa2, pa3);
}
__device__ __forceinline__ void pv_sm(f32x16 (&o)[4], int vb, bf16x8 pa0, bf16x8 pa1, bf16x8 pa2, bf16x8 pa3, f32x16& pX0, f32x16& pX1, float& m_reg, float& alpha) {
  float mnC;
  pv_one<0>(o[0], vb, pa0, pa1, pa2, pa3); const float pm = sm_rowmax(pX0, pX1);
  pv_one<1>(o[1], vb, pa0, pa1, pa2, pa3); sm_decide(pm, m_reg, mnC, alpha); sm_scale(pX0, mnC);
  pv_one<2>(o[2], vb, pa0, pa1, pa2, pa3); sm_scale(pX1, mnC); sm_exp<0, 8>(pX0);
  pv_one<3>(o[3], vb, pa0, pa1, pa2, pa3); sm_exp<8, 16>(pX0);
}
#define KREAD(a, b, d0) asm volatile("ds_read_b128 %0, %2 offset:%3\n\tds_read_b128 %1, %2 offset:%4" : "=&v"(a), "=&v"(b) : "v"(kaddr), "i"((d0) * 2048), "i"((d0) * 2048 + 1024))
#define KWAIT(n, a, b) asm volatile("s_waitcnt lgkmcnt(" #n ")" : "+v"(a), "+v"(b))
__device__ __forceinline__ void qkt2(f32x16& p0, f32x16& p1, int kaddr, const bf16x8 (&qr)[12], const f32x16& cinit) {
  p0 = cinit; p1 = cinit;
#if ATT_KDEPTH == 2
  bf16x8 ka0, ka1, kb0, kb1, kc0, kc1;
  KREAD(ka0, ka1, 0); KREAD(kb0, kb1, 1);
#define KSTEP(x0, x1, d0) do { if ((d0) + 2 < 12) { KWAIT(4, x0, x1); } else if ((d0) + 1 < 12) { KWAIT(2, x0, x1); } else { KWAIT(0, x0, x1); } \
    p0 = __builtin_amdgcn_mfma_f32_32x32x16_bf16(x0, qr[d0], p0, 0, 0, 0); p1 = __builtin_amdgcn_mfma_f32_32x32x16_bf16(x1, qr[d0], p1, 0, 0, 0); } while (0)
#pragma unroll
  for (int d0 = 0; d0 < 12; d0 += 3) {
    KREAD(kc0, kc1, d0 + 2); KSTEP(ka0, ka1, d0);
    if (d0 + 3 < 12) KREAD(ka0, ka1, d0 + 3);
    KSTEP(kb0, kb1, d0 + 1);
    if (d0 + 4 < 12) KREAD(kb0, kb1, d0 + 4);
    KSTEP(kc0, kc1, d0 + 2);
  }
#undef KSTEP
#else
  bf16x8 ka0, ka1, kb0, kb1;
  KREAD(ka0, ka1, 0);
#pragma unroll
  for (int d0 = 0; d0 < 12; d0 += 2) {
    KREAD(kb0, kb1, d0 + 1); KWAIT(2, ka0, ka1);
    p0 = __builtin_amdgcn_mfma_f32_32x32x16_bf16(ka0, qr[d0], p0, 0, 0, 0); p1 = __builtin_amdgcn_mfma_f32_32x32x16_bf16(ka1, qr[d0], p1, 0, 0, 0);
    if (d0 + 2 < 12) { KREAD(ka0, ka1, d0 + 2); KWAIT(2, kb0, kb1); } else { KWAIT(0, kb0, kb1); }
    p0 = __builtin_amdgcn_mfma_f32_32x32x16_bf16(kb0, qr[d0 + 1], p0, 0, 0, 0); p1 = __builtin_amdgcn_mfma_f32_32x32x16_bf16(kb1, qr[d0 + 1], p1, 0, 0, 0);
  }
#endif
}
#undef KREAD
#undef KWAIT
template <int D0> __device__ __forceinline__ void pv_reads(s16x4 (&t)[8], int vb) {
  t[0] = tr_read<v_rd_off(D0, 0, 0)>(vb); t[1] = tr_read<v_rd_off(D0, 0, 1)>(vb); t[2] = tr_read<v_rd_off(D0, 1, 0)>(vb); t[3] = tr_read<v_rd_off(D0, 1, 1)>(vb);
  t[4] = tr_read<v_rd_off(D0, 2, 0)>(vb); t[5] = tr_read<v_rd_off(D0, 2, 1)>(vb); t[6] = tr_read<v_rd_off(D0, 3, 0)>(vb); t[7] = tr_read<v_rd_off(D0, 3, 1)>(vb);
}
__device__ __forceinline__ void pv_mma(f32x16& od, const s16x4 (&t)[8], bf16x8 pa0, bf16x8 pa1, bf16x8 pa2, bf16x8 pa3) {
#define PK(L, H) (bf16x8){L[0], L[1], L[2], L[3], H[0], H[1], H[2], H[3]}
  od = __builtin_amdgcn_mfma_f32_32x32x16_bf16(pa0, PK(t[0], t[1]), od, 0, 0, 0);
  od = __builtin_amdgcn_mfma_f32_32x32x16_bf16(pa1, PK(t[2], t[3]), od, 0, 0, 0);
  od = __builtin_amdgcn_mfma_f32_32x32x16_bf16(pa2, PK(t[4], t[5]), od, 0, 0, 0);
  od = __builtin_amdgcn_mfma_f32_32x32x16_bf16(pa3, PK(t[6], t[7]), od, 0, 0, 0);
#undef PK
}
#define PVW(n) do { asm volatile("s_waitcnt lgkmcnt(" #n ")" ::: "memory"); SBAR(); } while (0)
__device__ __forceinline__ void pv_sm2(f32x16 (&o)[4], int vb, bf16x8 pa0, bf16x8 pa1, bf16x8 pa2, bf16x8 pa3, f32x16& pX0, f32x16& pX1, float& m_reg, float& alpha) {
  float mnC; s16x4 ta[8], tb[8];
  pv_reads<0>(ta, vb);
  pv_reads<1>(tb, vb); PVW(8); pv_mma(o[0], ta, pa0, pa1, pa2, pa3); float pm = sm_rowmax(pX0, pX1); asm volatile("" : "+v"(pm));
  pv_reads<2>(ta, vb); PVW(8); pv_mma(o[1], tb, pa0, pa1, pa2, pa3); sm_decide(pm, m_reg, mnC, alpha); sm_scale(pX0, mnC); asm volatile("" : "+v"(pX0));
  pv_reads<3>(tb, vb); PVW(8); pv_mma(o[2], ta, pa0, pa1, pa2, pa3); sm_scale(pX1, mnC); sm_exp<0, 8>(pX0); asm volatile("" : "+v"(pX0), "+v"(pX1));
  PVW(0); pv_mma(o[3], tb, pa0, pa1, pa2, pa3); sm_exp<8, 16>(pX0); asm volatile("" : "+v"(pX0));
}
__device__ __forceinline__ void pv_sm3(f32x16 (&o)[4], int vb, bf16x8 pa0, bf16x8 pa1, bf16x8 pa2, bf16x8 pa3, f32x16& pX0, f32x16& pX1, float& m_reg, float& alpha, s16x4 (&ta)[8]) {
  float mnC; s16x4 tb[8];
  pv_reads<1>(tb, vb); PVW(8); pv_mma(o[0], ta, pa0, pa1, pa2, pa3); float pm = sm_rowmax(pX0, pX1); asm volatile("" : "+v"(pm));
  pv_reads<2>(ta, vb); PVW(8); pv_mma(o[1], tb, pa0, pa1, pa2, pa3); sm_decide(pm, m_reg, mnC, alpha); sm_scale(pX0, mnC); asm volatile("" : "+v"(pX0));
  pv_reads<3>(tb, vb); PVW(8); pv_mma(o[2], ta, pa0, pa1, pa2, pa3); sm_scale(pX1, mnC); sm_exp<0, 8>(pX0); asm volatile("" : "+v"(pX0), "+v"(pX1));
  PVW(0); pv_mma(o[3], tb, pa0, pa1, pa2, pa3); sm_exp<8, 16>(pX0); asm volatile("" : "+v"(pX0));
}
constexpr float THRL = THR * 1.4426950408889634f;
__device__ __forceinline__ void sm_grow(float pm, f32x16& p0, f32x16& p1, float& m_reg, float& alpha, f32x16& negm) {
  const bool grow = pm > THRL;
  alpha = 1.f;
  if (__any(grow)) {
    const float dl = grow ? pm : 0.f;
#pragma unroll
    for (int r = 0; r < 16; ++r) { p0[r] -= dl; p1[r] -= dl; }
    m_reg += dl; alpha = __builtin_amdgcn_exp2f(-dl);
    const float nm = -m_reg;
#pragma unroll
    for (int r = 0; r < 16; ++r) negm[r] = nm;
  }
}
__device__ __forceinline__ void pv_sm4(f32x16 (&o)[4], int vb, bf16x8 pa0, bf16x8 pa1, bf16x8 pa2, bf16x8 pa3, f32x16& pX0, f32x16& pX1, float& m_reg, float& alpha, f32x16& negm) {
  s16x4 ta[8], tb[8];
  pv_reads<0>(ta, vb);
  pv_reads<1>(tb, vb); PVW(8); pv_mma(o[0], ta, pa0, pa1, pa2, pa3); float pm = sm_rowmax(pX0, pX1); asm volatile("" : "+v"(pm));
  pv_reads<2>(ta, vb); PVW(8); pv_mma(o[1], tb, pa0, pa1, pa2, pa3); sm_grow(pm, pX0, pX1, m_reg, alpha, negm); sm_exp<0, 6>(pX0); asm volatile("" : "+v"(pX0));
  pv_reads<3>(tb, vb); PVW(8); pv_mma(o[2], ta, pa0, pa1, pa2, pa3); sm_exp<6, 12>(pX0); asm volatile("" : "+v"(pX0));
  PVW(0); pv_mma(o[3], tb, pa0, pa1, pa2, pa3); sm_exp<12, 16>(pX0); asm volatile("" : "+v"(pX0));
}
__device__ __forceinline__ void pv_sm5(f32x16 (&o)[4], int vb, bf16x8 pa0, bf16x8 pa1, bf16x8 pa2, bf16x8 pa3, f32x16& pX0, f32x16& pX1, float& m_reg, float& alpha, f32x16& negm, s16x4 (&ta)[8]) {
  s16x4 tb[8];
  pv_reads<1>(tb, vb); PVW(8); pv_mma(o[0], ta, pa0, pa1, pa2, pa3); float pm = sm_rowmax(pX0, pX1); asm volatile("" : "+v"(pm));
  pv_reads<2>(ta, vb); PVW(8); pv_mma(o[1], tb, pa0, pa1, pa2, pa3); sm_grow(pm, pX0, pX1, m_reg, alpha, negm); sm_exp<0, 6>(pX0); asm volatile("" : "+v"(pX0));
  pv_reads<3>(tb, vb); PVW(8); pv_mma(o[2], ta, pa0, pa1, pa2, pa3); sm_exp<6, 12>(pX0); asm volatile("" : "+v"(pX0));
  PVW(0); pv_mma(o[3], tb, pa0, pa1, pa2, pa3); sm_exp<12, 16>(pX0); asm volatile("" : "+v"(pX0));
}
__device__ __forceinline__ void pv_d02(f32x16 (&o)[4], int vb, bf16x8 pa0, bf16x8 pa1, bf16x8 pa2, bf16x8 pa3) {
  s16x4 ta[8], tb[8];
  pv_reads<0>(ta, vb);
  pv_reads<1>(tb, vb); PVW(8); pv_mma(o[0], ta, pa0, pa1, pa2, pa3);
  pv_reads<2>(ta, vb); PVW(8); pv_mma(o[1], tb, pa0, pa1, pa2, pa3);
  pv_reads<3>(tb, vb); PVW(8); pv_mma(o[2], ta, pa0, pa1, pa2, pa3);
  PVW(0); pv_mma(o[3], tb, pa0, pa1, pa2, pa3);
}
__device__ __forceinline__ int krow(int j, int b) { return j < 256 ? b * SEQ + 64 * j : M_LAT + b * CTXL + 64 * (j - 256); }

__device__ __forceinline__ void attn_unit(const bf16* __restrict__ Qb, const bf16* __restrict__ KNh, const bf16* __restrict__ KPE, const bf16* __restrict__ Vh, bf16* __restrict__ Ob, int b, LAS char* lds) {
  int tid_l = threadIdx.x; asm volatile("" : "+v"(tid_l));
  const int tid = tid_l, wid = __builtin_amdgcn_readfirstlane(tid >> 6), lane = tid & 63, r32 = lane & 31, hi = lane >> 5;
  LAS char* V_lds = lds; LAS char* K_lds = lds + ATT_OFF_K;
  LAS float* wsf = (LAS float*)(lds + ATT_OFF_WS) + wid * 64; LAS float* li_l = wsf; LAS float* al_l = wsf + 32;
  LAS char* ost = lds + ATT_OFF_OST + wid * 8192;
  LAS char* qpe = lds + ATT_OFF_QPE + wid * ((12 - NQR) * 1024) + lane * 16;
  float m_reg = -1e30f, l_reg = 0; f32x16 o[4] = {}; bf16x8 qr[NQR];
  const bf16* Qw = Qb + (size_t)(wid * 32 + r32) * 3072 + hi * 8;
#pragma unroll
  for (int d0 = 0; d0 < NQR; ++d0) qr[d0] = *reinterpret_cast<const bf16x8*>(Qw + d0 * 16);
#pragma unroll
  for (int d0 = NQR; d0 < 12; ++d0) *reinterpret_cast<LAS bf16x8*>(qpe + (d0 - NQR) * 1024) = *reinterpret_cast<const bf16x8*>(Qw + d0 * 16);
  const int sr = tid >> 4, sc = (tid & 15) * 8, vst0 = v_st(sr, sc), vst1 = v_st(32 + sr, sc);
  const int khalf = lane & 1, krl = (lane >> 1) & 3, kc8 = (lane >> 3) & 7, kswz = wid & 1;
  const int krow0 = 8 * wid + krl, krow1 = krow0 + 4, kcol = kc8 * 16 + khalf * 8;
  const int kst0 = kc8 * 2048 + krow0 * 32 + ((khalf ^ kswz) * 16), kst1 = kst0 + 128;
  const int prow = 8 * wid + 4 * (lane >> 5) + krl, pcol = ((lane >> 3) & 3) * 16 + khalf * 8, kst2 = (8 + ((lane >> 3) & 3)) * 2048 + prow * 32 + ((khalf ^ kswz) * 16);
  const LAS char* krd = K_lds + r32 * 32 + ((hi ^ ((r32 >> 3) & 1)) * 16);
  const int vb0 = (int)(unsigned)(uintptr_t)V_lds + v_rd_base(lane);
  bf16x8 vs0, vs1, ks0, ks1, kp;
  const unsigned ovs0 = (unsigned)(sr * D + sc) * 2u, okn0 = (unsigned)(krow0 * D + kcol) * 2u, okp = (unsigned)(prow * 64 + pcol) * 2u;
#define SLOAD(j) do { const unsigned rb_ = (unsigned)krow((j), b), rv_ = rb_ * (unsigned)(D * 2), rp_ = rb_ * 128u; \
    vs0 = *reinterpret_cast<const bf16x8*>(reinterpret_cast<const char*>(Vh) + (size_t)(rv_ + ovs0)); vs1 = *reinterpret_cast<const bf16x8*>(reinterpret_cast<const char*>(Vh) + (size_t)(rv_ + ovs0 + 32u * D * 2u)); \
    ks0 = *reinterpret_cast<const bf16x8*>(reinterpret_cast<const char*>(KNh) + (size_t)(rv_ + okn0)); ks1 = *reinterpret_cast<const bf16x8*>(reinterpret_cast<const char*>(KNh) + (size_t)(rv_ + okn0 + 4u * D * 2u)); \
    kp = *reinterpret_cast<const bf16x8*>(reinterpret_cast<const char*>(KPE) + (size_t)(rp_ + okp)); } while (0)
#define SWRITE(bb) do { *(LAS bf16x8*)(V_lds + (bb) * ATT_SHM_V + vst0) = vs0; *(LAS bf16x8*)(V_lds + (bb) * ATT_SHM_V + vst1) = vs1; \
    *(LAS bf16x8*)(K_lds + (bb) * ATT_SHM_K + kst0) = ks0; *(LAS bf16x8*)(K_lds + (bb) * ATT_SHM_K + kst1) = ks1; *(LAS bf16x8*)(K_lds + (bb) * ATT_SHM_K + kst2) = kp; } while (0)
#define SWAIT() asm volatile("s_waitcnt vmcnt(0)" ::: "memory")
#define RESC(a) do { if (__any((a) < 1.f)) { if (hi == 0) al_l[r32] = (a); asm volatile("s_waitcnt lgkmcnt(0)" ::: "memory"); \
    _Pragma("unroll") for (int d = 0; d < 4; ++d) _Pragma("unroll") for (int r = 0; r < 16; ++r) o[d][r] *= al_l[crow(r, hi)]; } } while (0)
  f32x16 pA0, pA1, pB0, pB1; float alA, alB; bf16x8 pa0, pa1, pa2, pa3;
  SLOAD(0); SWAIT(); SWRITE(0); __syncthreads();
  qkt<NQR>(pA0, pA1, krd, qr, qpe); partialSM(pA0, pA1, m_reg, alA);
  SLOAD(1);
  SWAIT(); SWRITE(1); __syncthreads();
  for (int j = 1; j + 1 < NT; j += 2) {
    SBAR(); qkt<NQR>(pB0, pB1, krd + ATT_SHM_K, qr, qpe);
    finishSM(pA0, pA1, alA, l_reg, pa0, pa1, pa2, pa3); SBAR();
    SLOAD(j + 1); SBAR();
    pv_sm(o, vb0, pa0, pa1, pa2, pa3, pB0, pB1, m_reg, alB);
    __syncthreads(); SWAIT(); SWRITE(0);
    RESC(alB); __syncthreads();
    SBAR(); qkt<NQR>(pA0, pA1, krd, qr, qpe);
    finishSM(pB0, pB1, alB, l_reg, pa0, pa1, pa2, pa3); SBAR();
    SLOAD(j + 2); SBAR();
    pv_sm(o, vb0 + ATT_SHM_V, pa0, pa1, pa2, pa3, pA0, pA1, m_reg, alA);
    __syncthreads(); SWAIT(); SWRITE(1);
    RESC(alA); __syncthreads();
  }
  SBAR(); qkt<NQR>(pB0, pB1, krd + ATT_SHM_K, qr, qpe);
  finishSM(pA0, pA1, alA, l_reg, pa0, pa1, pa2, pa3); SBAR();
  pv_sm(o, vb0, pa0, pa1, pa2, pa3, pB0, pB1, m_reg, alB);
  __syncthreads(); RESC(alB);
  finishSM(pB0, pB1, alB, l_reg, pa0, pa1, pa2, pa3); SBAR();
  pv_d0(o, vb0 + ATT_SHM_V, pa0, pa1, pa2, pa3);
  __syncthreads();
  if (hi == 0) li_l[r32] = l_reg; asm volatile("s_waitcnt lgkmcnt(0)" ::: "memory");
#pragma unroll
  for (int r = 0; r < 16; ++r) { const int orow = crow(r, hi); const float rl = __builtin_amdgcn_rcpf(li_l[orow]);
#pragma unroll
    for (int d0 = 0; d0 < 4; ++d0) *(LAS unsigned short*)(ost + orow * 256 + (d0 * 32 + r32) * 2) = (unsigned short)f2bf(o[d0][r] * rl); }
  asm volatile("s_waitcnt lgkmcnt(0)" ::: "memory");
#pragma unroll
  for (int i = 0; i < 8; ++i) { const int gidx = i * 64 + lane, row = gidx >> 4, cg = gidx & 15;
    const v4u v = *(const LAS v4u*)(ost + row * 256 + cg * 16);
    *(GAS v4u*)(Ob + (size_t)(wid * 32 + row) * D + cg * 8) = v; }
  __syncthreads();
#undef SLOAD
#undef SWRITE
#undef SWAIT
#undef RESC
}

#ifndef ATT_KDEPTH
#define ATT_KDEPTH 2
#endif
#ifndef ATT_EARLYTR
#define ATT_EARLYTR 0
#endif
#ifndef ATT_QKPIPE
#define ATT_QKPIPE 1
#endif
#ifndef ATT_PVPIPE
#define ATT_PVPIPE 1
#endif
#if ATT_PVPIPE
#define PVSM pv_sm2
#define PVD0 pv_d02
#else
#define PVSM pv_sm
#define PVD0 pv_d0
#endif
constexpr int DBUF = 40960, DOFF_K = 16384, DOFF_WS = 3 * DBUF, DOFF_QPE = DOFF_WS + NWAVES * 256, NQD = ATT_NQD;
static_assert(DOFF_QPE + NWAVES * (12 - NQD) * 1024 <= MISC_OFF, "attention (DMA variant) LDS map");

template <int S> __device__ __forceinline__ pg8::f32x4 sub_get(const f32x16& v) { return __builtin_shufflevector(v, v, 4 * S, 4 * S + 1, 4 * S + 2, 4 * S + 3); }
template <int S> __device__ __forceinline__ void sub_put(f32x16& v, pg8::f32x4 x) {
  const f32x16 w = __builtin_shufflevector(x, x, 0, 1, 2, 3, -1, -1, -1, -1, -1, -1, -1, -1, -1, -1, -1, -1);
  if constexpr (S == 0) v = __builtin_shufflevector(v, w, 16, 17, 18, 19, 4, 5, 6, 7, 8, 9, 10, 11, 12, 13, 14, 15);
  else if constexpr (S == 1) v = __builtin_shufflevector(v, w, 0, 1, 2, 3, 16, 17, 18, 19, 8, 9, 10, 11, 12, 13, 14, 15);
  else if constexpr (S == 2) v = __builtin_shufflevector(v, w, 0, 1, 2, 3, 4, 5, 6, 7, 16, 17, 18, 19, 12, 13, 14, 15);
  else v = __builtin_shufflevector(v, w, 0, 1, 2, 3, 4, 5, 6, 7, 8, 9, 10, 11, 16, 17, 18, 19);
}
#define M16(v, S, A, B) sub_put<S>(v, __builtin_amdgcn_mfma_f32_16x16x32_bf16(A, B, sub_get<S>(v), 0, 0, 0))
#define MKREAD(a, b, d0) asm volatile("ds_read_b128 %0, %2 offset:%3\n\tds_read_b128 %1, %2 offset:%4" : "=&v"(a), "=&v"(b) : "v"(kaddr), "i"((d0) * 2048), "i"((d0) * 2048 + 1024))
#define MKWAIT(n, a, b) asm volatile("s_waitcnt lgkmcnt(" #n ")" : "+v"(a), "+v"(b))
__device__ __forceinline__ void qkt16_mock(f32x16& p0, f32x16& p1, int kaddr, const bf16x8 (&qr)[12], const f32x16& cinit) {
  p0 = cinit; p1 = cinit;
  bf16x8 ka0, ka1, kb0, kb1;
  MKREAD(ka0, ka1, 0);
#pragma unroll
  for (int d0 = 0; d0 < 12; d0 += 2) {
    MKREAD(kb0, kb1, d0 + 1); MKWAIT(2, ka0, ka1);
    M16(p0, 0, ka0, qr[d0 % 6]); M16(p0, 1, ka1, qr[d0 % 6]); M16(p1, 0, ka0, qr[(d0 + 1) % 6]); M16(p1, 1, ka1, qr[(d0 + 1) % 6]);
    if (d0 + 2 < 12) { MKREAD(ka0, ka1, d0 + 2); MKWAIT(2, kb0, kb1); } else { MKWAIT(0, kb0, kb1); }
    M16(p0, 2, kb0, qr[(d0 + 1) % 6]); M16(p0, 3, kb1, qr[(d0 + 1) % 6]); M16(p1, 2, kb0, qr[d0 % 6]); M16(p1, 3, kb1, qr[d0 % 6]);
  }
}
#undef MKREAD
#undef MKWAIT
__device__ __forceinline__ void pv_mma16_mock(f32x16& od, const s16x4 (&t)[8], bf16x8 pa0, bf16x8 pa1, bf16x8 pa2, bf16x8 pa3) {
#define PK(L, H) (bf16x8){L[0], L[1], L[2], L[3], H[0], H[1], H[2], H[3]}
  M16(od, 0, pa0, PK(t[0], t[1])); M16(od, 1, pa0, PK(t[0], t[1])); M16(od, 2, pa1, PK(t[2], t[3])); M16(od, 3, pa1, PK(t[2], t[3]));
  M16(od, 0, pa2, PK(t[4], t[5])); M16(od, 1, pa2, PK(t[4], t[5])); M16(od, 2, pa3, PK(t[6], t[7])); M16(od, 3, pa3, PK(t[6], t[7]));
#undef PK
}
#undef M16
__device__ __forceinline__ void pv_sm4_mock(f32x16 (&o)[4], int vb, bf16x8 pa0, bf16x8 pa1, bf16x8 pa2, bf16x8 pa3, f32x16& pX0, f32x16& pX1, float& m_reg, float& alpha, f32x16& negm) {
  s16x4 ta[8], tb[8];
  pv_reads<0>(ta, vb);
  pv_reads<1>(tb, vb); PVW(8); pv_mma16_mock(o[0], ta, pa0, pa1, pa2, pa3); float pm = sm_rowmax(pX0, pX1); asm volatile("" : "+v"(pm));
  pv_reads<2>(ta, vb); PVW(8); pv_mma16_mock(o[1], tb, pa0, pa1, pa2, pa3); sm_grow(pm, pX0, pX1, m_reg, alpha, negm); sm_exp<0, 6>(pX0); asm volatile("" : "+v"(pX0));
  pv_reads<3>(tb, vb); PVW(8); pv_mma16_mock(o[2], ta, pa0, pa1, pa2, pa3); sm_exp<6, 12>(pX0); asm volatile("" : "+v"(pX0));
  PVW(0); pv_mma16_mock(o[3], tb, pa0, pa1, pa2, pa3); sm_exp<12, 16>(pX0); asm volatile("" : "+v"(pX0));
}
__device__ __forceinline__ void fsm_raw(f32x16& p0, f32x16& p1, bf16x8& pa0, bf16x8& pa1, bf16x8& pa2, bf16x8& pa3) {
  v4u w0 = {__float_as_uint(p0[0]), __float_as_uint(p0[1]), __float_as_uint(p0[2]), __float_as_uint(p0[3])}, w1 = {__float_as_uint(p0[8]), __float_as_uint(p0[9]), __float_as_uint(p0[10]), __float_as_uint(p0[15])};
  v4u w2 = {__float_as_uint(p1[0]), __float_as_uint(p1[1]), __float_as_uint(p1[2]), __float_as_uint(p1[3])}, w3 = {__float_as_uint(p1[8]), __float_as_uint(p1[9]), __float_as_uint(p1[10]), __float_as_uint(p1[15])};
  pa0 = *reinterpret_cast<bf16x8*>(&w0); pa1 = *reinterpret_cast<bf16x8*>(&w1); pa2 = *reinterpret_cast<bf16x8*>(&w2); pa3 = *reinterpret_cast<bf16x8*>(&w3);
}
__device__ __forceinline__ void qkt_noread(f32x16& p0, f32x16& p1, const bf16x8 (&qr)[12], const f32x16& cinit) {
  p0 = cinit; p1 = cinit;
#pragma unroll
  for (int d0 = 0; d0 < 12; ++d0) { p0 = __builtin_amdgcn_mfma_f32_32x32x16_bf16(qr[(d0 + 1) % 12], qr[d0], p0, 0, 0, 0); p1 = __builtin_amdgcn_mfma_f32_32x32x16_bf16(qr[(d0 + 2) % 12], qr[d0], p1, 0, 0, 0); }
}
__device__ __forceinline__ void qkt_nomma(f32x16& p0, f32x16& p1, int kaddr, const bf16x8 (&qr)[12], const f32x16& cinit) {
  p0 = cinit; p1 = cinit;
#pragma unroll
  for (int d0 = 0; d0 < 12; ++d0) { bf16x8 a, b2;
    asm volatile("ds_read_b128 %0, %2 offset:%3\n\tds_read_b128 %1, %2 offset:%4\n\ts_waitcnt lgkmcnt(0)" : "=&v"(a), "=&v"(b2) : "v"(kaddr), "i"(d0 * 2048), "i"(d0 * 2048 + 1024));
    p0[d0] += (float)a[0]; p1[d0] += (float)b2[0]; }
}
__device__ __forceinline__ void pv_sm4_noread(f32x16 (&o)[4], bf16x8 pa0, bf16x8 pa1, bf16x8 pa2, bf16x8 pa3, f32x16& pX0, f32x16& pX1, float& m_reg, float& alpha, f32x16& negm) {
#define PVM(od) do { od = __builtin_amdgcn_mfma_f32_32x32x16_bf16(pa0, pa1, od, 0, 0, 0); od = __builtin_amdgcn_mfma_f32_32x32x16_bf16(pa1, pa2, od, 0, 0, 0); od = __builtin_amdgcn_mfma_f32_32x32x16_bf16(pa2, pa3, od, 0, 0, 0); od = __builtin_amdgcn_mfma_f32_32x32x16_bf16(pa3, pa0, od, 0, 0, 0); } while (0)
  PVM(o[0]); float pm = sm_rowmax(pX0, pX1); asm volatile("" : "+v"(pm));
  PVM(o[1]); sm_grow(pm, pX0, pX1, m_reg, alpha, negm); sm_exp<0, 6>(pX0); asm volatile("" : "+v"(pX0));
  PVM(o[2]); sm_exp<6, 12>(pX0); asm volatile("" : "+v"(pX0));
  PVM(o[3]); sm_exp<12, 16>(pX0); asm volatile("" : "+v"(pX0));
#undef PVM
}
template <int ABL = 0> __device__ __forceinline__ void attn_unit_dma(const bf16* __restrict__ Qb, const bf16* __restrict__ KNh, const bf16* __restrict__ KPE, const bf16* __restrict__ Vh, bf16* __restrict__ Ob, int b, LAS char* lds) {
  int tid_l = threadIdx.x; asm volatile("" : "+v"(tid_l));
  const int tid = tid_l, wid = __builtin_amdgcn_readfirstlane(tid >> 6), lane = tid & 63, r32 = lane & 31, hi = lane >> 5;
  LAS float* wsf = (LAS float*)(lds + DOFF_WS) + wid * 64; LAS float* li_l = wsf; LAS float* al_l = wsf + 32;
  LAS char* ost = lds + wid * 8192;
  LAS char* qpe = lds + DOFF_QPE + wid * ((12 - NQD) * 1024) + lane * 16;
  float m_reg = -1e30f, l_reg = 0; f32x16 o[4] = {}; bf16x8 qr[NQD];
  const bf16* Qw = Qb + (size_t)(wid * 32 + r32) * 3072 + hi * 8;
#pragma unroll
  for (int d0 = 0; d0 < NQD; ++d0) qr[d0] = *reinterpret_cast<const bf16x8*>(Qw + d0 * 16);
#pragma unroll
  for (int d0 = NQD; d0 < 12; ++d0) *reinterpret_cast<LAS bf16x8*>(qpe + (d0 - NQD) * 1024) = *reinterpret_cast<const bf16x8*>(Qw + d0 * 16);
  unsigned ovs, okn, okp;
  { const int kk = 8 * (wid >> 1) + ((lane & 31) >> 2), k = (kk & ~0xC) | ((kk & 4) << 1) | ((kk & 8) >> 1), col = 32 * (2 * (wid & 1) + (lane >> 5)) + 8 * (lane & 3);
    ovs = (unsigned)(k * D + col) * 2u;
    const int row = 32 * (wid & 1) + (lane >> 1), half = (lane & 1) ^ ((row >> 3) & 1);
    okn = (unsigned)(row * D + (wid >> 1) * 16 + half * 8) * 2u; okp = (unsigned)(row * 64 + (wid >> 1) * 16 + half * 8) * 2u; }
  const int krd0 = r32 * 32 + ((hi ^ ((r32 >> 3) & 1)) * 16) + DOFF_K;
  const int vrd0 = (int)(unsigned)(uintptr_t)lds + v_rd_base(lane);
#define DMA_TILE(j, boff) do { const unsigned rb_ = (unsigned)krow((j), b), rv_ = rb_ * (unsigned)(D * 2), rp_ = rb_ * 128u; LAS char* d_ = lds + (boff) + wid * 1024; \
    __builtin_amdgcn_global_load_lds((const unsigned*)(reinterpret_cast<const char*>(Vh) + (size_t)(rv_ + ovs)), (LAS unsigned*)d_, 16, 0, 0); \
    __builtin_amdgcn_global_load_lds((const unsigned*)(reinterpret_cast<const char*>(Vh) + (size_t)(rv_ + ovs + 32u * D * 2u)), (LAS unsigned*)(d_ + 8192), 16, 0, 0); \
    __builtin_amdgcn_global_load_lds((const unsigned*)(reinterpret_cast<const char*>(KNh) + (size_t)(rv_ + okn)), (LAS unsigned*)(d_ + DOFF_K), 16, 0, 0); \
    __builtin_amdgcn_global_load_lds((const unsigned*)(reinterpret_cast<const char*>(KNh) + (size_t)(rv_ + okn + 128u)), (LAS unsigned*)(d_ + DOFF_K + 8192), 16, 0, 0); \
    __builtin_amdgcn_global_load_lds((const unsigned*)(reinterpret_cast<const char*>(KPE) + (size_t)(rp_ + okp)), (LAS unsigned*)(d_ + DOFF_K + 16384), 16, 0, 0); } while (0)
#if ATT_QKPIPE
#define QKT(x0, x1) do { if constexpr (ABL == 7) qkt16_mock(x0, x1, (int)(unsigned)(uintptr_t)lds + o_cur + krd0, qr, negm); else if constexpr (ABL == 2) qkt_noread(x0, x1, qr, negm); else if constexpr (ABL == 6) qkt_nomma(x0, x1, (int)(unsigned)(uintptr_t)lds + o_cur + krd0, qr, negm); else qkt2(x0, x1, (int)(unsigned)(uintptr_t)lds + o_cur + krd0, qr, negm); } while (0)
#else
#define QKT(x0, x1) qkt<NQD>(x0, x1, lds + o_cur + krd0, qr, qpe)
#endif
#if ATT_EARLYTR
#define EARLY_TR() pv_reads<0>(tr0, vrd0 + o_prev)
#define PVSM3(x0, x1, al) pv_sm5(o, vrd0 + o_prev, pa0, pa1, pa2, pa3, x0, x1, m_reg, al, negm, tr0)
#else
#define EARLY_TR() do { } while (0)
#define PVSM3(x0, x1, al) do { if constexpr (ABL == 7) pv_sm4_mock(o, vrd0 + o_prev, pa0, pa1, pa2, pa3, x0, x1, m_reg, al, negm); else if constexpr (ABL == 1) { al = 1.f; pv_d02(o, vrd0 + o_prev, pa0, pa1, pa2, pa3); } else if constexpr (ABL == 2) pv_sm4_noread(o, pa0, pa1, pa2, pa3, x0, x1, m_reg, al, negm); else pv_sm4(o, vrd0 + o_prev, pa0, pa1, pa2, pa3, x0, x1, m_reg, al, negm); } while (0)
#endif
#define TILE_BAR() do { if constexpr (ABL == 4) { asm volatile("s_waitcnt lgkmcnt(0)" ::: "memory"); } else { asm volatile("s_waitcnt vmcnt(0) lgkmcnt(0)" ::: "memory"); __builtin_amdgcn_s_barrier(); asm volatile("" ::: "memory"); } } while (0)
#define RESC(a) do { if (__any((a) < 1.f)) { if (hi == 0) al_l[r32] = (a); asm volatile("s_waitcnt lgkmcnt(0)" ::: "memory"); \
    _Pragma("unroll") for (int d = 0; d < 4; ++d) _Pragma("unroll") for (int r = 0; r < 16; ++r) o[d][r] *= al_l[crow(r, hi)]; } } while (0)
#define FSM(x0, x1, al) do { if constexpr (ABL == 1) fsm_raw(x0, x1, pa0, pa1, pa2, pa3); else finishSM(x0, x1, al, l_reg, pa0, pa1, pa2, pa3); } while (0)
#define ROT() do { const int t_ = o_prev; o_prev = o_cur; o_cur = o_next; o_next = t_; } while (0)
  f32x16 pA0, pA1, pB0, pB1; float alA, alB; bf16x8 pa0, pa1, pa2, pa3; s16x4 tr0[8];
  int o_prev = 2 * DBUF, o_cur = 0, o_next = DBUF;
  DMA_TILE(0, 0); DMA_TILE(1, DBUF);
  asm volatile("s_waitcnt vmcnt(5) lgkmcnt(0)" ::: "memory"); __builtin_amdgcn_s_barrier(); asm volatile("" ::: "memory");
  f32x16 negm = {};
  QKT(pA0, pA1);
  { const float pm0 = sm_rowmax(pA0, pA1); m_reg = pm0; alA = 1.f;
#pragma unroll
    for (int r = 0; r < 16; ++r) { pA0[r] -= pm0; pA1[r] -= pm0; negm[r] = -pm0; }
    sm_exp<0, 16>(pA0); }
  TILE_BAR(); DMA_TILE(2, 2 * DBUF); ROT();
  for (int j = 1; j + 1 < NT; j += 2) {
    SBAR(); QKT(pB0, pB1); EARLY_TR();
    FSM(pA0, pA1, alA); SBAR();
    PVSM3(pB0, pB1, alB);
    TILE_BAR(); if (ABL != 4 && j + 2 < NT) DMA_TILE(j + 2, o_prev); ROT();
    RESC(alB);
    SBAR(); QKT(pA0, pA1); EARLY_TR();
    FSM(pB0, pB1, alB); SBAR();
    PVSM3(pA0, pA1, alA);
    TILE_BAR(); if (ABL != 4 && j + 3 < NT) DMA_TILE(j + 3, o_prev); ROT();
    RESC(alA);
  }
  SBAR(); QKT(pB0, pB1); EARLY_TR();
  FSM(pA0, pA1, alA); SBAR();
  PVSM3(pB0, pB1, alB);
  RESC(alB);
  FSM(pB0, pB1, alB); SBAR();
  PVD0(o, vrd0 + o_cur, pa0, pa1, pa2, pa3);
  TILE_BAR();
  if (hi == 0) li_l[r32] = l_reg; asm volatile("s_waitcnt lgkmcnt(0)" ::: "memory");
#pragma unroll
  for (int r = 0; r < 16; ++r) { const int orow = crow(r, hi); const float rl = __builtin_amdgcn_rcpf(li_l[orow]);
#pragma unroll
    for (int d0 = 0; d0 < 4; ++d0) *(LAS unsigned short*)(ost + orow * 256 + (d0 * 32 + r32) * 2) = (unsigned short)f2bf(o[d0][r] * rl); }
  asm volatile("s_waitcnt lgkmcnt(0)" ::: "memory");
#pragma unroll
  for (int i = 0; i < 8; ++i) { const int gidx = i * 64 + lane, row = gidx >> 4, cg = gidx & 15;
    const v4u v = *(const LAS v4u*)(ost + row * 256 + cg * 16);
    *(GAS v4u*)(Ob + (size_t)(wid * 32 + row) * D + cg * 8) = v; }
  TILE_BAR();
#undef DMA_TILE
#undef EARLY_TR
#undef PVSM3
#undef QKT
#undef TILE_BAR
#undef RESC
#undef ROT
#undef FSM
}

constexpr int PP_VB = 16384, PP_KB = 24576, PP_KRING = 3 * PP_VB;
static_assert(PP_KRING + 3 * PP_KB <= DOFF_WS, "attention (ping-pong variant) LDS map");
__device__ __forceinline__ void attn_unit_pp(const bf16* __restrict__ Qb, const bf16* __restrict__ KNh, const bf16* __restrict__ KPE, const bf16* __restrict__ Vh, bf16* __restrict__ Ob, int b, LAS char* lds, int hot = 0) {
  int tid_l = threadIdx.x; asm volatile("" : "+v"(tid_l));
  const int tid = tid_l, wid = __builtin_amdgcn_readfirstlane(tid >> 6), lane = tid & 63, r32 = lane & 31, hi = lane >> 5;
  const bool late = wid >= 4;
  LAS float* wsf = (LAS float*)(lds + DOFF_WS) + wid * 64; LAS float* li_l = wsf; LAS float* al_l = wsf + 32;
  LAS char* ost = lds + wid * 8192;
  float m_reg = -1e30f, l_reg = 0; f32x16 o[4] = {}; bf16x8 qr[12];
  const bf16* Qw = Qb + (size_t)(wid * 32 + r32) * 3072 + hi * 8;
#pragma unroll
  for (int d0 = 0; d0 < 12; ++d0) qr[d0] = *reinterpret_cast<const bf16x8*>(Qw + d0 * 16);
  unsigned ovs, okn, okp;
  { const int kk = 8 * (wid >> 1) + ((lane & 31) >> 2), k = (kk & ~0xC) | ((kk & 4) << 1) | ((kk & 8) >> 1), col = 32 * (2 * (wid & 1) + (lane >> 5)) + 8 * (lane & 3);
    ovs = (unsigned)(k * D + col) * 2u;
    const int row = 32 * (wid & 1) + (lane >> 1), half = (lane & 1) ^ ((row >> 3) & 1);
    okn = (unsigned)(row * D + (wid >> 1) * 16 + half * 8) * 2u; okp = (unsigned)(row * 64 + (wid >> 1) * 16 + half * 8) * 2u; }
  const int krd0 = (int)(unsigned)(uintptr_t)lds + r32 * 32 + ((hi ^ ((r32 >> 3) & 1)) * 16) + PP_KRING;
  const int vrd0 = (int)(unsigned)(uintptr_t)lds + v_rd_base(lane);
#define DMA_V(j, voff) do { const unsigned rv_ = (unsigned)krow(hot ? ((j) & 3) : (j), b) * (unsigned)(D * 2); LAS char* d_ = lds + (voff) + wid * 1024; \
    __builtin_amdgcn_global_load_lds((const unsigned*)(reinterpret_cast<const char*>(Vh) + (size_t)(rv_ + ovs)), (LAS unsigned*)d_, 16, 0, 0); \
    __builtin_amdgcn_global_load_lds((const unsigned*)(reinterpret_cast<const char*>(Vh) + (size_t)(rv_ + ovs + 32u * D * 2u)), (LAS unsigned*)(d_ + 8192), 16, 0, 0); } while (0)
#define DMA_K(j, koff) do { const unsigned rb_ = (unsigned)krow(hot ? ((j) & 3) : (j), b), rv_ = rb_ * (unsigned)(D * 2), rp_ = rb_ * 128u; LAS char* d_ = lds + PP_KRING + (koff) + wid * 1024; \
    __builtin_amdgcn_global_load_lds((const unsigned*)(reinterpret_cast<const char*>(KNh) + (size_t)(rv_ + okn)), (LAS unsigned*)d_, 16, 0, 0); \
    __builtin_amdgcn_global_load_lds((const unsigned*)(reinterpret_cast<const char*>(KNh) + (size_t)(rv_ + okn + 128u)), (LAS unsigned*)(d_ + 8192), 16, 0, 0); \
    __builtin_amdgcn_global_load_lds((const unsigned*)(reinterpret_cast<const char*>(KPE) + (size_t)(rp_ + okp)), (LAS unsigned*)(d_ + 16384), 16, 0, 0); } while (0)
#define QKT(x0, x1) qkt2(x0, x1, krd0 + k_cur, qr, negm)
#define PVSM3(x0, x1, al) pv_sm4(o, vrd0 + v_prev, pa0, pa1, pa2, pa3, x0, x1, m_reg, al, negm)
#define HBAR(n) do { asm volatile("s_waitcnt vmcnt(" #n ") lgkmcnt(0)" ::: "memory"); __builtin_amdgcn_s_barrier(); asm volatile("" ::: "memory"); } while (0)
#define RESC(a) do { if (__any((a) < 1.f)) { if (hi == 0) al_l[r32] = (a); asm volatile("s_waitcnt lgkmcnt(0)" ::: "memory"); \
    _Pragma("unroll") for (int d = 0; d < 4; ++d) _Pragma("unroll") for (int r = 0; r < 16; ++r) o[d][r] *= al_l[crow(r, hi)]; } } while (0)
#define ROTK() do { const int t_ = k_prev; k_prev = k_cur; k_cur = k_next; k_next = t_; } while (0)
#define ROTV() do { const int t_ = v_prev; v_prev = v_cur; v_cur = v_next; v_next = t_; } while (0)
  f32x16 pA0, pA1, pB0, pB1; float alA, alB; bf16x8 pa0, pa1, pa2, pa3;
  int k_prev = 2 * PP_KB, k_cur = 0, k_next = PP_KB, v_prev = 2 * PP_VB, v_cur = 0, v_next = PP_VB;
  DMA_K(0, 0); DMA_K(1, PP_KB);
  HBAR(3);
  if (late) { __builtin_amdgcn_s_barrier(); asm volatile("" ::: "memory"); }
  f32x16 negm = {};
  DMA_V(0, v_cur); DMA_K(2, k_prev); SBAR();
  QKT(pA0, pA1);
  HBAR(5); ROTK();
  { const float pm0 = sm_rowmax(pA0, pA1); m_reg = pm0; alA = 1.f;
#pragma unroll
    for (int r = 0; r < 16; ++r) { pA0[r] -= pm0; pA1[r] -= pm0; negm[r] = -pm0; }
    sm_exp<0, 16>(pA0); }
  HBAR(3); ROTV();
  for (int j = 1; j + 1 < NT; j += 2) {
    DMA_V(j, v_cur); DMA_K(j + 2 < NT ? j + 2 : NT - 1, k_prev); SBAR();
    QKT(pB0, pB1);
    finishSM(pA0, pA1, alA, l_reg, pa0, pa1, pa2, pa3); SBAR();
    HBAR(5); ROTK();
    PVSM3(pB0, pB1, alB);
    HBAR(3); ROTV();
    RESC(alB);
    DMA_V(j + 1, v_cur); DMA_K(j + 3 < NT ? j + 3 : NT - 1, k_prev); SBAR();
    QKT(pA0, pA1);
    finishSM(pB0, pB1, alB, l_reg, pa0, pa1, pa2, pa3); SBAR();
    HBAR(5); ROTK();
    PVSM3(pA0, pA1, alA);
    HBAR(3); ROTV();
    RESC(alA);
  }
  DMA_V(NT - 1, v_cur); SBAR();
  QKT(pB0, pB1);
  finishSM(pA0, pA1, alA, l_reg, pa0, pa1, pa2, pa3); SBAR();
  HBAR(0); ROTK();
  PVSM3(pB0, pB1, alB);
  HBAR(0); ROTV();
  RESC(alB);
  finishSM(pB0, pB1, alB, l_reg, pa0, pa1, pa2, pa3); SBAR();
  HBAR(0);
  pv_d02(o, vrd0 + v_prev, pa0, pa1, pa2, pa3);
  HBAR(0);
  if (!late) { __builtin_amdgcn_s_barrier(); asm volatile("" ::: "memory"); }
  if (hi == 0) li_l[r32] = l_reg; asm volatile("s_waitcnt lgkmcnt(0)" ::: "memory");
#pragma unroll
  for (int r = 0; r < 16; ++r) { const int orow = crow(r, hi); const float rl = __builtin_amdgcn_rcpf(li_l[orow]);
#pragma unroll
    for (int d0 = 0; d0 < 4; ++d0) *(LAS unsigned short*)(ost + orow * 256 + (d0 * 32 + r32) * 2) = (unsigned short)f2bf(o[d0][r] * rl); }
  asm volatile("s_waitcnt lgkmcnt(0)" ::: "memory");
#pragma unroll
  for (int i = 0; i < 8; ++i) { const int gidx = i * 64 + lane, row = gidx >> 4, cg = gidx & 15;
    const v4u v = *(const LAS v4u*)(ost + row * 256 + cg * 16);
    *(GAS v4u*)(Ob + (size_t)(wid * 32 + row) * D + cg * 8) = v; }
  HBAR(0);
#undef DMA_V
#undef DMA_K
#undef QKT
#undef PVSM3
#undef HBAR
#undef RESC
#undef ROTK
#undef ROTV
}

struct S16 { pg8::f32x4 a[4][2]; };
#define K16READ(a, b, d) asm volatile("ds_read_b128 %0, %2 offset:%3\n\tds_read_b128 %1, %2 offset:%4" : "=&v"(a), "=&v"(b) : "v"(kaddr), "i"(((d) >> 1) * 4096 + ((d) & 1) * 2048), "i"(((d) >> 1) * 4096 + ((d) & 1) * 2048 + 1024))
#define K16WAIT(n, a, b) asm volatile("s_waitcnt lgkmcnt(" #n ")" : "+v"(a), "+v"(b))
#define MF16(A, B, C) __builtin_amdgcn_mfma_f32_16x16x32_bf16(A, B, C, 0, 0, 0)
__device__ __forceinline__ void qkt16(S16& p, int kaddr, const bf16x8 (&qr)[6][2], const pg8::f32x4 (&negm)[2]) {
#pragma unroll
  for (int kb = 0; kb < 4; ++kb) { p.a[kb][0] = negm[0]; p.a[kb][1] = negm[1]; }
  bf16x8 ka0, ka1, kb0, kb1, kc0, kc1;
  K16READ(ka0, ka1, 0); K16READ(kb0, kb1, 1);
#define K16STEP(x0, x1, d) do { if ((d) + 2 < 12) { K16WAIT(4, x0, x1); } else if ((d) + 1 < 12) { K16WAIT(2, x0, x1); } else { K16WAIT(0, x0, x1); } \
    p.a[2 * ((d) & 1)][0] = MF16(x0, qr[(d) >> 1][0], p.a[2 * ((d) & 1)][0]); p.a[2 * ((d) & 1)][1] = MF16(x0, qr[(d) >> 1][1], p.a[2 * ((d) & 1)][1]); \
    p.a[2 * ((d) & 1) + 1][0] = MF16(x1, qr[(d) >> 1][0], p.a[2 * ((d) & 1) + 1][0]); p.a[2 * ((d) & 1) + 1][1] = MF16(x1, qr[(d) >> 1][1], p.a[2 * ((d) & 1) + 1][1]); } while (0)
#pragma unroll
  for (int d0 = 0; d0 < 12; d0 += 3) {
    K16READ(kc0, kc1, d0 + 2); K16STEP(ka0, ka1, d0);
    if (d0 + 3 < 12) K16READ(ka0, ka1, d0 + 3);
    K16STEP(kb0, kb1, d0 + 1);
    if (d0 + 4 < 12) K16READ(kb0, kb1, d0 + 4);
    K16STEP(kc0, kc1, d0 + 2);
  }
#undef K16STEP
}
#undef K16READ
#undef K16WAIT
__device__ __forceinline__ void sm16_pmax(const S16& p, float (&pm)[2]) {
#pragma unroll
  for (int qb = 0; qb < 2; ++qb) { float m = p.a[0][qb][0];
#pragma unroll
    for (int kb = 0; kb < 4; ++kb)
#pragma unroll
      for (int i = 0; i < 4; ++i) if (kb | i) m = fmaxf(m, p.a[kb][qb][i]);
    pm[qb] = m; }
}
__device__ __forceinline__ float rowmax4(float v) {
  auto a = __builtin_amdgcn_permlane16_swap(__float_as_uint(v), __float_as_uint(v), false, false); const float m = fmaxf(__uint_as_float(a[0]), __uint_as_float(a[1]));
  auto c = __builtin_amdgcn_permlane32_swap(__float_as_uint(m), __float_as_uint(m), false, false); return fmaxf(__uint_as_float(c[0]), __uint_as_float(c[1])); }
__device__ __forceinline__ float rowsum4(float v) {
  auto a = __builtin_amdgcn_permlane16_swap(__float_as_uint(v), __float_as_uint(v), false, false); const float m = __uint_as_float(a[0]) + __uint_as_float(a[1]);
  auto c = __builtin_amdgcn_permlane32_swap(__float_as_uint(m), __float_as_uint(m), false, false); return __uint_as_float(c[0]) + __uint_as_float(c[1]); }
__device__ __forceinline__ void sm16_grow(const float (&pm)[2], S16& p, float (&m_reg)[2], float (&alpha)[2], pg8::f32x4 (&negm)[2]) {
  alpha[0] = 1.f; alpha[1] = 1.f;
  if (__any((pm[0] > THRL) || (pm[1] > THRL))) {
#pragma unroll
    for (int qb = 0; qb < 2; ++qb) { const float r = rowmax4(pm[qb]); const float dl = (r > THRL) ? r : 0.f;
#pragma unroll
      for (int kb = 0; kb < 4; ++kb)
#pragma unroll
        for (int i = 0; i < 4; ++i) p.a[kb][qb][i] -= dl;
      m_reg[qb] += dl; alpha[qb] = __builtin_amdgcn_exp2f(-dl); const float nm = -m_reg[qb]; negm[qb] = (pg8::f32x4){nm, nm, nm, nm}; }
  }
}
template <int KB> __device__ __forceinline__ void sm16_exp(S16& p) {
#pragma unroll
  for (int qb = 0; qb < 2; ++qb)
#pragma unroll
    for (int i = 0; i < 4; ++i) p.a[KB][qb][i] = __builtin_amdgcn_exp2f(p.a[KB][qb][i]);
}
#define PIN16(p, KB) asm volatile("" : "+v"(p.a[KB][0]), "+v"(p.a[KB][1]))
__device__ __forceinline__ void finish16(S16& p, const float (&alpha)[2], float (&l_reg)[2], bf16x8 (&pa)[2][2]) {
  sm16_exp<2>(p); sm16_exp<3>(p);
#pragma unroll
  for (int qb = 0; qb < 2; ++qb) { float ps = 0;
#pragma unroll
    for (int kb = 0; kb < 4; ++kb)
#pragma unroll
      for (int i = 0; i < 4; ++i) ps += p.a[kb][qb][i];
    l_reg[qb] = l_reg[qb] * alpha[qb] + ps;
#pragma unroll
    for (int s = 0; s < 2; ++s) { const pg8::f32x4 lo = p.a[2 * s][qb], hi = p.a[2 * s + 1][qb];
      v4u w = {cvtpk(lo[0], lo[1]), cvtpk(lo[2], lo[3]), cvtpk(hi[0], hi[1]), cvtpk(hi[2], hi[3])}; pa[qb][s] = *reinterpret_cast<bf16x8*>(&w); } }
}
constexpr int v16_off(int s, int db, int hi) { return s * 8192 + hi * 4096 + db * 256; }
template <int DB> __device__ __forceinline__ void pv16_reads(s16x4 (&t)[4], int vb) {
  t[0] = tr_read<v16_off(0, DB, 0)>(vb); t[1] = tr_read<v16_off(0, DB, 1)>(vb); t[2] = tr_read<v16_off(1, DB, 0)>(vb); t[3] = tr_read<v16_off(1, DB, 1)>(vb);
}
template <int DB> __device__ __forceinline__ void pv16_mma(pg8::f32x4 (&o)[2][8], const s16x4 (&t)[4], const bf16x8 (&pa)[2][2]) {
#define PK(L, H) (bf16x8){L[0], L[1], L[2], L[3], H[0], H[1], H[2], H[3]}
  { const bf16x8 B = PK(t[0], t[1]); o[0][DB] = MF16(pa[0][0], B, o[0][DB]); o[1][DB] = MF16(pa[1][0], B, o[1][DB]); }
  { const bf16x8 B = PK(t[2], t[3]); o[0][DB] = MF16(pa[0][1], B, o[0][DB]); o[1][DB] = MF16(pa[1][1], B, o[1][DB]); }
#undef PK
}
__device__ __forceinline__ void pv16_sm(pg8::f32x4 (&o)[2][8], int vb, const bf16x8 (&pa)[2][2], S16& pX, float (&m_reg)[2], float (&alpha)[2], pg8::f32x4 (&negm)[2]) {
  s16x4 ta[4], tb[4]; float pm[2];
  pv16_reads<0>(ta, vb);
  pv16_reads<1>(tb, vb); PVW(4); pv16_mma<0>(o, ta, pa);
  pv16_reads<2>(ta, vb); PVW(4); pv16_mma<1>(o, tb, pa); sm16_pmax(pX, pm); asm volatile("" : "+v"(pm[0]), "+v"(pm[1]));
  pv16_reads<3>(tb, vb); PVW(4); pv16_mma<2>(o, ta, pa);
  pv16_reads<4>(ta, vb); PVW(4); pv16_mma<3>(o, tb, pa); sm16_grow(pm, pX, m_reg, alpha, negm); sm16_exp<0>(pX); PIN16(pX, 0);
  pv16_reads<5>(tb, vb); PVW(4); pv16_mma<4>(o, ta, pa);
  pv16_reads<6>(ta, vb); PVW(4); pv16_mma<5>(o, tb, pa); sm16_exp<1>(pX); PIN16(pX, 1);
  pv16_reads<7>(tb, vb); PVW(4); pv16_mma<6>(o, ta, pa);
  PVW(0); pv16_mma<7>(o, tb, pa);
}
__device__ __forceinline__ void pv16_d0(pg8::f32x4 (&o)[2][8], int vb, const bf16x8 (&pa)[2][2]) {
  s16x4 ta[4], tb[4];
  pv16_reads<0>(ta, vb);
  pv16_reads<1>(tb, vb); PVW(4); pv16_mma<0>(o, ta, pa);
  pv16_reads<2>(ta, vb); PVW(4); pv16_mma<1>(o, tb, pa);
  pv16_reads<3>(tb, vb); PVW(4); pv16_mma<2>(o, ta, pa);
  pv16_reads<4>(ta, vb); PVW(4); pv16_mma<3>(o, tb, pa);
  pv16_reads<5>(tb, vb); PVW(4); pv16_mma<4>(o, ta, pa);
  pv16_reads<6>(ta, vb); PVW(4); pv16_mma<5>(o, tb, pa);
  pv16_reads<7>(tb, vb); PVW(4); pv16_mma<6>(o, ta, pa);
  PVW(0); pv16_mma<7>(o, tb, pa);
}
__device__ __forceinline__ void sm16_sum(const S16& p, int qb, float alpha, float& l) { float ps = 0;
#pragma unroll
  for (int kb = 0; kb < 4; ++kb)
#pragma unroll
    for (int i = 0; i < 4; ++i) ps += p.a[kb][qb][i];
  l = l * alpha + ps; }
__device__ __forceinline__ void sm16_pack(const S16& p, bf16x8 (&pn)[2][2]) {
#pragma unroll
  for (int qb = 0; qb < 2; ++qb)
#pragma unroll
    for (int s = 0; s < 2; ++s) { const pg8::f32x4 lo = p.a[2 * s][qb], hi = p.a[2 * s + 1][qb];
      v4u w = {cvtpk(lo[0], lo[1]), cvtpk(lo[2], lo[3]), cvtpk(hi[0], hi[1]), cvtpk(hi[2], hi[3])}; pn[qb][s] = *reinterpret_cast<bf16x8*>(&w); }
}
__device__ __forceinline__ void pv16_smf(pg8::f32x4 (&o)[2][8], int vb, const bf16x8 (&pa)[2][2], S16& pX, float (&m_reg)[2], float (&alpha)[2], float (&l_reg)[2], pg8::f32x4 (&negm)[2], bf16x8 (&pn)[2][2]) {
  s16x4 ta[4], tb[4]; float pm[2];
  pv16_reads<0>(ta, vb);
  pv16_reads<1>(tb, vb); PVW(4); pv16_mma<0>(o, ta, pa); sm16_pmax(pX, pm); asm volatile("" : "+v"(pm[0]), "+v"(pm[1]));
  pv16_reads<2>(ta, vb); PVW(4); pv16_mma<1>(o, tb, pa); sm16_grow(pm, pX, m_reg, alpha, negm); sm16_exp<0>(pX); PIN16(pX, 0);
  pv16_reads<3>(tb, vb); PVW(4); pv16_mma<2>(o, ta, pa); sm16_exp<1>(pX); PIN16(pX, 1);
  pv16_reads<4>(ta, vb); PVW(4); pv16_mma<3>(o, tb, pa); sm16_exp<2>(pX); PIN16(pX, 2);
  pv16_reads<5>(tb, vb); PVW(4); pv16_mma<4>(o, ta, pa); sm16_exp<3>(pX); PIN16(pX, 3);
  pv16_reads<6>(ta, vb); PVW(4); pv16_mma<5>(o, tb, pa); sm16_sum(pX, 0, alpha[0], l_reg[0]); asm volatile("" : "+v"(l_reg[0]));
  pv16_reads<7>(tb, vb); PVW(4); pv16_mma<6>(o, ta, pa); sm16_sum(pX, 1, alpha[1], l_reg[1]); asm volatile("" : "+v"(l_reg[1]));
  PVW(0); pv16_mma<7>(o, tb, pa); sm16_pack(pX, pn);
}
#define K16R(a, b, ks, H) asm volatile("ds_read_b128 %0, %2 offset:%3\n\tds_read_b128 %1, %2 offset:%4" : "=&v"(a), "=&v"(b) : "v"(kaddr), "i"((ks) * 4096 + (H) * 2048), "i"((ks) * 4096 + (H) * 2048 + 1024))
#define K16W(n, a, b) asm volatile("s_waitcnt lgkmcnt(" #n ")" : "+v"(a), "+v"(b))
#define K16M(x0, x1, ks, H) do { p.a[2 * (H)][0] = MF16(x0, qr[ks][0], p.a[2 * (H)][0]); p.a[2 * (H)][1] = MF16(x0, qr[ks][1], p.a[2 * (H)][1]); \
    p.a[2 * (H) + 1][0] = MF16(x1, qr[ks][0], p.a[2 * (H) + 1][0]); p.a[2 * (H) + 1][1] = MF16(x1, qr[ks][1], p.a[2 * (H) + 1][1]); } while (0)
__device__ __forceinline__ float amax3(float a, float b, float c) { float r; asm("v_max3_f32 %0, %1, %2, %3" : "=v"(r) : "v"(a), "v"(b), "v"(c)); return r; }
__device__ __forceinline__ float amax2(float a, float b) { float r; asm("v_max_f32 %0, %1, %2" : "=v"(r) : "v"(a), "v"(b)); return r; }
template <int H> __device__ __forceinline__ void sm16_pmaxh(const S16& p, float (&pm)[2]) {
#pragma unroll
  for (int qb = 0; qb < 2; ++qb) { const pg8::f32x4 a = p.a[2 * H][qb], c = p.a[2 * H + 1][qb];
    float m = amax3(a[0], a[1], a[2]); m = amax3(m, a[3], c[0]); m = amax3(m, c[1], c[2]); pm[qb] = amax2(m, c[3]); }
}
__device__ __forceinline__ void sm16_grow_h0(const float (&pm)[2], S16& p, float (&m_reg)[2], float (&alpha)[2], pg8::f32x4 (&negm)[2]) {
  alpha[0] = 1.f; alpha[1] = 1.f;
  if (__any(amax2(pm[0], pm[1]) > THRL)) {
#pragma unroll
    for (int qb = 0; qb < 2; ++qb) { const float r = rowmax4(pm[qb]); const float dl = (r > THRL) ? r : 0.f;
#pragma unroll
      for (int kb = 0; kb < 4; ++kb)
#pragma unroll
        for (int i = 0; i < 4; ++i) p.a[kb][qb][i] -= dl;
      m_reg[qb] += dl; alpha[qb] = __builtin_amdgcn_exp2f(-dl); const float nm = -m_reg[qb]; negm[qb] = (pg8::f32x4){nm, nm, nm, nm}; }
  }
}
__device__ __forceinline__ void sm16_grow_h1(const float (&pm)[2], S16& p, float (&m_reg)[2], float (&alpha)[2], pg8::f32x4 (&negm)[2], float (&ps)[2]) {
  if (__any(amax2(pm[0], pm[1]) > THRL)) {
#pragma unroll
    for (int qb = 0; qb < 2; ++qb) { const float r = rowmax4(pm[qb]); const float dl = (r > THRL) ? r : 0.f; const float a2 = __builtin_amdgcn_exp2f(-dl);
#pragma unroll
      for (int i = 0; i < 4; ++i) { p.a[2][qb][i] -= dl; p.a[3][qb][i] -= dl; p.a[0][qb][i] *= a2; p.a[1][qb][i] *= a2; }
      ps[qb] *= a2; m_reg[qb] += dl; alpha[qb] *= a2; const float nm = -m_reg[qb]; negm[qb] = (pg8::f32x4){nm, nm, nm, nm}; }
  }
}
template <int H> __device__ __forceinline__ void sm16_sumh(const S16& p, float (&ps)[2]) {
#pragma unroll
  for (int qb = 0; qb < 2; ++qb)
#pragma unroll
    for (int kb = 2 * H; kb < 2 * H + 2; ++kb)
#pragma unroll
      for (int i = 0; i < 4; ++i) ps[qb] += p.a[kb][qb][i];
}
__device__ __forceinline__ void qkt16_sm(S16& p, int kaddr, const bf16x8 (&qr)[6][2], float (&m_reg)[2], float (&alpha)[2], pg8::f32x4 (&negm)[2], float (&ps)[2]) {
#pragma unroll
  for (int kb = 0; kb < 4; ++kb) { p.a[kb][0] = negm[0]; p.a[kb][1] = negm[1]; }
  bf16x8 ka0, ka1, kb0, kb1, kc0, kc1; float pm[2];
  K16R(ka0, ka1, 0, 0); K16R(kb0, kb1, 1, 0);
  K16R(kc0, kc1, 2, 0); K16W(4, ka0, ka1); K16M(ka0, ka1, 0, 0);
  K16R(ka0, ka1, 3, 0); K16W(4, kb0, kb1); K16M(kb0, kb1, 1, 0);
  K16R(kb0, kb1, 4, 0); K16W(4, kc0, kc1); K16M(kc0, kc1, 2, 0);
  K16R(kc0, kc1, 5, 0); K16W(4, ka0, ka1); K16M(ka0, ka1, 3, 0);
  K16R(ka0, ka1, 0, 1); K16W(4, kb0, kb1); K16M(kb0, kb1, 4, 0);
  K16R(kb0, kb1, 1, 1); K16W(4, kc0, kc1); K16M(kc0, kc1, 5, 0);
  K16R(kc0, kc1, 2, 1); K16W(4, ka0, ka1); K16M(ka0, ka1, 0, 1);
  K16R(ka0, ka1, 3, 1); K16W(4, kb0, kb1); K16M(kb0, kb1, 1, 1); sm16_pmaxh<0>(p, pm); asm volatile("" : "+v"(pm[0]), "+v"(pm[1]));
  K16R(kb0, kb1, 4, 1); K16W(4, kc0, kc1); K16M(kc0, kc1, 2, 1); sm16_grow_h0(pm, p, m_reg, alpha, negm); sm16_exp<0>(p); PIN16(p, 0);
  K16R(kc0, kc1, 5, 1); K16W(4, ka0, ka1); K16M(ka0, ka1, 3, 1); sm16_exp<1>(p); PIN16(p, 1);
  K16W(2, kb0, kb1); K16M(kb0, kb1, 4, 1); ps[0] = 0.f; ps[1] = 0.f; sm16_sumh<0>(p, ps); asm volatile("" : "+v"(ps[0]), "+v"(ps[1]));
  K16W(0, kc0, kc1); K16M(kc0, kc1, 5, 1);
}
#undef K16R
#undef K16W
#undef K16M
__device__ __forceinline__ void pv16_smh(pg8::f32x4 (&o)[2][8], int vb, const bf16x8 (&pa)[2][2], S16& pX, float (&m_reg)[2], float (&alpha)[2], float (&l_reg)[2], pg8::f32x4 (&negm)[2], float (&ps)[2], bf16x8 (&pn)[2][2]) {
  s16x4 ta[4], tb[4]; float pm[2];
  pv16_reads<0>(ta, vb);
  pv16_reads<1>(tb, vb); PVW(4); pv16_mma<0>(o, ta, pa); sm16_pmaxh<1>(pX, pm); asm volatile("" : "+v"(pm[0]), "+v"(pm[1]));
  pv16_reads<2>(ta, vb); PVW(4); pv16_mma<1>(o, tb, pa); sm16_grow_h1(pm, pX, m_reg, alpha, negm, ps); sm16_exp<2>(pX); PIN16(pX, 2);
  pv16_reads<3>(tb, vb); PVW(4); pv16_mma<2>(o, ta, pa); sm16_exp<3>(pX); PIN16(pX, 3);
  pv16_reads<4>(ta, vb); PVW(4); pv16_mma<3>(o, tb, pa); sm16_sumh<1>(pX, ps); l_reg[0] = l_reg[0] * alpha[0] + ps[0]; l_reg[1] = l_reg[1] * alpha[1] + ps[1]; asm volatile("" : "+v"(l_reg[0]), "+v"(l_reg[1]));
  pv16_reads<5>(tb, vb); PVW(4); pv16_mma<4>(o, ta, pa);
  pv16_reads<6>(ta, vb); PVW(4); pv16_mma<5>(o, tb, pa); sm16_pack(pX, pn); asm volatile("" : "+v"(pn[0][0]), "+v"(pn[0][1]), "+v"(pn[1][0]), "+v"(pn[1][1]));
  pv16_reads<7>(tb, vb); PVW(4); pv16_mma<6>(o, ta, pa);
  PVW(0); pv16_mma<7>(o, tb, pa);
}
__device__ __forceinline__ void attn_unit16(const bf16* __restrict__ Qb, const bf16* __restrict__ KNh, const bf16* __restrict__ KPE, const bf16* __restrict__ Vh, bf16* __restrict__ Ob, int b, LAS char* lds) {
  int tid_l = threadIdx.x; asm volatile("" : "+v"(tid_l));
  const int tid = tid_l, wid = __builtin_amdgcn_readfirstlane(tid >> 6), lane = tid & 63, i16 = lane & 15, g = lane >> 4;
  LAS float* wsf = (LAS float*)(lds + DOFF_WS) + wid * 64; LAS float* li_l = wsf; LAS float* al_l = wsf + 32;
  LAS char* ost = lds + wid * 8192;
  float m_reg[2] = {-1e30f, -1e30f}, l_reg[2] = {0.f, 0.f}; pg8::f32x4 o[2][8]; bf16x8 qr[6][2];
#pragma unroll
  for (int qb = 0; qb < 2; ++qb)
#pragma unroll
    for (int db = 0; db < 8; ++db) o[qb][db] = (pg8::f32x4){0.f, 0.f, 0.f, 0.f};
#pragma unroll
  for (int ks = 0; ks < 6; ++ks)
#pragma unroll
    for (int qb = 0; qb < 2; ++qb) qr[ks][qb] = *reinterpret_cast<const bf16x8*>(Qb + (size_t)(wid * 32 + 16 * qb + i16) * 3072 + 32 * ks + 8 * g);
  unsigned ovs, okn, okp;
  { const int key = 8 * (wid >> 1) + ((lane & 15) >> 1), col = 16 * (4 * (wid & 1) + (lane >> 4)) + 8 * (lane & 1);
    ovs = (unsigned)(key * D + col) * 2u;
    const int kin = lane >> 2, kk = 16 * (wid & 3) + kin, gg = (lane & 3) ^ (2 * ((kin >> 3) & 1));
    okn = (unsigned)(kk * D + 32 * (wid >> 2) + 8 * gg) * 2u; okp = (unsigned)(kk * 64 + 32 * (wid >> 2) + 8 * gg) * 2u; }
  const int krd0 = i16 * 64 + ((g ^ (2 * ((i16 >> 3) & 1))) * 16) + DOFF_K;
  const int vrd0 = (int)(unsigned)(uintptr_t)lds + (g >> 1) * 2048 + (4 * (g & 1) + (i16 >> 2)) * 32 + (i16 & 3) * 8;
#define DMA_TILE(j, boff) do { const unsigned rb_ = (unsigned)krow((j), b), rv_ = rb_ * (unsigned)(D * 2), rp_ = rb_ * 128u; LAS char* d_ = lds + (boff) + wid * 1024; \
    __builtin_amdgcn_global_load_lds((const unsigned*)(reinterpret_cast<const char*>(Vh) + (size_t)(rv_ + ovs)), (LAS unsigned*)d_, 16, 0, 0); \
    __builtin_amdgcn_global_load_lds((const unsigned*)(reinterpret_cast<const char*>(Vh) + (size_t)(rv_ + ovs + 32u * D * 2u)), (LAS unsigned*)(d_ + 8192), 16, 0, 0); \
    __builtin_amdgcn_global_load_lds((const unsigned*)(reinterpret_cast<const char*>(KNh) + (size_t)(rv_ + okn)), (LAS unsigned*)(d_ + DOFF_K), 16, 0, 0); \
    __builtin_amdgcn_global_load_lds((const unsigned*)(reinterpret_cast<const char*>(KNh) + (size_t)(rv_ + okn + 128u)), (LAS unsigned*)(d_ + DOFF_K + 8192), 16, 0, 0); \
    __builtin_amdgcn_global_load_lds((const unsigned*)(reinterpret_cast<const char*>(KPE) + (size_t)(rp_ + okp)), (LAS unsigned*)(d_ + DOFF_K + 16384), 16, 0, 0); } while (0)
#define QKT(x) qkt16(x, (int)(unsigned)(uintptr_t)lds + o_cur + krd0, qr, negm)
#define TILE_BAR() do { asm volatile("s_waitcnt vmcnt(0) lgkmcnt(0)" ::: "memory"); __builtin_amdgcn_s_barrier(); asm volatile("" ::: "memory"); } while (0)
#define RESC(a) do { if (__any((a[0] < 1.f) || (a[1] < 1.f))) { if (g == 0) { al_l[i16] = a[0]; al_l[16 + i16] = a[1]; } asm volatile("s_waitcnt lgkmcnt(0)" ::: "memory"); \
    _Pragma("unroll") for (int qb = 0; qb < 2; ++qb) { const pg8::f32x4 av = *(const LAS pg8::f32x4*)(al_l + 16 * qb + 4 * g); \
      _Pragma("unroll") for (int db = 0; db < 8; ++db) o[qb][db] *= av; } } } while (0)
#define ROT() do { const int t_ = o_prev; o_prev = o_cur; o_cur = o_next; o_next = t_; } while (0)
  S16 p; float al[2]; bf16x8 paA[2][2], paB[2][2];
  int o_prev = 2 * DBUF, o_cur = 0, o_next = DBUF;
  DMA_TILE(0, 0); DMA_TILE(1, DBUF);
  asm volatile("s_waitcnt vmcnt(5) lgkmcnt(0)" ::: "memory"); __builtin_amdgcn_s_barrier(); asm volatile("" ::: "memory");
  pg8::f32x4 negm[2] = {{0.f, 0.f, 0.f, 0.f}, {0.f, 0.f, 0.f, 0.f}};
  QKT(p);
  { float pm[2]; sm16_pmax(p, pm); al[0] = 1.f; al[1] = 1.f;
#pragma unroll
    for (int qb = 0; qb < 2; ++qb) { const float r = rowmax4(pm[qb]); m_reg[qb] = r; negm[qb] = (pg8::f32x4){-r, -r, -r, -r};
#pragma unroll
      for (int kb = 0; kb < 4; ++kb)
#pragma unroll
        for (int i = 0; i < 4; ++i) p.a[kb][qb][i] -= r; }
    sm16_exp<0>(p); sm16_exp<1>(p); sm16_exp<2>(p); sm16_exp<3>(p);
    sm16_sum(p, 0, 1.f, l_reg[0]); sm16_sum(p, 1, 1.f, l_reg[1]); sm16_pack(p, paA); }
  TILE_BAR(); DMA_TILE(2, 2 * DBUF); ROT();
  float ps[2];
#define QKTS() qkt16_sm(p, (int)(unsigned)(uintptr_t)lds + o_cur + krd0, qr, m_reg, al, negm, ps)
  for (int j = 1; j + 1 < NT; j += 2) {
    SBAR(); QKTS(); SBAR();
    pv16_smh(o, vrd0 + o_prev, paA, p, m_reg, al, l_reg, negm, ps, paB);
    TILE_BAR(); if (j + 2 < NT) DMA_TILE(j + 2, o_prev); ROT();
    RESC(al);
    SBAR(); QKTS(); SBAR();
    pv16_smh(o, vrd0 + o_prev, paB, p, m_reg, al, l_reg, negm, ps, paA);
    TILE_BAR(); if (j + 3 < NT) DMA_TILE(j + 3, o_prev); ROT();
    RESC(al);
  }
  SBAR(); QKTS(); SBAR();
  pv16_smh(o, vrd0 + o_prev, paA, p, m_reg, al, l_reg, negm, ps, paB);
  RESC(al);
#undef QKTS
  pv16_d0(o, vrd0 + o_cur, paB);
  TILE_BAR();
  { const float l0 = rowsum4(l_reg[0]), l1 = rowsum4(l_reg[1]); if (g == 0) { li_l[i16] = l0; li_l[16 + i16] = l1; } }
  asm volatile("s_waitcnt lgkmcnt(0)" ::: "memory");
#pragma unroll
  for (int qb = 0; qb < 2; ++qb) { const pg8::f32x4 lv = *(const LAS pg8::f32x4*)(li_l + 16 * qb + 4 * g);
#pragma unroll
    for (int i = 0; i < 4; ++i) { const float rl = __builtin_amdgcn_rcpf(lv[i]); const int orow = 16 * qb + 4 * g + i;
#pragma unroll
      for (int db = 0; db < 8; ++db) *(LAS unsigned short*)(ost + orow * 256 + (db * 16 + i16) * 2) = (unsigned short)f2bf(o[qb][db][i] * rl); } }
  asm volatile("s_waitcnt lgkmcnt(0)" ::: "memory");
#pragma unroll
  for (int i = 0; i < 8; ++i) { const int gidx = i * 64 + lane, row = gidx >> 4, cg = gidx & 15;
    const v4u v = *(const LAS v4u*)(ost + row * 256 + cg * 16);
    *(GAS v4u*)(Ob + (size_t)(wid * 32 + row) * D + cg * 8) = v; }
  TILE_BAR();
#undef DMA_TILE
#undef QKT
#undef TILE_BAR
#undef RESC
#undef ROT
}
#undef MF16
#undef PIN16
#undef SBAR
}

#ifndef MK_SPLIT
#define MK_SPLIT 0
#endif
#if MK_SPLIT
#define GRID_BAR() do { } while (0)
#else
#define GRID_BAR() xcd_barrier(bar)
#endif
#define IN(k) (lo <= (k) && (k) < hi)
#ifndef ATTN_MAIN
#define ATTN_MAIN attn_unit16
#endif
#ifndef ATTN_FN
#define ATTN_FN attn_unit_pp
#endif
#ifndef GU_WGM
#define GU_WGM 8
#endif
#ifndef DN_WGM
#define DN_WGM 4
#endif
#ifndef PROBE_PH
#define PROBE_PH (-1)
#define PROBE_N 1
#endif
#define REPEAT(k) _Pragma("unroll") for (int rep_ = 0; rep_ < ((k) == PROBE_PH ? PROBE_N : 1); ++rep_)
#define SEAM(k) do { if (IN(k) && IN((k) + 1)) GRID_BAR(); } while (0)
template <int l> __device__ __forceinline__ void layer_body(Frame& F, const Args& args, const int lo, const int hi, const XcdBarrier& bar) {
    unsigned char* ws = args.ws;
    float* X = args.out;
    float* Yc = (float*)(ws + WS_Y) - (size_t)M_LAT * D;
    float* PARTc = (float*)(ws + WS_F) - (size_t)M_LAT * D;
    const float* XinC = args.in[2] - (size_t)M_LAT * D;
    bf16* XN = (bf16*)args.out;
    bf16* XB = (bf16*)(ws + WS_XB);
    bf16* Hb = (bf16*)(ws + WS_BIG);
    const float* MOD = (const float*)(ws + WS_MOD);
    const float* ROPEt = (const float*)(ws + WS_ROPE);
    (void)XinC; (void)ROPEt;
        const int pb = l == 0 ? 2 : 12;
        const float* modl = MOD + (size_t)l * 3 * NMODV;
        const float* ng = args.in[6] + (size_t)l * 3 * D;
        if (IN(pb + 0)) { REPEAT(pb + 0) { if constexpr (l == 0) ph_norm<true>(F, args.in[0], XinC, M_ALL, ng, modl, 0, XN); else ph_norm<false, CTX_P>(F, XB, Yc, M_ALL, ng, modl, 0, XN, PARTc, Yc); } } SEAM(pb + 0);
#if defined(DRY_GU)
        if (l == 0 && IN(pb + 1)) { for (int rr = 0; rr < DRY_GU; ++rr) { pg8::Gemm g{XN, (const bf16*)(ws + WS_WGU), M_ALL, NGU, D, D}; pg8::StaticOrder S; S.init(M_ALL, NGU, F.G, (int)blockIdx.x, GU_WGM);
            EpiNull E; pg8::gemm_phase<EpiNull, pg8::StaticOrder, true, true>(F.lds + RING_OFF, g, S, E); __syncthreads(); } }
#endif
        if (IN(pb + 1)) REPEAT(pb + 1) {
            pg8::Gemm g{XN, (const bf16*)(ws + WS_WGU + (size_t)(l * 2) * SZ_WGU), M_ALL, NGU, D, D}; pg8::StaticOrder S; S.init(M_LAT, NGU, F.G, (int)blockIdx.x, GU_WGM);
            EpiSwiGLU E{Hb};
            pg8::gemm_phase<EpiSwiGLU, pg8::StaticOrder, true, true>(F.lds + RING_OFF, g, S, E);
            __syncthreads();
            ClaimOrder C{NGU / 256, 1, 0, (unsigned*)(ws + 944 * 1024 + 256 + l * 64), (volatile LAS unsigned*)(F.lds + MISC_OFF) + 40};
            pg8::gemm_phase<EpiSwiGLU, ClaimOrder, true, true>(F.lds + RING_OFF, g, C, E);
        } SEAM(pb + 1);
#if defined(DRY_DN)
        if (l == 0 && IN(pb + 2)) { for (int rr = 0; rr < DRY_DN; ++rr) { pg8::Gemm g{Hb, (const bf16*)(ws + WS_WD), M_LAT, D, FF, FF}; pg8::StaticOrder S; S.init(M_LAT, D, F.G, (int)blockIdx.x, DN_WGM);
            EpiNull E; pg8::gemm_phase<EpiNull, pg8::StaticOrder, true, true>(F.lds + RING_OFF, g, S, E); __syncthreads(); } }
#endif
        if (IN(pb + 2)) REPEAT(pb + 2) {
#ifdef CTX_CHECK
            if constexpr (l == 0) {
                const float* Ysrc = (const float*)(ws + WS_Y); float* Y2 = (float*)(ws + WS_F + 64 * MiB);
                for (size_t i = (size_t)blockIdx.x * 512 + threadIdx.x; i < (size_t)M_CTX * D; i += (size_t)F.G * 512) Y2[i] = Ysrc[i];
            }
#endif
            {   pg8::Gemm g{Hb, (const bf16*)(ws + WS_WD + (size_t)(l * 2) * SZ_WD), M_LAT, D, FF, FF}; pg8::StaticOrder S; S.init(M_LAT, D, F.G, (int)blockIdx.x, DN_WGM);
                if constexpr (l == 0) { EpiResidF32 E{args.in[0], XB, modl + 2 * D, 0.5f}; pg8::gemm_phase<EpiResidF32, pg8::StaticOrder, true, true>(F.lds + RING_OFF, g, S, E); }
                else { EpiResid E{XB, XB, modl + 2 * D, 0.5f}; pg8::gemm_phase<EpiResid, pg8::StaticOrder, true, true>(F.lds + RING_OFF, g, S, E); } }
            __syncthreads();
            {   pg8::Gemm g{Hb, (const bf16*)(ws + WS_WD + (size_t)(l * 2) * SZ_WD), M_CTX, D, FF / CTX_P, FF}; ClaimOrder S{D / 256, CTX_P, (FF / CTX_P) * 2, (unsigned*)(ws + 944 * 1024 + l * 64), (volatile LAS unsigned*)(F.lds + MISC_OFF) + 40};
                EpiPartial E{PARTc, modl + 2 * D, 0.5f, (FF / CTX_P) * 2};
                pg8::gemm_phase<EpiPartial, ClaimOrder, true, true>(F.lds + RING_OFF, g, S, E); }
#ifdef CTX_CHECK
            if constexpr (l == 0) {
                __syncthreads();
                pg8::Gemm g{Hb, (const bf16*)(ws + WS_WD + (size_t)(l * 2) * SZ_WD), M_CTX, D, FF, FF}; SplitKOrder S{D / 256, 1, 0, F.G, (int)blockIdx.x};
                EpiResidAtomic E{(float*)(ws + WS_F + 64 * MiB) - (size_t)M_LAT * D, modl + 2 * D, 0.5f};
                pg8::gemm_phase<EpiResidAtomic, SplitKOrder, true, true>(F.lds + RING_OFF, g, S, E);
            }
#endif
        } SEAM(pb + 2);
        if (IN(pb + 3)) { ph_norm<false, CTX_P>(F, XB, Yc, M_ALL, ng + D, modl, 1, XN, PARTc, Yc); } SEAM(pb + 3);
#ifdef CTX_CHECK
        if constexpr (l == 0) {
            const float* Ysrc = (const float*)(ws + WS_Y); const float* Y2 = (const float*)(ws + WS_F + 64 * MiB); float md = 0.f, mv = 0.f;
            for (size_t i = (size_t)blockIdx.x * 512 + threadIdx.x; i < (size_t)M_CTX * D; i += (size_t)F.G * 512) {
                const float a = __builtin_nontemporal_load(Ysrc + i), c = __builtin_nontemporal_load(Y2 + i); md = fmaxf(md, fabsf(a - c) / (fabsf(a) + 1.0f)); mv = fmaxf(mv, fabsf(a - args.in[2][i])); }
            atomicMax((unsigned*)(ws + 940 * 1024), __float_as_uint(md)); atomicMax((unsigned*)(ws + 940 * 1024 + 4), __float_as_uint(mv));
        }
#endif
        int pn2;
        if constexpr (l == 0) {
            bf16* Ub = (bf16*)(ws + WS_U); bf16* Vb = (bf16*)(ws + WS_V); float* stats = (float*)(ws + WS_STATS);
            if (IN(6)) {
                pg8::Gemm g{XN, (const bf16*)(ws + WS_GMIN), M_ALL, 4096, D, D}; pg8::StaticOrder S; S.init(M_LAT, 4096, F.G, (int)blockIdx.x);
                EpiGeluUV E{Ub, Vb, stats};
                pg8::gemm_phase<EpiGeluUV, pg8::StaticOrder, true, true>(F.lds + RING_OFF, g, S, E);
                __syncthreads();
                ClaimOrder C{4096 / 256, 1, 0, (unsigned*)(ws + 944 * 1024 + 448), (volatile LAS unsigned*)(F.lds + MISC_OFF) + 40};
                pg8::gemm_phase<EpiGeluUV, ClaimOrder, true, true>(F.lds + RING_OFF, g, C, E);
            } SEAM(6);
            if (IN(7)) { REPEAT(7) { ph_gm_mix(F, Ub, Vb, stats, args.in[11], args.in[12], args.in[13], args.in[14], (PROBE_PH == 7 && rep_ + 1 < PROBE_N) ? (bf16*)(ws + WS_VV) : nullptr); } } SEAM(7);
            if (IN(8)) {
                {   pg8::Gemm g{Ub, (const bf16*)(ws + WS_GMOUT), M_LAT, D, D, D}; pg8::StaticOrder S; S.init(M_LAT, D, F.G, (int)blockIdx.x);
                    EpiResid E{XB, XB, modl + 5 * D, 1.0f};
                    pg8::gemm_phase<EpiResid, pg8::StaticOrder, true, true>(F.lds + RING_OFF, g, S, E); }
                __syncthreads();
                {   pg8::Gemm g{Ub, (const bf16*)(ws + WS_GMOUT), M_CTX, D, D / 4, D}; SplitKOrder S{D / 256, 4, (D / 4) * 2, F.G, (int)blockIdx.x};
                    EpiResidAtomic E{Yc, modl + 5 * D, 1.0f};
                    pg8::gemm_phase<EpiResidAtomic, SplitKOrder, true, true>(F.lds + RING_OFF, g, S, E); }
            } SEAM(8);
            pn2 = 9;
        } else {
            float* Fm = (float*)(ws + WS_F); bf16* CQ = (bf16*)(ws + WS_CQ); bf16* CKV = (bf16*)(ws + WS_CKV); bf16* KPE = (bf16*)(ws + WS_KPE);
            bf16* Qb = (bf16*)(ws + WS_Q); bf16* KN = (bf16*)(ws + WS_KN); bf16* VV = (bf16*)(ws + WS_VV); bf16* Ob = XN;
            if (IN(16)) {
                pg8::Gemm g{XN, (const bf16*)(ws + WS_WDQKV), M_ALL, NDQKV, D, D}; pg8::StaticOrder S; S.init(M_ALL, NDQKV, F.G, (int)blockIdx.x);
                EpiF32 E{Fm, NDQKV};
                pg8::gemm_phase<EpiF32, pg8::StaticOrder, true, true>(F.lds + RING_OFF, g, S, E);
            } SEAM(16);
            if (IN(17)) { ph_mla_norm(F, Fm, args.in[17], args.in[20], ROPEt, CQ, CKV, KPE); } SEAM(17);
            if (IN(18)) REPEAT(18) {
                {   pg8::Gemm g{CQ, (const bf16*)(ws + WS_WUQ), M_LAT, 3072, KQ, KQ}; pg8::StaticOrder S; S.init(M_LAT, 3072, F.G, (int)blockIdx.x);
                    EpiQRope E{Qb, ROPEt};
                    pg8::gemm_phase<EpiQRope, pg8::StaticOrder, true, true>(F.lds + RING_OFF, g, S, E); }
                __syncthreads();
                {   pg8::Gemm g{CKV, (const bf16*)(ws + WS_WUKV), M_ALL, 4096, KKV, KKV}; pg8::StaticOrder S; S.init(M_ALL, 4096, F.G, (int)blockIdx.x);
                    EpiKV E{KN, VV};
                    pg8::gemm_phase<EpiKV, pg8::StaticOrder, true, true>(F.lds + RING_OFF, g, S, E); }
            } SEAM(18);
            if (IN(19)) REPEAT(19) {
#ifdef CLK_PROBE
                const unsigned long long ct0_ = __builtin_amdgcn_s_memtime(), cr0_ = __builtin_amdgcn_s_memrealtime();
#endif
                __syncthreads();
                for (int L = F.vcu; L < NB * NHEAD * (SEQ / 256); L += F.G) {
                    const int qb = L & 63, bh = L >> 6, b = bh >> 4, h = bh & 15;
#ifdef ATT_ABL
                    if (PROBE_PH == 19 && rep_ + 1 < PROBE_N) att::attn_unit_dma<ATT_ABL>(Qb + (size_t)(b * SEQ + qb * 256) * 3072 + h * DQK, KN + h * DVH, KPE, VV + h * DVH, Ob + (size_t)(b * SEQ + qb * 256) * D + h * DVH, b, (LAS char*)F.lds);
                    else
#endif
                    att::ATTN_MAIN(Qb + (size_t)(b * SEQ + qb * 256) * 3072 + h * DQK, KN + h * DVH, KPE, VV + h * DVH, Ob + (size_t)(b * SEQ + qb * 256) * D + h * DVH, b, (LAS char*)F.lds);
                }
                __syncthreads();
#ifdef CLK_PROBE
                if (blockIdx.x == CLK_PROBE && threadIdx.x == 0) { const unsigned long long dt_ = __builtin_amdgcn_s_memtime() - ct0_, dr_ = __builtin_amdgcn_s_memrealtime() - cr0_;
                    const int q_ = (int)((dt_ + dr_ / 2) / dr_); __hip_atomic_store((int*)(args.ws + 950 * 1024), (dt_ * 10 >= dr_ * 190) ? 20000 : 10000, __ATOMIC_RELAXED, __HIP_MEMORY_SCOPE_AGENT); }
#endif
            } SEAM(19);
            if (IN(20)) {
                pg8::Gemm g{Ob, (const bf16*)(ws + WS_WO), M_LAT, D, D, D}; pg8::StaticOrder S; S.init(M_LAT, D, F.G, (int)blockIdx.x);
                EpiResid E{XB, XB, modl + 5 * D, 1.0f};
                pg8::gemm_phase<EpiResid, pg8::StaticOrder, true, true>(F.lds + RING_OFF, g, S, E);
            } SEAM(20);
            pn2 = 21;
        }
        const int M2 = l == 0 ? M_ALL : M_LAT;
        if (IN(pn2)) { ph_norm<false>(F, XB, Yc, M2, ng + 2 * D, modl, 2, XN); } SEAM(pn2);
        if (IN(pn2 + 1)) {
            pg8::Gemm g{XN, (const bf16*)(ws + WS_WGU + (size_t)(l * 2 + 1) * SZ_WGU), M2, NGU, D, D}; pg8::StaticOrder S; S.init(M_LAT, NGU, F.G, (int)blockIdx.x, GU_WGM);
            EpiSwiGLU E{Hb};
            pg8::gemm_phase<EpiSwiGLU, pg8::StaticOrder, true, true>(F.lds + RING_OFF, g, S, E);
            if constexpr (l == 0) {
                __syncthreads();
                ClaimOrder C{NGU / 256, 1, 0, (unsigned*)(ws + 944 * 1024 + 384), (volatile LAS unsigned*)(F.lds + MISC_OFF) + 40};
                pg8::gemm_phase<EpiSwiGLU, ClaimOrder, true, true>(F.lds + RING_OFF, g, C, E);
            }
        } SEAM(pn2 + 1);
        if (IN(pn2 + 2)) {
            {   pg8::Gemm g{Hb, (const bf16*)(ws + WS_WD + (size_t)(l * 2 + 1) * SZ_WD), M_LAT, D, FF, FF}; pg8::StaticOrder S; S.init(M_LAT, D, F.G, (int)blockIdx.x, DN_WGM);
                EpiResid E{XB, XB, modl + 8 * D, 0.5f};
                pg8::gemm_phase<EpiResid, pg8::StaticOrder, true, true>(F.lds + RING_OFF, g, S, E); }
            if constexpr (l == 0) {
                __syncthreads();
                pg8::Gemm g{Hb, (const bf16*)(ws + WS_WD + (size_t)(l * 2 + 1) * SZ_WD), M_CTX, D, FF / CTX_P, FF}; ClaimOrder S{D / 256, CTX_P, (FF / CTX_P) * 2, (unsigned*)(ws + 944 * 1024 + 128), (volatile LAS unsigned*)(F.lds + MISC_OFF) + 40};
                EpiPartial E{PARTc, modl + 8 * D, 0.5f, (FF / CTX_P) * 2};
                pg8::gemm_phase<EpiPartial, ClaimOrder, true, true>(F.lds + RING_OFF, g, S, E);
            }
        } SEAM(pn2 + 2);
    }

__global__ void __launch_bounds__(NWAVES * 64, 2) mk_fwd(Args args) {
    extern __shared__ __attribute__((aligned(16))) unsigned char lds[];
    Frame F;
    F.lds = (LAS unsigned char*)lds;
    F.wave = __builtin_amdgcn_readfirstlane((int)threadIdx.x >> 6);
    F.G = gridDim.x; { const int bx = blockIdx.x; F.vcu = (F.G % 8 == 0) ? (bx % 8) * (F.G / 8) + bx / 8 : bx; }
    unsigned char* ws = args.ws;
    F.ctl = (gu32*)(ws + WS_CTL);
    volatile LAS unsigned* MISC = (volatile LAS unsigned*)(F.lds + MISC_OFF);
    for (int u = threadIdx.x; u < (LDS_BYTES - MISC_OFF) / 4; u += NWAVES * 64) ((LAS unsigned*)(F.lds + MISC_OFF))[u] = 0u;
    __syncthreads();
#if MK_SPLIT
    XcdBarrier bar; bar.bar = (unsigned*)(F.ctl + CW_BAR); bar.x = 0; bar.st = nullptr;
#else
    XcdBarrier bar = xcd_barrier_post((unsigned*)(F.ctl + CW_BAR), MISC + 8);
#endif
    const int lo = args.ph_lo, hi = args.ph_hi;

    float* X = args.out;
    float* Yc = (float*)(ws + WS_Y) - (size_t)M_LAT * D;
    const float* XinC = args.in[2] - (size_t)M_LAT * D;
    bf16* XN = (bf16*)args.out;
    bf16* XB = (bf16*)(ws + WS_XB);
    bf16* Hb = (bf16*)(ws + WS_BIG);
    const float* MOD = (const float*)(ws + WS_MOD);
    const float* ROPEt = (const float*)(ws + WS_ROPE);

#ifdef CLK_PROBE0
    const unsigned long long ct00_ = __builtin_amdgcn_s_memtime(), cr00_ = __builtin_amdgcn_s_memrealtime();
#endif
    if (IN(0)) { REPEAT(0) { ph_prologue(F, args); __syncthreads(); } }
#ifdef CLK_PROBE0
    if (blockIdx.x == CLK_PROBE && threadIdx.x == 0) { const unsigned long long dt_ = __builtin_amdgcn_s_memtime() - ct00_, dr_ = __builtin_amdgcn_s_memrealtime() - cr00_;
        __hip_atomic_store((int*)(args.ws + 950 * 1024 + 64), (dt_ * 10 >= dr_ * CLK_PROBE0) ? 20000 : 10000, __ATOMIC_RELAXED, __HIP_MEMORY_SCOPE_AGENT); }
#endif
    SEAM(0);
    if (IN(1)) { ph_modreduce(F, args); } SEAM(1);

    layer_body<0>(F, args, lo, hi, bar);
    layer_body<1>(F, args, lo, hi, bar);
    if (IN(24)) { ph_final(F, (const bf16*)(ws + WS_XB), args.out, args.in[23]); }
#ifdef CTX_CHECK
    GRID_BAR();
    if (blockIdx.x == 0 && threadIdx.x == 0) {
        const float md = __uint_as_float(__hip_atomic_load((unsigned*)(args.ws + 940 * 1024), __ATOMIC_RELAXED, __HIP_MEMORY_SCOPE_AGENT));
        const float mv = __uint_as_float(__hip_atomic_load((unsigned*)(args.ws + 940 * 1024 + 4), __ATOMIC_RELAXED, __HIP_MEMORY_SCOPE_AGENT));
        args.out[7] = (md < 1e-3f) ? ((mv > 1e-2f) ? 1000.0f : 5000.0f) : 9000.0f; }
#endif
#ifdef CLK_PROBE
    GRID_BAR();
    if (blockIdx.x == 0 && threadIdx.x == 0) {
#ifdef CLK_PROBE0
        const int v = __hip_atomic_load((int*)(args.ws + 950 * 1024 + 64), __ATOMIC_RELAXED, __HIP_MEMORY_SCOPE_AGENT);
#else
        const int v = __hip_atomic_load((int*)(args.ws + 950 * 1024), __ATOMIC_RELAXED, __HIP_MEMORY_SCOPE_AGENT);
#endif
        args.out[7] = (float)v; }
#endif
#undef IN
#undef SEAM
#undef GRID_BAR
}

extern "C" void kernel_launch(void* const* d_in, const int* in_sizes, int n_in, void* d_out, int out_size, void* d_ws, size_t ws_size, hipStream_t stream) {
    static int grid = 0;
    if (grid == 0) {
        if (n_in != 24 || in_sizes[0] != M_LAT * D || out_size != M_LAT * D || ws_size < WS_END) {
            fprintf(stderr, "kernel_launch: shape mismatch: n_in %d in0 %d out %d ws %zu (need %zu)\n", n_in, n_in > 0 ? in_sizes[0] : -1, out_size, ws_size, (size_t)WS_END); grid = -1; return; }
        int dev = 0, cus = 0, per_cu = 0;
        if (hipGetDevice(&dev) != hipSuccess || hipDeviceGetAttribute(&cus, hipDeviceAttributeMultiprocessorCount, dev) != hipSuccess) { grid = -1; return; }
        if (hipFuncSetAttribute((const void*)mk_fwd, hipFuncAttributeMaxDynamicSharedMemorySize, LDS_BYTES) != hipSuccess) { fprintf(stderr, "kernel_launch: hipFuncSetAttribute failed\n"); grid = -1; return; }
        if (hipOccupancyMaxActiveBlocksPerMultiprocessor(&per_cu, (const void*)mk_fwd, NWAVES * 64, LDS_BYTES) != hipSuccess || per_cu < 1)
            fprintf(stderr, "kernel_launch: note: occupancy query reports %d workgroups per CU\n", per_cu);
        (void)hipGetLastError();
        grid = cus;
    }
    if (grid < 0) return;
    if (hipMemsetAsync((char*)d_ws + WS_CTL, 0, CTL_ZERO_BYTES, stream) != hipSuccess) { fprintf(stderr, "kernel_launch: memset failed\n"); return; }
    Args a{};
    for (int i = 0; i < 24; ++i) a.in[i] = (const float*)d_in[i];
    a.out = (float*)d_out; a.ws = (unsigned char*)d_ws;
#if MK_SPLIT
    for (int p = 0; p < N_PHASES; ++p) { a.ph_lo = p; a.ph_hi = p + 1;
        hipLaunchKernelGGL(mk_fwd, dim3(grid), dim3(NWAVES * 64), LDS_BYTES, stream, a); }
#else
    a.ph_lo = 0; a.ph_hi = N_PHASES;
    hipLaunchKernelGGL(mk_fwd, dim3(grid), dim3(NWAVES * 64), LDS_BYTES, stream, a);
#endif
    const hipError_t le = hipPeekAtLastError();
    if (le != hipSuccess) fprintf(stderr, "kernel_launch: launch failed: %s\n", hipGetErrorName(le));
}
```

```cpp
#include <hip/hip_runtime.h>
#include <cstdio>
#include <cstdint>

namespace pg8 {
#define PG8_LAS __attribute__((address_space(3)))
typedef unsigned short bf16_t;
typedef short bf16x8 __attribute__((ext_vector_type(8)));
typedef float f32x4 __attribute__((ext_vector_type(4)));
typedef unsigned u32x4 __attribute__((ext_vector_type(4)));
constexpr int BM = 256, BK = 64, HALF = 128, HTB = HALF * BK * 2  , STAGE_BYTES = 8 * HTB, NXCD = 8, WGM = 8;

__host__ __device__ __forceinline__ int lds_byte(int r, int c) { const int st = (r >> 4) * 2 + (c >> 5), rr = r & 15, cc = c & 31, ob = rr * 64 + cc * 2; return st * 1024 + (ob ^ (((ob >> 9) & 1) << 5)); }
__host__ __device__ __forceinline__ void stage_rc(int b, int& R, int& C) { const int st = b / 1024, sb = b % 1024, swz = sb ^ (((sb >> 9) & 1) << 5); R = (st >> 1) * 16 + swz / 64; C = (st & 1) * 32 + (swz % 64) / 2; }
__host__ __device__ __forceinline__ int perm32(int rho) { const int n = rho >> 4, i = rho & 15; return 8 * (i >> 2) + 4 * n + (i & 3); }

struct Unit { int pm, pn, kofs; };
struct Gemm { const bf16_t* A; const bf16_t* Bt; int M, N, K, ld; };

struct StaticOrder {
    int nM, nN, nwg, G, c, wgm;
    __host__ __device__ void init(int M, int N, int G_, int c_, int wgm_ = WGM) { nM = M / BM; nN = N / BM; nwg = nM * nN; G = G_; c = c_; wgm = wgm_; }
    __host__ __device__ bool next(int i, Unit& u) const {
        const long L = (long)i * G + c; if (L >= nwg) return false;
        int wgid = (int)L; { const int q = nwg / NXCD, r = nwg % NXCD, xcd = wgid % NXCD, off = wgid / NXCD; wgid = (xcd < r ? xcd * (q + 1) : r * (q + 1) + (xcd - r) * q) + off; }
        const int nig = wgm * nN, gid = wgid / nig, fm = gid * wgm, gsz = (nM - fm) < wgm ? (nM - fm) : wgm;
        u.pm = fm + ((wgid % nig) % gsz); u.pn = (wgid % nig) / gsz; u.kofs = 0; return true;
    }
    __device__ __forceinline__ void a_ready(const Unit&) const {}
    __device__ __forceinline__ void done(const Unit&) const {}
};

__device__ __forceinline__ unsigned cvt_pk_bf16(float lo, float hi) { unsigned r; asm volatile("v_cvt_pk_bf16_f32 %0, %1, %2" : "=v"(r) : "v"(lo), "v"(hi)); return r; }
typedef float f32x2 __attribute__((ext_vector_type(2)));
template <class Epi, class Sched, bool ALIGN_EPI = false, bool SP2 = false>
__device__ __forceinline__ void gemm_phase(PG8_LAS unsigned char* lds, const Gemm g, const Sched& S, const Epi& E) {
    int tid_l = threadIdx.x; asm volatile("" : "+v"(tid_l));
    const int tid = tid_l, wid = __builtin_amdgcn_readfirstlane(tid >> 6), lane = tid & 63, wr = wid >> 2, wc = wid & 3, fr = lane & 15, fq = lane >> 4;
    const int K = g.K, nt = K / BK, LD = g.ld;
    unsigned voffA[2], voffB[2];
#pragma unroll
    for (int i = 0; i < 2; ++i) { int R, C; stage_rc(tid * 16 + i * 8192, R, C); const int Rb = Epi::PERM ? ((R & ~31) + perm32(R & 31)) : R;
        voffA[i] = (unsigned)(R * LD + C) * 2u; voffB[i] = (unsigned)(Rb * LD + C) * 2u; }
    const size_t kstep = (size_t)(BK * 2);
    const size_t hstep = (size_t)HALF * LD * 2;
    const size_t tstep = 2 * hstep;
    const unsigned ldsw = (unsigned)wid * 1024u;
    const int aoff = lds_byte(wr * 64 + fr, fq * 8), boff = lds_byte(wc * 32 + fr, fq * 8);
#define PG8_SA(b, h) (((b) * 2 + (h)) * HTB)
#define PG8_SB(b, h) ((4 + (b) * 2 + (h)) * HTB)
#define PG8_STAGE(bufoff, gbase, voff) do { _Pragma("unroll") for (int _i = 0; _i < 2; ++_i) \
        __builtin_amdgcn_global_load_lds((const unsigned*)((const char*)(gbase) + (voff)[_i]), (PG8_LAS unsigned*)(lds + (bufoff) + ldsw + _i * 8192), 16, 0, 0); } while (0)
#define PG8_LDA(dst, b, h) do { _Pragma("unroll") for (int m = 0; m < 4; ++m) _Pragma("unroll") for (int k = 0; k < 2; ++k) dst[m][k] = *(const PG8_LAS bf16x8*)(lds + PG8_SA(b, h) + aoff + m * 2048 + k * 1024); } while (0)
#define PG8_LDB(dst, b, h) do { _Pragma("unroll") for (int n = 0; n < 2; ++n) _Pragma("unroll") for (int k = 0; k < 2; ++k) dst[n][k] = *(const PG8_LAS bf16x8*)(lds + PG8_SB(b, h) + boff + n * 2048 + k * 1024); } while (0)
#define PG8_MMA(ai, bj, At, Bt) do { __builtin_amdgcn_s_setprio(1); _Pragma("unroll") for (int m = 0; m < 4; ++m) _Pragma("unroll") for (int n = 0; n < 2; ++n) _Pragma("unroll") for (int k = 0; k < 2; ++k) \
        acc[ai][bj][m][n] = __builtin_amdgcn_mfma_f32_16x16x32_bf16(Bt[n][k], At[m][k], acc[ai][bj][m][n], 0, 0, 0); __builtin_amdgcn_s_setprio(0); } while (0)
#define PG8_WAIT_V(n) asm volatile("s_waitcnt vmcnt(" #n ")" ::: "memory")
#define PG8_WAIT_L(n) asm volatile("s_waitcnt lgkmcnt(" #n ")" ::: "memory")
#define PG8_BAR __builtin_amdgcn_s_barrier()
#define PG8_SCHED __builtin_amdgcn_sched_barrier(0)
    Unit cur, nxt; int ui = 0;
    if (!S.next(0, cur)) return;
    f32x4 acc[2][2][4][2];
#pragma unroll
    for (int a = 0; a < 2; ++a)
#pragma unroll
        for (int b = 0; b < 2; ++b)
#pragma unroll
            for (int m = 0; m < 4; ++m)
#pragma unroll
                for (int n = 0; n < 2; ++n) acc[a][b][m][n] = (f32x4){0.f, 0.f, 0.f, 0.f};
    bf16x8 At[4][2], B0[2][2], B1[2][2];
    const char* cA = (const char*)g.A + (size_t)cur.pm * tstep + cur.kofs; const char* cB = (const char*)g.Bt + (size_t)cur.pn * tstep + cur.kofs;
    S.a_ready(cur);
    if constexpr (SP2) {
        PG8_STAGE(PG8_SB(0, 0), cB, voffB); PG8_STAGE(PG8_SB(0, 1), cB + hstep, voffB); PG8_STAGE(PG8_SA(0, 0), cA, voffA); PG8_STAGE(PG8_SA(0, 1), cA + hstep, voffA);
        if (wr == 1) PG8_BAR;
        PG8_WAIT_V(2); PG8_BAR;
        PG8_STAGE(PG8_SB(1, 0), cB + kstep, voffB); PG8_STAGE(PG8_SA(1, 0), cA + kstep, voffA); PG8_STAGE(PG8_SB(1, 1), cB + hstep + kstep, voffB);
        PG8_WAIT_V(6); PG8_BAR;
    } else {
        PG8_STAGE(PG8_SB(0, 0), cB, voffB); PG8_STAGE(PG8_SA(0, 0), cA, voffA); PG8_STAGE(PG8_SB(0, 1), cB + hstep, voffB); PG8_STAGE(PG8_SA(0, 1), cA + hstep, voffA);
        if (wr == 1) PG8_BAR;
        PG8_WAIT_V(4); PG8_BAR;
        PG8_STAGE(PG8_SB(1, 0), cB + kstep, voffB); PG8_STAGE(PG8_SA(1, 0), cA + kstep, voffA); PG8_STAGE(PG8_SB(1, 1), cB + hstep + kstep, voffB);
        PG8_WAIT_V(6); PG8_BAR;
    }
    for (;;) {
        const bool has_next = S.next(ui + 1, nxt);
        const char* nA = has_next ? (const char*)g.A + (size_t)nxt.pm * tstep + nxt.kofs : cA; const char* nB = has_next ? (const char*)g.Bt + (size_t)nxt.pn * tstep + nxt.kofs : cB;
        for (int t = 0; t < nt; t += 2) {
            const bool last = (t == nt - 2);
            const char* a1 = cA + (size_t)(t + 1) * kstep;
            const char* a2 = last ? nA : cA + (size_t)(t + 2) * kstep; const char* b2 = last ? nB : cB + (size_t)(t + 2) * kstep;
            const char* a3 = a2 + kstep; const char* b3 = b2 + kstep;
            if (last && has_next) S.a_ready(nxt);
            if constexpr (SP2) {
            PG8_LDB(B0, 0, 0); PG8_LDB(B1, 0, 1); PG8_SCHED; PG8_LDA(At, 0, 0); PG8_STAGE(PG8_SA(1, 1), a1 + hstep, voffA);
            PG8_WAIT_V(8); PG8_WAIT_L(0); PG8_BAR; PG8_MMA(0, 0, At, B0); PG8_MMA(0, 1, At, B1); PG8_BAR; PG8_SCHED;
            PG8_LDA(At, 0, 1); PG8_STAGE(PG8_SB(0, 0), b2, voffB); PG8_STAGE(PG8_SB(0, 1), b2 + hstep, voffB); PG8_STAGE(PG8_SA(0, 0), a2, voffA);
            PG8_WAIT_V(8); PG8_WAIT_L(0); PG8_BAR; PG8_MMA(1, 0, At, B0); PG8_MMA(1, 1, At, B1); PG8_BAR; PG8_SCHED;
            PG8_LDB(B0, 1, 0); PG8_LDB(B1, 1, 1); PG8_SCHED; PG8_LDA(At, 1, 0); PG8_STAGE(PG8_SA(0, 1), a2 + hstep, voffA);
            PG8_WAIT_V(8); PG8_WAIT_L(0); PG8_BAR; PG8_MMA(0, 0, At, B0); PG8_MMA(0, 1, At, B1); PG8_BAR; PG8_SCHED;
            PG8_LDA(At, 1, 1); PG8_STAGE(PG8_SB(1, 0), b3, voffB); PG8_STAGE(PG8_SB(1, 1), b3 + hstep, voffB); PG8_STAGE(PG8_SA(1, 0), a3, voffA);
            PG8_WAIT_V(8); PG8_WAIT_L(0); PG8_BAR; PG8_MMA(1, 0, At, B0); PG8_MMA(1, 1, At, B1); PG8_BAR; PG8_SCHED;
            } else {
            PG8_LDB(B0, 0, 0); PG8_SCHED; PG8_LDA(At, 0, 0); PG8_STAGE(PG8_SA(1, 1), a1 + hstep, voffA);
            PG8_WAIT_L(8); PG8_BAR; PG8_WAIT_L(0); PG8_MMA(0, 0, At, B0); PG8_BAR; PG8_SCHED;
            PG8_LDB(B1, 0, 1); PG8_STAGE(PG8_SB(0, 0), b2, voffB);
            PG8_BAR; PG8_WAIT_L(0); PG8_MMA(0, 1, At, B1); PG8_BAR;
            PG8_LDA(At, 0, 1); PG8_STAGE(PG8_SA(0, 0), a2, voffA);
            PG8_BAR; PG8_WAIT_L(0); PG8_MMA(1, 0, At, B0); PG8_BAR; PG8_SCHED;
            PG8_STAGE(PG8_SB(0, 1), b2 + hstep, voffB);
            PG8_WAIT_V(6); PG8_BAR; PG8_MMA(1, 1, At, B1); PG8_BAR;
            PG8_LDB(B0, 1, 0); PG8_SCHED; PG8_LDA(At, 1, 0); PG8_STAGE(PG8_SA(0, 1), a2 + hstep, voffA);
            PG8_WAIT_L(8); PG8_BAR; PG8_WAIT_L(0); PG8_MMA(0, 0, At, B0); PG8_BAR; PG8_SCHED;
            PG8_LDB(B1, 1, 1); PG8_STAGE(PG8_SB(1, 0), b3, voffB);
            PG8_BAR; PG8_WAIT_L(0); PG8_MMA(0, 1, At, B1); PG8_BAR;
            PG8_LDA(At, 1, 1); PG8_STAGE(PG8_SA(1, 0), a3, voffA);
            PG8_BAR; PG8_WAIT_L(0); PG8_MMA(1, 0, At, B0); PG8_BAR; PG8_SCHED;
            PG8_STAGE(PG8_SB(1, 1), b3 + hstep, voffB);
            PG8_WAIT_V(6); PG8_BAR; PG8_MMA(1, 1, At, B1); PG8_BAR;
            }
        }
        if constexpr (ALIGN_EPI) { if (wr == 0) PG8_BAR; }
        if constexpr (!Epi::AFTER_DRAIN) { E(acc, cur, wr, wc, fr, fq); S.done(cur); }
        if (!has_next) break;
#pragma unroll
        for (int a = 0; a < 2; ++a)
#pragma unroll
            for (int b = 0; b < 2; ++b)
#pragma unroll
                for (int m = 0; m < 4; ++m)
#pragma unroll
                    for (int n = 0; n < 2; ++n) acc[a][b][m][n] = (f32x4){0.f, 0.f, 0.f, 0.f};
        cur = nxt; cA = nA; cB = nB; ++ui;
        if constexpr (ALIGN_EPI) { if (wr == 1) PG8_BAR; }
    }
    PG8_WAIT_V(0);
    if constexpr (!ALIGN_EPI) { if (wr == 0) PG8_BAR; }
    PG8_BAR;
    if constexpr (Epi::AFTER_DRAIN) { E.fused(acc, cur, wr, wc, fr, fq, lds, wid, lane); S.done(cur); }
#undef PG8_SA
#undef PG8_SB
#undef PG8_STAGE
#undef PG8_LDA
#undef PG8_LDB
#undef PG8_MMA
#undef PG8_WAIT_V
#undef PG8_WAIT_L
#undef PG8_BAR
#undef PG8_SCHED
}
}
#define GAS __attribute__((address_space(1)))
#define LAS __attribute__((address_space(3)))
typedef unsigned short bf16;
typedef unsigned v4u __attribute__((ext_vector_type(4)));
typedef float f32x4 __attribute__((ext_vector_type(4)));
typedef short bf16x8 __attribute__((ext_vector_type(8)));
typedef GAS unsigned gu32;
typedef GAS unsigned long long gu64;
#define RLX_AGENT __ATOMIC_RELAXED, __HIP_MEMORY_SCOPE_AGENT
#define LDS_WAIT() asm volatile("s_waitcnt lgkmcnt(0)" ::: "memory")
#define VM_WAIT() asm volatile("s_waitcnt vmcnt(0)" ::: "memory")
__device__ __forceinline__ unsigned long long rt() { return __builtin_amdgcn_s_memrealtime(); }
__device__ __forceinline__ unsigned f2bf(float f) { unsigned u = __builtin_bit_cast(unsigned, f); return (u + 0x7fffu + ((u >> 16) & 1u)) >> 16; }
__device__ __forceinline__ unsigned pk2(float lo, float hi) { return f2bf(lo) | (f2bf(hi) << 16); }

#define XB_TMO      128
#define XB_XCNT(j)  (256  + 64 * (j))
#define XB_XSUB(j)  (1280 + 64 * (j))
#define XB_XGEN(j)  (2304 + 64 * (j))
#define XB_TOP      3328
#define XB_TOPGEN   3392
#define XCD_BAR_WORDS 3456
#define XB_SPIN_CAP (1u << 18)

__device__ __forceinline__ unsigned xb_ld(unsigned* p)              { return __hip_atomic_load(p, __ATOMIC_RELAXED, __HIP_MEMORY_SCOPE_AGENT); }
__device__ __forceinline__ unsigned xb_add(unsigned* p, unsigned v) { return __hip_atomic_fetch_add(p, v, __ATOMIC_RELAXED, __HIP_MEMORY_SCOPE_AGENT); }
__device__ __forceinline__ unsigned xb_xcc_id() { return (unsigned)__builtin_amdgcn_s_getreg((3 << 11) | 20) & 0xFu; }
#define XB_SPIN(cond, bar) do { unsigned _sp = 0; while (cond) { __builtin_amdgcn_s_sleep(1); \
    if ((++_sp & 255u) == 0u) { if (xb_ld(&(bar)[XB_TMO])) break; if (_sp > XB_SPIN_CAP) { atomicAdd(&(bar)[XB_TMO], 1u); break; } } } } while (0)

struct XcdBarrier {
    unsigned* bar; unsigned x;
    volatile LAS unsigned* st;
};

__device__ __forceinline__ XcdBarrier xcd_barrier_post(unsigned* bar, volatile LAS unsigned* st) {
    XcdBarrier b; b.bar = bar; b.x = xb_xcc_id(); b.st = st;
    if (threadIdx.x == 0) (void)xb_add(&bar[XB_XCNT(b.x)], 1u);
    return b;
}
__device__ __forceinline__ void xcd_barrier_complete(unsigned* bar, unsigned x, unsigned& nloc, unsigned& nx) {
    const unsigned G = gridDim.x * gridDim.y * gridDim.z;
    unsigned sum, cnt, mine, sp = 0u;
    for (;;) {
        sum = 0u; cnt = 0u; mine = 0u;
#pragma unroll
        for (unsigned j = 0; j < 16; ++j) { const unsigned c = xb_ld(&bar[XB_XCNT(j)]); sum += c; cnt += (c > 0u) ? 1u : 0u; mine = (j == x) ? c : mine; }
        if (sum == G) break;
        __builtin_amdgcn_s_sleep(1);
        if ((++sp & 255u) == 0u) { if (xb_ld(&bar[XB_TMO])) break; if (sp > XB_SPIN_CAP) { atomicAdd(&bar[XB_TMO], 1u); break; } }
    }
    nloc = mine > 0u ? mine : 1u; nx = cnt > 0u ? cnt : 1u;
}

__device__ __forceinline__ void xcd_barrier(const XcdBarrier& b) {
    asm volatile("s_waitcnt vmcnt(0)" ::: "memory");
    __syncthreads();
    if (threadIdx.x == 0) {
        unsigned* bar = b.bar;
        __builtin_amdgcn_s_waitcnt(0);
        unsigned nloc = b.st[0], nx = b.st[1];
        if (nloc == 0u) { xcd_barrier_complete(bar, b.x, nloc, nx); b.st[0] = nloc; b.st[1] = nx; }
        const unsigned old = xb_add(&bar[XB_XSUB(b.x)], 1u);
        const unsigned gen = old / nloc;
        if (old + 1u == (gen + 1u) * nloc) {
            __builtin_amdgcn_fence(__ATOMIC_RELEASE, "agent");
            asm volatile("s_waitcnt vmcnt(0)" ::: "memory");
            const unsigned og = xb_add(&bar[XB_TOP], 1u);
            const unsigned tg = og / nx;
            if (og + 1u == (tg + 1u) * nx) xb_add(&bar[XB_TOPGEN], 1u);
            else XB_SPIN(xb_ld(&bar[XB_TOPGEN]) == tg, bar);
            __builtin_amdgcn_fence(__ATOMIC_ACQUIRE, "agent");
            xb_add(&bar[XB_XGEN(b.x)], 1u);
            asm volatile("s_waitcnt vmcnt(0)" ::: "memory");
        } else {
            XB_SPIN(xb_ld(&bar[XB_XGEN(b.x)]) == gen, bar);
            __builtin_amdgcn_fence(__ATOMIC_ACQUIRE, "agent");
            asm volatile("s_waitcnt vmcnt(0)" ::: "memory");
        }
    }
    __syncthreads();
}

typedef float f32x16 __attribute__((ext_vector_type(16)));
typedef short s16x4 __attribute__((ext_vector_type(4)));
typedef unsigned u32x2 __attribute__((ext_vector_type(2)));

constexpr int D = 2048, FF = 5632, NGU = 2 * FF, SEQ = 16384, NB = 2, CTXL = 256;
constexpr int M_LAT = NB * SEQ;
constexpr int M_CTX = NB * CTXL;
constexpr int M_ALL = M_LAT + M_CTX;
constexpr int NMODV = 9 * D;
constexpr int QLORA = 448, KVLORA = 160, ROPE = 64, NHEAD = 16, DQK = 192, DVH = 128;
constexpr int NDQKV = 768;
constexpr int KQ = 512, KKV = 256;
constexpr float EPS = 1e-6f;
constexpr int KSPLIT = 14;
constexpr int NWAVES = 8;

constexpr size_t MiB = 1u << 20;
constexpr size_t WS_CTL = 0, CTL_ZERO_BYTES = 1 * MiB;
constexpr size_t WS_STATS = 512 * 1024;
constexpr size_t WS_MOD = 1 * MiB;
constexpr size_t WS_ROPE = 2 * MiB;
constexpr size_t WS_MODP = 3 * MiB;
constexpr size_t WS_WGU = 10 * MiB;
constexpr size_t SZ_WGU = 44 * MiB;
constexpr size_t WS_WD = WS_WGU + 4 * SZ_WGU;
constexpr size_t SZ_WD = 22 * MiB;
constexpr size_t WS_GMIN = WS_WD + 4 * SZ_WD;
constexpr size_t WS_GMOUT = WS_GMIN + 16 * MiB;
constexpr size_t WS_WDQKV = WS_GMOUT + 8 * MiB;
constexpr size_t WS_WUQ = WS_WDQKV + 3 * MiB;
constexpr size_t WS_WUKV = WS_WUQ + 3 * MiB;
constexpr size_t WS_WO = WS_WUKV + 2 * MiB;
constexpr size_t WS_Y = WS_WO + 8 * MiB;
constexpr size_t WS_XB = WS_Y + 4 * MiB;
constexpr size_t WS_XN = WS_XB;
constexpr size_t WS_BIG = WS_XN + 130 * MiB;
constexpr size_t WS_U = WS_BIG, WS_V = WS_BIG + 130 * MiB;
constexpr size_t WS_Q = WS_BIG, WS_KN = WS_BIG + 192 * MiB, WS_VV = WS_KN + 130 * MiB, WS_F = WS_VV + 130 * MiB;
constexpr size_t WS_CQ = WS_F + 98 * MiB, WS_CKV = WS_CQ + 33 * MiB, WS_KPE = WS_CKV + 17 * MiB, WS_END = WS_KPE + 5 * MiB;
static_assert((size_t)M_ALL * D * 2 <= 130 * MiB && (size_t)M_ALL * FF * 2 <= 358 * MiB && (size_t)M_LAT * 3072 * 2 <= 192 * MiB, "ws map");
static_assert((size_t)M_ALL * NDQKV * 4 <= 98 * MiB && (size_t)M_ALL * KQ * 2 <= 33 * MiB && (size_t)M_ALL * KKV * 2 <= 17 * MiB && (size_t)M_ALL * 64 * 2 <= 5 * MiB, "ws map 2");
static_assert(WS_STATS + (size_t)M_ALL * 8 <= CTL_ZERO_BYTES, "stats inside the zeroed region");
constexpr int CW_TMO = 0, CW_CODE = 1, CW_BAR = 4096;

constexpr int RING_OFF = 0, RING_BYTES = 131072;
constexpr int ATT_SHM_V = 64 * 256, ATT_SHM_K = 64 * 384;
constexpr int ATT_OFF_K = 2 * ATT_SHM_V, ATT_OFF_WS = ATT_OFF_K + 2 * ATT_SHM_K, ATT_OFF_QPE = ATT_OFF_WS + NWAVES * 256, ATT_NQR = 5, ATT_END = ATT_OFF_QPE + NWAVES * (12 - ATT_NQR) * 1024, ATT_OFF_OST = 0;
static_assert(NWAVES * 8192 <= ATT_OFF_WS, "O stage overlays the K/V buffers");
constexpr int ATT_NQD = 12;
constexpr int MISC_OFF = 149504, LDS_BYTES = 149504 + 512;
static_assert(ATT_END <= MISC_OFF && RING_BYTES <= MISC_OFF && MISC_OFF + 128 <= LDS_BYTES, "LDS map");

enum Phase { PH_PRO = 0, PH_MOD, PH_L0 = 2,
             PH_END = 27 };
constexpr int N_PHASES = 25;

struct Args { const float* in[24]; float* out; unsigned char* ws; int ph_lo, ph_hi; };
static_assert(sizeof(Args) == 24 * 8 + 8 + 8 + 8, "Args has no padding");

struct Frame {
    LAS unsigned char* lds;
    gu32* ctl;
    int wave, vcu, G;
};
__device__ __forceinline__ int mk_lane() { int l; asm volatile("v_mbcnt_lo_u32_b32 %0, -1, 0\n\tv_mbcnt_hi_u32_b32 %0, -1, %0" : "=v"(l)); return l; }

__device__ __forceinline__ float wave_sum(float v) {
#pragma unroll
    for (int o = 1; o < 64; o <<= 1) v += __shfl_xor(v, o);
    return v;
}
__device__ __forceinline__ float silu_f(float x) { return x * __builtin_amdgcn_rcpf(1.0f + __builtin_amdgcn_exp2f(-1.4426950408889634f * x)); }
__device__ __forceinline__ float gelu_tanh_f(float x) {
    const float z = 0.7978845608028654f * (x + 0.044715f * x * x * x);
    return x * __builtin_amdgcn_rcpf(1.0f + __builtin_amdgcn_exp2f(-2.0f * 1.4426950408889634f * z));
}
__device__ __forceinline__ int cond_of_row(int r) { return r < SEQ ? 0 : (r < M_LAT ? 1 : 2); }

typedef float f32x2 __attribute__((ext_vector_type(2)));
constexpr float GATE_SCALE = 1.4426950408889634f, UP_SCALE = 0.6931471805599453f;
struct EpiSwiGLU {
    static constexpr bool PERM = true, AFTER_DRAIN = false;
    pg8::bf16_t* H;
    __device__ __forceinline__ void operator()(const pg8::f32x4 (&acc)[2][2][4][2], const pg8::Unit& u, int wr, int wc, int fr, int fq) const {
        asm volatile("" : "+v"(fr), "+v"(fq));
        const int row0 = u.pm * 256 + wr * 64 + fr, col0 = u.pn * 128 + wc * 32 + 8 * fq;
#pragma unroll
        for (int ai = 0; ai < 2; ++ai)
#pragma unroll
            for (int m = 0; m < 4; ++m) {
                pg8::bf16_t* rowp = H + (size_t)(row0 + ai * 128 + m * 16) * FF + col0;
                f32x2 hp[4];
#pragma unroll
                for (int n = 0; n < 2; ++n)
#pragma unroll
                    for (int j = 0; j < 4; j += 2) {
                        const f32x2 g2 = {acc[ai][0][m][n][j], acc[ai][0][m][n][j + 1]}, u2 = {acc[ai][1][m][n][j], acc[ai][1][m][n][j + 1]};
                        f32x2 e2 = {__builtin_amdgcn_exp2f(-g2.x), __builtin_amdgcn_exp2f(-g2.y)};
                        e2 = e2 + 1.0f;
                        const f32x2 r2 = {__builtin_amdgcn_rcpf(e2.x), __builtin_amdgcn_rcpf(e2.y)};
                        hp[n * 2 + (j >> 1)] = (g2 * u2) * r2; }
                pg8::u32x4 w; w.x = pg8::cvt_pk_bf16(hp[0].x, hp[0].y); w.y = pg8::cvt_pk_bf16(hp[1].x, hp[1].y); w.z = pg8::cvt_pk_bf16(hp[2].x, hp[2].y); w.w = pg8::cvt_pk_bf16(hp[3].x, hp[3].y);
                *(pg8::u32x4*)rowp = w;
            }
    }
};
typedef _Float16 h16x4 __attribute__((ext_vector_type(4)));
__device__ __forceinline__ pg8::f32x4 bf4_to_f32(u32x2 w) { const h16x4 h = __builtin_bit_cast(h16x4, w); return __builtin_convertvector(h, pg8::f32x4); }
__device__ __forceinline__ u32x2 f32_to_bf4(pg8::f32x4 v) { const h16x4 h = __builtin_convertvector(v, h16x4); return __builtin_bit_cast(u32x2, h); }
template <bool BASE_F32> struct EpiResidT {
    static constexpr bool PERM = true, AFTER_DRAIN = false;
    const void* base; pg8::bf16_t* out;
    const float* gate;
    float coef;
    __device__ __forceinline__ void operator()(const pg8::f32x4 (&acc)[2][2][4][2], const pg8::Unit& u, int wr, int wc, int fr, int fq) const {
        asm volatile("" : "+v"(fr), "+v"(fq));
        typedef _Float16 h16x8 __attribute__((ext_vector_type(8)));
        typedef float f32x8v __attribute__((ext_vector_type(8)));
        const int row0 = u.pm * 256 + wr * 64 + fr, col0 = u.pn * 256 + wc * 32 + 8 * fq;
        const int cond = u.pm < 64 ? 0 : 1;
        const float* gv = gate + (size_t)cond * NMODV + col0;
        pg8::f32x4 g[2][2];
#pragma unroll
        for (int bj = 0; bj < 2; ++bj)
#pragma unroll
            for (int n = 0; n < 2; ++n) g[bj][n] = *(const pg8::f32x4*)(gv + bj * 128 + 4 * n) * coef;
#pragma unroll
        for (int ai = 0; ai < 2; ++ai) {
            pg8::f32x4 bv[4][2][2];
#pragma unroll
            for (int m = 0; m < 4; ++m)
#pragma unroll
                for (int bj = 0; bj < 2; ++bj) { const size_t off = (size_t)(row0 + ai * 128 + m * 16) * D + col0 + bj * 128;
                    if constexpr (BASE_F32) { bv[m][bj][0] = *(const pg8::f32x4*)((const float*)base + off); bv[m][bj][1] = *(const pg8::f32x4*)((const float*)base + off + 4); }
                    else { const h16x8 h = __builtin_bit_cast(h16x8, *(const pg8::u32x4*)((const pg8::bf16_t*)base + off)); const f32x8v f = __builtin_convertvector(h, f32x8v);
                        bv[m][bj][0] = (pg8::f32x4){f[0], f[1], f[2], f[3]}; bv[m][bj][1] = (pg8::f32x4){f[4], f[5], f[6], f[7]}; } }
#pragma unroll
            for (int m = 0; m < 4; ++m)
#pragma unroll
                for (int bj = 0; bj < 2; ++bj) {
                    const pg8::f32x4 o0 = bv[m][bj][0] + g[bj][0] * acc[ai][bj][m][0], o1 = bv[m][bj][1] + g[bj][1] * acc[ai][bj][m][1];
                    const f32x8v f = {o0[0], o0[1], o0[2], o0[3], o1[0], o1[1], o1[2], o1[3]};
                    *(pg8::u32x4*)(out + (size_t)(row0 + ai * 128 + m * 16) * D + col0 + bj * 128) = __builtin_bit_cast(pg8::u32x4, __builtin_convertvector(f, h16x8));
                }
        }
    }
};
typedef EpiResidT<false> EpiResid;
typedef EpiResidT<true> EpiResidF32;
struct EpiResidAtomic {
    static constexpr bool PERM = false, AFTER_DRAIN = false;
    float* outC;
    const float* gate;
    float coef;
    __device__ __forceinline__ void operator()(const pg8::f32x4 (&acc)[2][2][4][2], const pg8::Unit& u, int wr, int wc, int fr, int fq) const {
        asm volatile("" : "+v"(fr), "+v"(fq));
        const int row0 = u.pm * 256 + wr * 64 + fr, col0 = u.pn * 256 + wc * 32 + 4 * fq;
        const float* gv = gate + (size_t)2 * NMODV + col0;
        pg8::f32x4 g[2][2];
#pragma unroll
        for (int bj = 0; bj < 2; ++bj)
#pragma unroll
            for (int n = 0; n < 2; ++n) g[bj][n] = *(const pg8::f32x4*)(gv + bj * 128 + n * 16) * coef;
#pragma unroll
        for (int ai = 0; ai < 2; ++ai)
#pragma unroll
            for (int m = 0; m < 4; ++m) {
                float* op = outC + (size_t)(row0 + ai * 128 + m * 16) * D + col0;
#pragma unroll
                for (int bj = 0; bj < 2; ++bj)
#pragma unroll
                    for (int n = 0; n < 2; ++n) {
                        const pg8::f32x4 v = g[bj][n] * acc[ai][bj][m][n];
#pragma unroll
                        for (int j = 0; j < 4; ++j) unsafeAtomicAdd(op + bj * 128 + n * 16 + j, v[j]);
                    }
            }
    }
};
struct EpiPartial {
    static constexpr bool PERM = false, AFTER_DRAIN = false;
    float* part;
    const float* gate; float coef; int kslice_bytes;
    __device__ __forceinline__ void operator()(const pg8::f32x4 (&acc)[2][2][4][2], const pg8::Unit& u, int wr, int wc, int fr, int fq) const {
        asm volatile("" : "+v"(fr), "+v"(fq));
        const int row0 = u.pm * 256 + wr * 64 + fr, col0 = u.pn * 256 + wc * 32 + 4 * fq;
        const float* gv = gate + (size_t)2 * NMODV + col0;
        float* pbase = part + (size_t)(u.kofs / kslice_bytes) * ((size_t)M_CTX * D);
        pg8::f32x4 g[2][2];
#pragma unroll
        for (int bj = 0; bj < 2; ++bj)
#pragma unroll
            for (int n = 0; n < 2; ++n) g[bj][n] = *(const pg8::f32x4*)(gv + bj * 128 + n * 16) * coef;
#pragma unroll
        for (int ai = 0; ai < 2; ++ai)
#pragma unroll
            for (int m = 0; m < 4; ++m) {
                float* op = pbase + (size_t)(row0 + ai * 128 + m * 16) * D + col0;
#pragma unroll
                for (int bj = 0; bj < 2; ++bj)
#pragma unroll
                    for (int n = 0; n < 2; ++n) *(pg8::f32x4*)(op + bj * 128 + n * 16) = g[bj][n] * acc[ai][bj][m][n];
            }
    }
};
constexpr int CTX_P = 11;
static_assert(FF % (CTX_P * 128) == 0, "every K slice must be an even number of 64-wide K tiles");
struct SplitKOrder {
    int nN, P, kslice_bytes, G, c;
    __device__ __forceinline__ bool next(int i, pg8::Unit& u) const {
        const int L = i * G + c; if (L >= 2 * nN * P) return false;
        const int part = L / (2 * nN), t = L % (2 * nN);
        u.pm = 128 + (t & 1); u.pn = t >> 1; u.kofs = part * kslice_bytes; return true;
    }
    __device__ __forceinline__ void a_ready(const pg8::Unit&) const {}
    __device__ __forceinline__ void done(const pg8::Unit&) const {}
};
struct ClaimOrder {
    int nN, P, kslice_bytes; unsigned* ctr; volatile LAS unsigned* mb;
    __device__ __forceinline__ bool next(int i, pg8::Unit& u) const {
        if (i > 0) return false;
        if (threadIdx.x == 0) *mb = atomicAdd(ctr, 1u);
        __syncthreads();
        const int L = (int)*mb; if (L >= 2 * nN * P) return false;
        const int part = L / (2 * nN), t = L % (2 * nN);
        u.pm = 128 + (t & 1); u.pn = t >> 1; u.kofs = part * kslice_bytes; return true;
    }
    __device__ __forceinline__ void a_ready(const pg8::Unit&) const {}
    __device__ __forceinline__ void done(const pg8::Unit&) const {}
};
static_assert(2 * (D / 256) * CTX_P <= 256 && 2 * (NGU / 256) <= 256, "ClaimOrder: one unit per workgroup");
struct EpiGeluUV {
    static constexpr bool PERM = true, AFTER_DRAIN = false;
    pg8::bf16_t* U; pg8::bf16_t* V; float* stats;
    __device__ __forceinline__ void operator()(const pg8::f32x4 (&acc)[2][2][4][2], const pg8::Unit& u, int wr, int wc, int fr, int fq) const {
        asm volatile("" : "+v"(fr), "+v"(fq));
        const int row0 = u.pm * 256 + wr * 64 + fr;
        const bool isv = u.pn >= 8;
        pg8::bf16_t* base = isv ? V : U;
        const int col0 = (u.pn & 7) * 256 + wc * 32 + 8 * fq;
#pragma unroll
        for (int ai = 0; ai < 2; ++ai)
#pragma unroll
            for (int m = 0; m < 4; ++m) {
                const int row = row0 + ai * 128 + m * 16;
                pg8::bf16_t* rowp = base + (size_t)row * D + col0;
                float s = 0.f, q = 0.f;
#pragma unroll
                for (int bj = 0; bj < 2; ++bj) {
                    float z[8];
#pragma unroll
                    for (int n = 0; n < 2; ++n)
#pragma unroll
                        for (int j = 0; j < 4; ++j) { const float t = gelu_tanh_f(acc[ai][bj][m][n][j]); z[n * 4 + j] = t; s += t; q += t * t; }
                    pg8::u32x4 w; w.x = pg8::cvt_pk_bf16(z[0], z[1]); w.y = pg8::cvt_pk_bf16(z[2], z[3]); w.z = pg8::cvt_pk_bf16(z[4], z[5]); w.w = pg8::cvt_pk_bf16(z[6], z[7]);
                    *(pg8::u32x4*)(rowp + bj * 128) = w;
                }
                if (isv) {
                    s += __shfl_xor(s, 16); s += __shfl_xor(s, 32); q += __shfl_xor(q, 16); q += __shfl_xor(q, 32);
                    if (fq == 0) { atomicAdd(stats + 2 * row, s); atomicAdd(stats + 2 * row + 1, q); }
                }
            }
    }
};
struct EpiF32 {
    static constexpr bool PERM = false, AFTER_DRAIN = false;
    float* C; int ldc;
    __device__ __forceinline__ void operator()(const pg8::f32x4 (&acc)[2][2][4][2], const pg8::Unit& u, int wr, int wc, int fr, int fq) const {
        asm volatile("" : "+v"(fr), "+v"(fq));
        const int row0 = u.pm * 256 + wr * 64 + fr, col0 = u.pn * 256 + wc * 32 + 4 * fq;
#pragma unroll
        for (int ai = 0; ai < 2; ++ai)
#pragma unroll
            for (int m = 0; m < 4; ++m) { float* rowp = C + (size_t)(row0 + ai * 128 + m * 16) * ldc + col0;
#pragma unroll
                for (int bj = 0; bj < 2; ++bj)
#pragma unroll
                    for (int n = 0; n < 2; ++n) *(pg8::f32x4*)(rowp + bj * 128 + n * 16) = acc[ai][bj][m][n]; }
    }
};
constexpr float QPRESCALE = 0.07216878364870322f * 1.4426950408889634f;
struct EpiQRope {
    static constexpr bool PERM = true, AFTER_DRAIN = false;
    pg8::bf16_t* Q; const float* rope;
    __device__ __forceinline__ void operator()(const pg8::f32x4 (&acc)[2][2][4][2], const pg8::Unit& u, int wr, int wc, int fr, int fq) const {
        asm volatile("" : "+v"(fr), "+v"(fq));
        const int row0 = u.pm * 256 + wr * 64 + fr;
#pragma unroll
        for (int bj = 0; bj < 2; ++bj) {
            const int g32 = u.pn * 8 + bj * 4 + wc, gh = g32 % 6;
            const int col0 = g32 * 32 + 8 * fq;
#pragma unroll
            for (int ai = 0; ai < 2; ++ai)
#pragma unroll
                for (int m = 0; m < 4; ++m) {
                    const int row = row0 + ai * 128 + m * 16;
                    float x[8];
#pragma unroll
                    for (int n = 0; n < 2; ++n)
#pragma unroll
                        for (int j = 0; j < 4; ++j) x[n * 4 + j] = acc[ai][bj][m][n][j];
                    if (gh >= 4) {
                        const int t = row & (SEQ - 1), pos = (gh == 4) ? (t >> 6) : (t & 63);
                        const float* cp = rope + pos * 16 + 8 * (fq & 1); const float* sp = cp + 256 * 16;
                        const float sgn = (fq & 2) ? 1.f : -1.f;
#pragma unroll
                        for (int e = 0; e < 8; ++e) { const float p = __shfl_xor(x[e], 32); x[e] = x[e] * cp[e] + sgn * p * sp[e]; }
                    }
#pragma unroll
                    for (int e = 0; e < 8; ++e) x[e] *= QPRESCALE;
                    pg8::u32x4 w; w.x = pg8::cvt_pk_bf16(x[0], x[1]); w.y = pg8::cvt_pk_bf16(x[2], x[3]); w.z = pg8::cvt_pk_bf16(x[4], x[5]); w.w = pg8::cvt_pk_bf16(x[6], x[7]);
                    *(pg8::u32x4*)(Q + (size_t)row * 3072 + col0) = w;
                }
        }
    }
};
struct EpiKV {
    static constexpr bool PERM = true, AFTER_DRAIN = false;
    pg8::bf16_t* KN; pg8::bf16_t* V;
    __device__ __forceinline__ void operator()(const pg8::f32x4 (&acc)[2][2][4][2], const pg8::Unit& u, int wr, int wc, int fr, int fq) const {
        asm volatile("" : "+v"(fr), "+v"(fq));
        const int row0 = u.pm * 256 + wr * 64 + fr, col0 = u.pn * 128 + wc * 32 + 8 * fq;
#pragma unroll
        for (int ai = 0; ai < 2; ++ai)
#pragma unroll
            for (int m = 0; m < 4; ++m) {
                const size_t off = (size_t)(row0 + ai * 128 + m * 16) * D + col0;
#pragma unroll
                for (int bj = 0; bj < 2; ++bj) {
                    const pg8::f32x4 v0 = acc[ai][bj][m][0], v1 = acc[ai][bj][m][1];
                    pg8::u32x4 w; w.x = pg8::cvt_pk_bf16(v0[0], v0[1]); w.y = pg8::cvt_pk_bf16(v0[2], v0[3]); w.z = pg8::cvt_pk_bf16(v1[0], v1[1]); w.w = pg8::cvt_pk_bf16(v1[2], v1[3]);
                    *(pg8::u32x4*)((bj ? V : KN) + off) = w;
                }
            }
    }
};

__device__ __forceinline__ void transpose_item(const float* W, int K, int N, bf16* WT, int Kd, int drow0, int k0, int n0, LAS float* scr, int lane, float scale = 1.0f) {
    float wv[32];
#pragma unroll
    for (int i = 0; i < 32; ++i) { const int kk = 2 * i + (lane >> 5), k = k0 + kk; wv[i] = (k < K) ? W[(size_t)k * N + n0 + (lane & 31)] : 0.f; }
    if (scale != 1.0f) {
#pragma unroll
        for (int i = 0; i < 32; ++i) wv[i] *= scale; }
#pragma unroll
    for (int i = 0; i < 32; ++i) { const int kk = 2 * i + (lane >> 5); scr[kk * 33 + (lane & 31)] = wv[i]; }
    LDS_WAIT(); asm volatile("" ::: "memory");
    const int c = lane & 7;
#pragma unroll
    for (int j = 0; j < 4; ++j) { const int n = (lane >> 3) + 8 * j; const LAS float* s = scr + (8 * c) * 33 + n;
        v4u o; o.x = pk2(s[0 * 33], s[1 * 33]); o.y = pk2(s[2 * 33], s[3 * 33]); o.z = pk2(s[4 * 33], s[5 * 33]); o.w = pk2(s[6 * 33], s[7 * 33]);
        *(GAS v4u*)(WT + (size_t)(drow0 + n) * Kd + k0 + 8 * c) = o; }
    LDS_WAIT(); asm volatile("" ::: "memory");
}
__device__ __forceinline__ void transpose_mat(const float* W, int K, int N, bf16* WT, int Kd, int drow_off, int r, LAS float* scr, int lane) {
    const int nblk = N / 32, kb = r / nblk, nb = r % nblk;
    transpose_item(W, K, N, WT, Kd, drow_off + 32 * nb, 64 * kb, 32 * nb, scr, lane);
}

__device__ __forceinline__ void ph_prologue(Frame& F, const Args& a) {
    unsigned char* ws = a.ws; const int lane_ = mk_lane(), tid_ = F.wave * 64 + lane_;
    const int gw = F.vcu * NWAVES + F.wave, NGW = F.G * NWAVES;
    LAS float* stab = (LAS float*)(F.lds + 98304);
    for (int k = tid_; k < D; k += NWAVES * 64) {
        pg8::f32x4 s; s.x = silu_f(a.in[1][k]); s.y = silu_f(a.in[1][D + k]); s.z = silu_f(a.in[3][k]); s.w = 0.f;
        *(LAS pg8::f32x4*)(stab + 4 * k) = s;
    }
    __syncthreads();
    {
        constexpr int NT = 2 * 72 * KSPLIT;
        for (int t = gw; t < NT; t += NGW) {
            const int ks = t % KSPLIT, cb = (t / KSPLIT) % 72, l = t / (KSPLIT * 72);
            const int kbeg = ks * D / KSPLIT, kend = (ks + 1) * D / KSPLIT, col = cb * 256 + 4 * lane_;
            const float* w = a.in[4] + ((size_t)l * D + kbeg) * NMODV + col;
            pg8::f32x4 a0 = {0.f, 0.f, 0.f, 0.f}, a1 = a0, a2 = a0;
#pragma unroll 16
            for (int k = kbeg; k < kend; ++k) {
                const pg8::f32x4 wv = *(const pg8::f32x4*)w; w += NMODV;
                const pg8::f32x4 s = *(LAS pg8::f32x4*)(stab + 4 * k);
                a0 += wv * s.x; a1 += wv * s.y; a2 += wv * s.z;
            }
            float* p = (float*)(ws + WS_MODP) + ((size_t)(ks * 2 + l) * 3) * NMODV + col;
            *(pg8::f32x4*)p = a0; *(pg8::f32x4*)(p + NMODV) = a1; *(pg8::f32x4*)(p + 2 * NMODV) = a2;
        }
    }
    for (int i = blockIdx.x * (NWAVES * 64) + tid_; i < 256 * 16; i += F.G * NWAVES * 64) {
        const int pos = i >> 4, f = i & 15;
        const float inv = __builtin_amdgcn_exp2f(-(float)f * (13.287712379549449f / 16.0f));
        const float rev = (float)pos * inv * 0.15915494309189535f;
        float* rp = (float*)(ws + WS_ROPE);
        rp[i] = __builtin_amdgcn_cosf(rev); rp[4096 + i] = __builtin_amdgcn_sinf(rev);
    }
    { const GAS v4u* src = (const GAS v4u*)a.in[2]; GAS v4u* dst = (GAS v4u*)(ws + WS_Y);
      for (int i = blockIdx.x * (NWAVES * 64) + tid_; i < M_CTX * D / 4; i += F.G * NWAVES * 64) dst[i] = src[i]; }
    { v4u z = {0u, 0u, 0u, 0u}; GAS v4u* p = (GAS v4u*)(ws + WS_WDQKV + (size_t)672 * D * 2);
      for (int i = blockIdx.x * (NWAVES * 64) + tid_; i < 96 * D * 2 / 16; i += F.G * NWAVES * 64) p[i] = z; }
    LAS float* scr = (LAS float*)(F.lds + F.wave * 8448);
    constexpr int IT_FFN = 5632, N_FFN = 12 * IT_FFN;
    constexpr int I_GMIN = 32 * 128, I_GMOUT = 32 * 64, I_WO = 32 * 64, I_DQ = 32 * 14, I_DKV = 32 * 7, I_UQ = 8 * 96, I_UKV = 4 * 128;
    constexpr int NITEMS = N_FFN + I_GMIN + I_GMOUT + I_WO + I_DQ + I_DKV + I_UQ + I_UKV;
    for (int it = gw; it < NITEMS; it += NGW) {
        int r = it;
        if (r < N_FFN) {
            const int idx = r / IT_FFN, sub = idx / 3, kind = idx % 3; r -= idx * IT_FFN;
            if (kind < 2) {
                const float* W = a.in[7 + kind] + (size_t)sub * D * FF;
                const int nblk = FF / 32, kb = r / nblk, nb = r % nblk, n0 = 32 * nb;
                transpose_item(W, D, FF, (bf16*)(ws + WS_WGU + sub * SZ_WGU), D, (n0 >> 7) * 256 + kind * 128 + (n0 & 127), 64 * kb, n0, scr, lane_, kind == 0 ? GATE_SCALE : UP_SCALE);
            } else {
                transpose_mat(a.in[9] + (size_t)sub * FF * D, FF, D, (bf16*)(ws + WS_WD + sub * SZ_WD), FF, 0, r, scr, lane_);
            }
            continue;
        }
        r -= N_FFN;
        if (r < I_GMIN) { transpose_mat(a.in[10], D, 4096, (bf16*)(ws + WS_GMIN), D, 0, r, scr, lane_); continue; } r -= I_GMIN;
        if (r < I_GMOUT) { transpose_mat(a.in[15], D, D, (bf16*)(ws + WS_GMOUT), D, 0, r, scr, lane_); continue; } r -= I_GMOUT;
        if (r < I_WO) { transpose_mat(a.in[22], D, D, (bf16*)(ws + WS_WO), D, 0, r, scr, lane_); continue; } r -= I_WO;
        if (r < I_DQ) { transpose_mat(a.in[16], D, QLORA, (bf16*)(ws + WS_WDQKV), D, 0, r, scr, lane_); continue; } r -= I_DQ;
        if (r < I_DKV) { transpose_mat(a.in[19], D, KVLORA + ROPE, (bf16*)(ws + WS_WDQKV), D, QLORA, r, scr, lane_); continue; } r -= I_DKV;
        if (r < I_UQ) { transpose_mat(a.in[18], QLORA, 3072, (bf16*)(ws + WS_WUQ), KQ, 0, r, scr, lane_); continue; } r -= I_UQ;
        transpose_mat(a.in[21], KVLORA, 4096, (bf16*)(ws + WS_WUKV), KKV, 0, r, scr, lane_);
    }
}
__device__ __forceinline__ void ph_modreduce(Frame& F, const Args& a) {
    const int tid_ = F.wave * 64 + mk_lane();
    const float* mp = (const float*)(a.ws + WS_MODP); float* mod = (float*)(a.ws + WS_MOD);
    for (int i = blockIdx.x * (NWAVES * 64) + tid_; i < 2 * 3 * NMODV; i += F.G * NWAVES * 64) {
        const int n = i % NMODV, l = i / (3 * NMODV);
        float s = a.in[5][l * NMODV + n];
#pragma unroll
        for (int ks = 0; ks < KSPLIT; ++ks) s += mp[(size_t)ks * 2 * 3 * NMODV + i];
        mod[i] = s;
    }
}
template <bool LAT_F32, int P = 0> __device__ __forceinline__ void ph_norm(Frame& F, const void* srcL  , const float* srcC  , int M, const float* g, const float* modl  , int k, bf16* XN, const float* part = nullptr  , float* Ywr = nullptr  ) {
    typedef _Float16 h16x8 __attribute__((ext_vector_type(8)));
    typedef float f32x8v __attribute__((ext_vector_type(8)));
    const int gw = F.vcu * NWAVES + F.wave, NGW = F.G * NWAVES, lane_ = mk_lane();
    int cur = -1; f32x8v A[4], B[4];
    auto do_row = [&](const int r) {
        const int cond = cond_of_row(r);
        if (cond != cur) {
            cur = cond;
            const float* sh = modl + (size_t)cond * NMODV + (3 * k) * D; const float* sc = sh + D;
#pragma unroll
            for (int j = 0; j < 4; ++j) { const int c = 8 * lane_ + 512 * j; const f32x8v gg = *(const f32x8v*)(g + c), s1 = *(const f32x8v*)(sc + c);
                A[j] = gg * (s1 + 1.0f); B[j] = *(const f32x8v*)(sh + c); }
        }
        f32x8v v[4]; float ss = 0.f;
        if (LAT_F32 || r >= M_LAT) {
            const float* xr = (r < M_LAT ? (const float*)srcL : srcC) + (size_t)r * D + 8 * lane_;
#pragma unroll
            for (int j = 0; j < 4; ++j) v[j] = *(const GAS f32x8v*)(xr + 512 * j);
            if (P > 0 && r >= M_LAT) {
                const float* pr = part + (size_t)r * D + 8 * lane_;
#pragma unroll
                for (int p0 = 0; p0 < P; p0 += 3) {
                    f32x8v t[3][4];
#pragma unroll
                    for (int pp = 0; pp < 3; ++pp)
#pragma unroll
                        for (int j = 0; j < 4; ++j) if (p0 + pp < P) t[pp][j] = *(const GAS f32x8v*)(pr + (size_t)(p0 + pp) * ((size_t)M_CTX * D) + 512 * j);
#pragma unroll
                    for (int pp = 0; pp < 3; ++pp)
#pragma unroll
                        for (int j = 0; j < 4; ++j) if (p0 + pp < P) v[j] += t[pp][j]; }
                float* yw = Ywr + (size_t)r * D + 8 * lane_;
#pragma unroll
                for (int j = 0; j < 4; ++j) *(GAS f32x8v*)(yw + 512 * j) = v[j];
            }
        } else {
            const bf16* xr = (const bf16*)srcL + (size_t)r * D + 8 * lane_;
#pragma unroll
            for (int j = 0; j < 4; ++j) v[j] = __builtin_convertvector(__builtin_bit_cast(h16x8, *(const GAS v4u*)(xr + 512 * j)), f32x8v);
        }
#pragma unroll
        for (int j = 0; j < 4; ++j) { const f32x8v q = v[j] * v[j]; ss += ((q[0] + q[1]) + (q[2] + q[3])) + ((q[4] + q[5]) + (q[6] + q[7])); }
        const float rstd = __builtin_amdgcn_rsqf(wave_sum(ss) * (1.0f / D) + EPS);
        GAS v4u* o = (GAS v4u*)(XN + (size_t)r * D + 8 * lane_);
#pragma unroll
        for (int j = 0; j < 4; ++j) { const f32x8v y = v[j] * rstd * A[j] + B[j]; v4u w; w.x = pg8::cvt_pk_bf16(y[0], y[1]); w.y = pg8::cvt_pk_bf16(y[2], y[3]); w.z = pg8::cvt_pk_bf16(y[4], y[5]); w.w = pg8::cvt_pk_bf16(y[6], y[7]); o[64 * j] = w; }
    };
    for (int r = gw; r < (M < M_LAT ? M : M_LAT); r += NGW) do_row(r);
    if (M > M_LAT) {
        const int S = NGW >= M_CTX ? NGW / M_CTX : 1;
        if (gw % S == 0) for (int jr = gw / S; jr < M - M_LAT; jr += NGW / S) do_row(M_LAT + jr);
    }
}
__device__ __forceinline__ void ph_final(Frame& F, const bf16* XB, float* out, const float* g) {
    typedef _Float16 h16x8 __attribute__((ext_vector_type(8)));
    typedef float f32x8v __attribute__((ext_vector_type(8)));
    const int gw = F.vcu * NWAVES + F.wave, NGW = F.G * NWAVES, lane_ = mk_lane();
    f32x8v A[4];
#pragma unroll
    for (int j = 0; j < 4; ++j) A[j] = *(const f32x8v*)(g + 8 * lane_ + 512 * j);
    for (int r = gw; r < M_LAT; r += NGW) {
        const bf16* xr = XB + (size_t)r * D + 8 * lane_; float* orow = out + (size_t)r * D + 8 * lane_;
        f32x8v v[4]; float ss = 0.f;
#pragma unroll
        for (int j = 0; j < 4; ++j) { v[j] = __builtin_convertvector(__builtin_bit_cast(h16x8, *(const GAS v4u*)(xr + 512 * j)), f32x8v); const f32x8v q = v[j] * v[j]; ss += ((q[0] + q[1]) + (q[2] + q[3])) + ((q[4] + q[5]) + (q[6] + q[7])); }
        const float rstd = __builtin_amdgcn_rsqf(wave_sum(ss) * (1.0f / D) + EPS);
#pragma unroll
        for (int j = 0; j < 4; ++j) *(GAS f32x8v*)(orow + 512 * j) = v[j] * rstd * A[j];
    }
}
__device__ __forceinline__ void ph_mla_norm(Frame& F, const float* Fm, const float* qn, const float* kvn, const float* rope, bf16* CQ, bf16* CKV, bf16* KPE) {
    const int gw = F.vcu * NWAVES + F.wave, NGW = F.G * NWAVES, lane = mk_lane();
    for (int r = gw; r < M_ALL; r += NGW) {
        const float* fr = Fm + (size_t)r * NDQKV;
        float x[8]; float ss = 0.f;
        if (lane < 56) {
            const pg8::f32x4 a = *(const GAS pg8::f32x4*)(fr + 8 * lane), b = *(const GAS pg8::f32x4*)(fr + 8 * lane + 4);
            x[0] = a.x; x[1] = a.y; x[2] = a.z; x[3] = a.w; x[4] = b.x; x[5] = b.y; x[6] = b.z; x[7] = b.w;
#pragma unroll
            for (int e = 0; e < 8; ++e) ss += x[e] * x[e];
        } else {
#pragma unroll
            for (int e = 0; e < 8; ++e) x[e] = 0.f;
        }
        const float rq = __builtin_amdgcn_rsqf(wave_sum(ss) * (1.0f / QLORA) + EPS);
        {
            float y[8];
#pragma unroll
            for (int e = 0; e < 8; ++e) y[e] = (lane < 56) ? x[e] * rq * qn[8 * lane + e] : 0.f;
            v4u w; w.x = pg8::cvt_pk_bf16(y[0], y[1]); w.y = pg8::cvt_pk_bf16(y[2], y[3]); w.z = pg8::cvt_pk_bf16(y[4], y[5]); w.w = pg8::cvt_pk_bf16(y[6], y[7]);
            *(GAS v4u*)(CQ + (size_t)r * KQ + 8 * lane) = w;
        }
        float z[8]; float s2 = 0.f;
        if (lane < 20) {
            const pg8::f32x4 a = *(const GAS pg8::f32x4*)(fr + QLORA + 8 * lane), b = *(const GAS pg8::f32x4*)(fr + QLORA + 8 * lane + 4);
            z[0] = a.x; z[1] = a.y; z[2] = a.z; z[3] = a.w; z[4] = b.x; z[5] = b.y; z[6] = b.z; z[7] = b.w;
#pragma unroll
            for (int e = 0; e < 8; ++e) s2 += z[e] * z[e];
        } else if (lane >= 32 && lane < 40) {
            const int j = lane - 32;
            const pg8::f32x4 a = *(const GAS pg8::f32x4*)(fr + QLORA + KVLORA + 8 * j), b = *(const GAS pg8::f32x4*)(fr + QLORA + KVLORA + 8 * j + 4);
            z[0] = a.x; z[1] = a.y; z[2] = a.z; z[3] = a.w; z[4] = b.x; z[5] = b.y; z[6] = b.z; z[7] = b.w;
        } else {
#pragma unroll
            for (int e = 0; e < 8; ++e) z[e] = 0.f;
        }
        const float rk = __builtin_amdgcn_rsqf(wave_sum(s2) * (1.0f / KVLORA) + EPS);
        float pz[8];
#pragma unroll
        for (int e = 0; e < 8; ++e) pz[e] = __shfl_xor(z[e], 2);
        if (lane < 32) {
            float y[8];
#pragma unroll
            for (int e = 0; e < 8; ++e) y[e] = (lane < 20) ? z[e] * rk * kvn[8 * lane + e] : 0.f;
            v4u w; w.x = pg8::cvt_pk_bf16(y[0], y[1]); w.y = pg8::cvt_pk_bf16(y[2], y[3]); w.z = pg8::cvt_pk_bf16(y[4], y[5]); w.w = pg8::cvt_pk_bf16(y[6], y[7]);
            *(GAS v4u*)(CKV + (size_t)r * KKV + 8 * lane) = w;
        } else if (lane < 40) {
            const int j = lane - 32;
            float y[8];
            if (r < M_LAT) {
                const int t = r & (SEQ - 1), pos = (j < 4) ? (t >> 6) : (t & 63);
                const float* cp = rope + pos * 16 + 8 * (j & 1); const float* sp = cp + 4096;
                const float sgn = (j & 2) ? 1.f : -1.f;
#pragma unroll
                for (int e = 0; e < 8; ++e) y[e] = z[e] * cp[e] + sgn * pz[e] * sp[e];
            } else {
#pragma unroll
                for (int e = 0; e < 8; ++e) y[e] = z[e];
            }
            v4u w; w.x = pg8::cvt_pk_bf16(y[0], y[1]); w.y = pg8::cvt_pk_bf16(y[2], y[3]); w.z = pg8::cvt_pk_bf16(y[4], y[5]); w.w = pg8::cvt_pk_bf16(y[6], y[7]);
            *(GAS v4u*)(KPE + (size_t)r * 64 + 8 * j) = w;
        }
    }
}

__device__ __forceinline__ s16x4 tr_read_dyn(int addr) { s16x4 r; asm volatile("ds_read_b64_tr_b16 %0, %1" : "=&v"(r) : "v"(addr) : "memory"); return r; }
__device__ __forceinline__ void ph_gm_mix(Frame& F, bf16* U, const bf16* V, const float* stats, const float* lng, const float* lnb, const float* w_s, const float* b_s, bf16* Uout = nullptr) {
    if (Uout == nullptr) Uout = U;
    constexpr int WS_STRIDE = 272, VN_STRIDE = 528, VN_OFF = 128 * WS_STRIDE;
    const int lane = mk_lane(), wave = F.wave, tid = wave * 64 + lane, wp = wave >> 2, wd = wave & 3;
    LAS unsigned char* lw = F.lds; LAS unsigned char* lv = F.lds + VN_OFF;
    const int NU = (M_ALL / 128) * 8;
    for (int un = F.vcu; un < NU; un += F.G) {
        const int c = un >> 3, g = un & 7, R0 = 128 * c, F0 = 256 * g;
        __syncthreads();
        { const float* w = w_s + (size_t)g * 128 * 128;
#pragma unroll
          for (int i = 0; i < 8; ++i) { const int id = tid + 512 * i, p = id >> 5, q4 = (id & 31) * 4; const pg8::f32x4 v = *(const GAS pg8::f32x4*)(w + p * 128 + q4);
              u32x2 o; o.x = pg8::cvt_pk_bf16(v.x, v.y); o.y = pg8::cvt_pk_bf16(v.z, v.w); *(LAS u32x2*)(lw + p * WS_STRIDE + q4 * 2) = o; } }
        { const int dg = tid & 31; const float* gp = lng + F0 + 8 * dg; const float* bp = lnb + F0 + 8 * dg;
          const pg8::f32x4 g0 = *(const pg8::f32x4*)gp, g1 = *(const pg8::f32x4*)(gp + 4), b0 = *(const pg8::f32x4*)bp, b1 = *(const pg8::f32x4*)(bp + 4);
#pragma unroll
          for (int i = 0; i < 8; ++i) { const int q = (tid >> 5) + 16 * i, row = R0 + q;
              const v4u raw = *(const GAS v4u*)(V + (size_t)row * D + F0 + 8 * dg);
              const float s = stats[2 * row], ss = stats[2 * row + 1];
              const float mean = s * (1.0f / D), var = ss * (1.0f / D) - mean * mean, rstd = __builtin_amdgcn_rsqf(var + EPS);
              float x[8];
              x[0] = __uint_as_float(raw.x << 16); x[1] = __uint_as_float(raw.x & 0xffff0000u); x[2] = __uint_as_float(raw.y << 16); x[3] = __uint_as_float(raw.y & 0xffff0000u);
              x[4] = __uint_as_float(raw.z << 16); x[5] = __uint_as_float(raw.z & 0xffff0000u); x[6] = __uint_as_float(raw.w << 16); x[7] = __uint_as_float(raw.w & 0xffff0000u);
              float y[8];
              y[0] = (x[0] - mean) * rstd * g0.x + b0.x; y[1] = (x[1] - mean) * rstd * g0.y + b0.y; y[2] = (x[2] - mean) * rstd * g0.z + b0.z; y[3] = (x[3] - mean) * rstd * g0.w + b0.w;
              y[4] = (x[4] - mean) * rstd * g1.x + b1.x; y[5] = (x[5] - mean) * rstd * g1.y + b1.y; y[6] = (x[6] - mean) * rstd * g1.z + b1.z; y[7] = (x[7] - mean) * rstd * g1.w + b1.w;
              v4u o; o.x = pg8::cvt_pk_bf16(y[0], y[1]); o.y = pg8::cvt_pk_bf16(y[2], y[3]); o.z = pg8::cvt_pk_bf16(y[4], y[5]); o.w = pg8::cvt_pk_bf16(y[6], y[7]);
              *(LAS v4u*)(lv + q * VN_STRIDE + dg * 16) = o; } }
        __syncthreads();
        pg8::f32x4 acc[4][4];
#pragma unroll
        for (int mi = 0; mi < 4; ++mi)
#pragma unroll
            for (int ni = 0; ni < 4; ++ni) acc[mi][ni] = (pg8::f32x4){0.f, 0.f, 0.f, 0.f};
        const int G4 = lane >> 4, i16 = lane & 15, ta = i16 >> 2, tb = i16 & 3;
        const int vbase = (int)(unsigned)(uintptr_t)lv + (8 * G4 + ta) * VN_STRIDE + (wd * 64 + 4 * tb) * 2;
#pragma unroll
        for (int ks = 0; ks < 4; ++ks) {
            pg8::bf16x8 Bw[4], Av[4];
#pragma unroll
            for (int mi = 0; mi < 4; ++mi) Bw[mi] = *(const LAS pg8::bf16x8*)(lw + (wp * 64 + 16 * mi + i16) * WS_STRIDE + (32 * ks + 8 * G4) * 2);
#pragma unroll
            for (int ni = 0; ni < 4; ++ni) { const int ad = vbase + 32 * ks * VN_STRIDE + ni * 32;
                const s16x4 lo = tr_read_dyn(ad), hi = tr_read_dyn(ad + 4 * VN_STRIDE);
                Av[ni] = (pg8::bf16x8){lo[0], lo[1], lo[2], lo[3], hi[0], hi[1], hi[2], hi[3]}; }
            asm volatile("s_waitcnt lgkmcnt(0)" ::: "memory"); __builtin_amdgcn_sched_barrier(0);
#pragma unroll
            for (int mi = 0; mi < 4; ++mi)
#pragma unroll
                for (int ni = 0; ni < 4; ++ni) acc[mi][ni] = __builtin_amdgcn_mfma_f32_16x16x32_bf16(Av[ni], Bw[mi], acc[mi][ni], 0, 0, 0);
        }
        u32x2 uall[4][4];
#pragma unroll
        for (int mi = 0; mi < 4; ++mi)
#pragma unroll
            for (int ni = 0; ni < 4; ++ni) uall[mi][ni] = *(const GAS u32x2*)(U + (size_t)(R0 + wp * 64 + 16 * mi + i16) * D + F0 + wd * 64 + 16 * ni + 4 * G4);
#pragma unroll
        for (int mi = 0; mi < 4; ++mi) {
            const int p = wp * 64 + 16 * mi + i16; const float bias = b_s[g * 128 + p];
#pragma unroll
            for (int ni = 0; ni < 4; ++ni) {
                GAS u32x2* up = (GAS u32x2*)(Uout + (size_t)(R0 + p) * D + F0 + wd * 64 + 16 * ni + 4 * G4);
                const u32x2 uu = uall[mi][ni];
                const float u0 = __uint_as_float(uu.x << 16), u1 = __uint_as_float(uu.x & 0xffff0000u), u2 = __uint_as_float(uu.y << 16), u3 = __uint_as_float(uu.y & 0xffff0000u);
                u32x2 o; o.x = pg8::cvt_pk_bf16(u0 * (acc[mi][ni][0] + bias), u1 * (acc[mi][ni][1] + bias)); o.y = pg8::cvt_pk_bf16(u2 * (acc[mi][ni][2] + bias), u3 * (acc[mi][ni][3] + bias));
                *up = o;
            }
        }
    }
    __syncthreads();
}

namespace att {
constexpr float SCALE = 0.07216878364870322f;
#ifndef ATT_THR
#define ATT_THR 8.f
#endif
constexpr float THR = ATT_THR;
constexpr int NT = (SEQ + CTXL) / 64;
constexpr int NQR = ATT_NQR;
#define SBAR() __builtin_amdgcn_sched_barrier(0)
__device__ __forceinline__ int crow(int r, int hi) { return (r & 3) + 8 * (r >> 2) + 4 * hi; }
__device__ __forceinline__ unsigned cvtpk(float lo, float hi) { unsigned r; asm volatile("v_cvt_pk_bf16_f32 %0, %1, %2" : "=v"(r) : "v"(lo), "v"(hi)); return r; }
__device__ __forceinline__ float sm_rowmax(const f32x16& p0, const f32x16& p1) {
  float pmax = p0[0];
#pragma unroll
  for (int r = 1; r < 16; ++r) pmax = fmaxf(pmax, p0[r]);
#pragma unroll
  for (int r = 0; r < 16; ++r) pmax = fmaxf(pmax, p1[r]);
  auto rr = __builtin_amdgcn_permlane32_swap(__float_as_uint(pmax), __float_as_uint(pmax), false, false);
  return fmaxf(__uint_as_float(rr[0]), __uint_as_float(rr[1]));
}
__device__ __forceinline__ void sm_decide(float pmax, float& m_reg, float& mnC, float& alpha) {
  constexpr float C = SCALE * 1.4426950408889634f;
  const bool grow = (pmax - m_reg) > (THR / SCALE);
  const float mn = grow ? pmax : m_reg;
  const float a = __builtin_amdgcn_exp2f((m_reg - mn) * C);
  alpha = grow ? a : 1.f; m_reg = mn; mnC = -mn * C;
}
__device__ __forceinline__ void sm_scale(f32x16& p, float mnC) {
  constexpr float C = SCALE * 1.4426950408889634f;
#pragma unroll
  for (int r = 0; r < 16; ++r) p[r] = fmaf(p[r], C, mnC);
}
template <int LO, int HI> __device__ __forceinline__ void sm_exp(f32x16& p) {
#pragma unroll
  for (int r = LO; r < HI; ++r) p[r] = __builtin_amdgcn_exp2f(p[r]);
}
__device__ __forceinline__ void partialSM(f32x16& p0, f32x16& p1, float& m_reg, float& alpha) {
  float mnC; const float pm = sm_rowmax(p0, p1); sm_decide(pm, m_reg, mnC, alpha); sm_scale(p0, mnC); sm_scale(p1, mnC); sm_exp<0, 16>(p0);
}
__device__ __forceinline__ void finishSM(f32x16& p0, f32x16& p1, float alpha, float& l_reg, bf16x8& pa0, bf16x8& pa1, bf16x8& pa2, bf16x8& pa3) {
#pragma unroll
  for (int r = 0; r < 16; ++r) p1[r] = __builtin_amdgcn_exp2f(p1[r]);
  float ps = 0;
#pragma unroll
  for (int r = 0; r < 16; ++r) ps += p0[r];
#pragma unroll
  for (int r = 0; r < 16; ++r) ps += p1[r];
  { auto rr = __builtin_amdgcn_permlane32_swap(__float_as_uint(ps), __float_as_uint(ps), false, false);
    ps = __uint_as_float(rr[0]) + __uint_as_float(rr[1]); }
  l_reg = l_reg * alpha + ps;
#define PK4(P, BASE, OUT) do { unsigned a0 = cvtpk(P[BASE + 0], P[BASE + 1]), a1 = cvtpk(P[BASE + 2], P[BASE + 3]);   \
    unsigned b0 = cvtpk(P[BASE + 4], P[BASE + 5]), b1 = cvtpk(P[BASE + 6], P[BASE + 7]);                              \
    auto r0 = __builtin_amdgcn_permlane32_swap(a0, b0, false, false); auto r1 = __builtin_amdgcn_permlane32_swap(a1, b1, false, false); \
    v4u w = {r0[0], r1[0], r0[1], r1[1]}; OUT = *reinterpret_cast<bf16x8*>(&w); } while (0)
  PK4(p0, 0, pa0); PK4(p0, 8, pa1); PK4(p1, 0, pa2); PK4(p1, 8, pa3);
#undef PK4
}
template <int NQ> __device__ __forceinline__ void qkt(f32x16& p0, f32x16& p1, const LAS char* Ks  , const bf16x8 (&qr)[NQ], const LAS char* qpe) {
  p0 = f32x16{}; p1 = f32x16{};
#pragma unroll
  for (int d0 = 0; d0 < 12; ++d0) {
    bf16x8 b0 = *reinterpret_cast<const LAS bf16x8*>(Ks + d0 * 2048);
    bf16x8 b1 = *reinterpret_cast<const LAS bf16x8*>(Ks + d0 * 2048 + 1024);
    bf16x8 q;
    if (d0 < NQ) q = qr[d0]; else q = *reinterpret_cast<const LAS bf16x8*>(qpe + (d0 - NQ) * 1024);
    p0 = __builtin_amdgcn_mfma_f32_32x32x16_bf16(b0, q, p0, 0, 0, 0);
    p1 = __builtin_amdgcn_mfma_f32_32x32x16_bf16(b1, q, p1, 0, 0, 0); }
}
__device__ __forceinline__ int v_st(int k, int c) { const int kk = (k & ~0xC) | ((k & 4) << 1) | ((k & 8) >> 1); return ((kk >> 3) * 4 + (c >> 5)) * 512 + ((kk & 7) * 32 + (c & 31)) * 2; }
__device__ __forceinline__ int v_rd_base(int lane) { return ((lane & 3) << 3) | (((lane >> 2) & 3) << 6) | (((lane >> 4) & 1) << 5) | (((lane >> 5) & 1) << 8); }
constexpr int v_rd_off(int d0, int ks, int half) { return d0 * 512 + ks * 4096 + half * 2048; }
template <int OFF> __device__ __forceinline__ s16x4 tr_read(int vb) {
  s16x4 r; asm volatile("ds_read_b64_tr_b16 %0, %1 offset:%2" : "=&v"(r) : "v"(vb), "i"(OFF) : "memory"); return r;
}
template <int D0> __device__ __forceinline__ void pv_one(f32x16& od, int vb, bf16x8 pa0, bf16x8 pa1, bf16x8 pa2, bf16x8 pa3) {
  const s16x4 l0 = tr_read<v_rd_off(D0, 0, 0)>(vb), h0 = tr_read<v_rd_off(D0, 0, 1)>(vb), l1 = tr_read<v_rd_off(D0, 1, 0)>(vb), h1 = tr_read<v_rd_off(D0, 1, 1)>(vb);
  const s16x4 l2 = tr_read<v_rd_off(D0, 2, 0)>(vb), h2 = tr_read<v_rd_off(D0, 2, 1)>(vb), l3 = tr_read<v_rd_off(D0, 3, 0)>(vb), h3 = tr_read<v_rd_off(D0, 3, 1)>(vb);
  asm volatile("s_waitcnt lgkmcnt(0)" ::: "memory"); SBAR();
#define PK(L, H) (bf16x8){L[0], L[1], L[2], L[3], H[0], H[1], H[2], H[3]}
  od = __builtin_amdgcn_mfma_f32_32x32x16_bf16(pa0, PK(l0, h0), od, 0, 0, 0);
  od = __builtin_amdgcn_mfma_f32_32x32x16_bf16(pa1, PK(l1, h1), od, 0, 0, 0);
  od = __builtin_amdgcn_mfma_f32_32x32x16_bf16(pa2, PK(l2, h2), od, 0, 0, 0);
  od = __builtin_amdgcn_mfma_f32_32x32x16_bf16(pa3, PK(l3, h3), od, 0, 0, 0);
#undef PK
}
__device__ __forceinline__ void pv_d0(f32x16 (&o)[4], int vb, bf16x8 pa0, bf16x8 pa1, bf16x8 pa2, bf16x8 pa3) {
  pv_one<0>(o[0], vb, pa0, pa1, pa2, pa3); pv_one<1>(o[1], vb, pa0, pa1, pa2, pa3); pv_one<2>(o[2], vb, pa0, pa1, pa2, pa3); pv_one<3>(o[3], vb, pa0, pa1, pa2, pa3);
}
__device__ __forceinline__ void pv_sm(f32x16 (&o)[4], int vb, bf16x8 pa0, bf16x8 pa1, bf16x8 pa2, bf16x8 pa3, f32x16& pX0, f32x16& pX1, float& m_reg, float& alpha) {
  float mnC;
  pv_one<0>(o[0], vb, pa0, pa1, pa2, pa3); const float pm = sm_rowmax(pX0, pX1);
  pv_one<1>(o[1], vb, pa0, pa1, pa2, pa3); sm_decide(pm, m_reg, mnC, alpha); sm_scale(pX0, mnC);
  pv_one<2>(o[2], vb, pa0, pa1, pa2, pa3); sm_scale(pX1, mnC); sm_exp<0, 8>(pX0);
  pv_one<3>(o[3], vb, pa0, pa1, pa2, pa3); sm_exp<8, 16>(pX0);
}
#define KREAD(a, b, d0) asm volatile("ds_read_b128 %0, %2 offset:%3\n\tds_read_b128 %1, %2 offset:%4" : "=&v"(a), "=&v"(b) : "v"(kaddr), "i"((d0) * 2048), "i"((d0) * 2048 + 1024))
#define KWAIT(n, a, b) asm volatile("s_waitcnt lgkmcnt(" #n ")" : "+v"(a), "+v"(b))
__device__ __forceinline__ void qkt2(f32x16& p0, f32x16& p1, int kaddr, const bf16x8 (&qr)[12], const f32x16& cinit) {
  p0 = cinit; p1 = cinit;
#if ATT_KDEPTH == 2
  bf16x8 ka0, ka1, kb0, kb1, kc0, kc1;
  KREAD(ka0, ka1, 0); KREAD(kb0, kb1, 1);
#define KSTEP(x0, x1, d0) do { if ((d0) + 2 < 12) { KWAIT(4, x0, x1); } else if ((d0) + 1 < 12) { KWAIT(2, x0, x1); } else { KWAIT(0, x0, x1); } \
    p0 = __builtin_amdgcn_mfma_f32_32x32x16_bf16(x0, qr[d0], p0, 0, 0, 0); p1 = __builtin_amdgcn_mfma_f32_32x32x16_bf16(x1, qr[d0], p1, 0, 0, 0); } while (0)
#pragma unroll
  for (int d0 = 0; d0 < 12; d0 += 3) {
    KREAD(kc0, kc1, d0 + 2); KSTEP(ka0, ka1, d0);
    if (d0 + 3 < 12) KREAD(ka0, ka1, d0 + 3);
    KSTEP(kb0, kb1, d0 + 1);
    if (d0 + 4 < 12) KREAD(kb0, kb1, d0 + 4);
    KSTEP(kc0, kc1, d0 + 2);
  }
#undef KSTEP
#else
  bf16x8 ka0, ka1, kb0, kb1;
  KREAD(ka0, ka1, 0);
#pragma unroll
  for (int d0 = 0; d0 < 12; d0 += 2) {
    KREAD(kb0, kb1, d0 + 1); KWAIT(2, ka0, ka1);
    p0 = __builtin_amdgcn_mfma_f32_32x32x16_bf16(ka0, qr[d0], p0, 0, 0, 0); p1 = __builtin_amdgcn_mfma_f32_32x32x16_bf16(ka1, qr[d0], p1, 0, 0, 0);
    if (d0 + 2 < 12) { KREAD(ka0, ka1, d0 + 2); KWAIT(2, kb0, kb1); } else { KWAIT(0, kb0, kb1); }
    p0 = __builtin_amdgcn_mfma_f32_32x32x16_bf16(kb0, qr[d0 + 1], p0, 0, 0, 0); p1 = __builtin_amdgcn_mfma_f32_32x32x16_bf16(kb1, qr[d0 + 1], p1, 0, 0, 0);
  }
#endif
}
#undef KREAD
#undef KWAIT
template <int D0> __device__ __forceinline__ void pv_reads(s16x4 (&t)[8], int vb) {
  t[0] = tr_read<v_rd_off(D0, 0, 0)>(vb); t[1] = tr_read<v_rd_off(D0, 0, 1)>(vb); t[2] = tr_read<v_rd_off(D0, 1, 0)>(vb); t[3] = tr_read<v_rd_off(D0, 1, 1)>(vb);
  t[4] = tr_read<v_rd_off(D0, 2, 0)>(vb); t[5] = tr_read<v_rd_off(D0, 2, 1)>(vb); t[6] = tr_read<v_rd_off(D0, 3, 0)>(vb); t[7] = tr_read<v_rd_off(D0, 3, 1)>(vb);
}
__device__ __forceinline__ void pv_mma(f32x16& od, const s16x4 (&t)[8], bf16x8 pa0, bf16x8 pa1, bf16x8 pa2, bf16x8 pa3) {
#define PK(L, H) (bf16x8){L[0], L[1], L[2], L[3], H[0], H[1], H[2], H[3]}
  od = __builtin_amdgcn_mfma_f32_32x32x16_bf16(pa0, PK(t[0], t[1]), od, 0, 0, 0);
  od = __builtin_amdgcn_mfma_f32_32x32x16_bf16(pa1, PK(t[2], t[3]), od, 0, 0, 0);
  od = __builtin_amdgcn_mfma_f32_32x32x16_bf16(pa2, PK(t[4], t[5]), od, 0, 0, 0);
  od = __builtin_amdgcn_mfma_f32_32x32x16_bf16(pa3, PK(t[6], t[7]), od, 0, 0, 0);
#undef PK
}
#define PVW(n) do { asm volatile("s_waitcnt lgkmcnt(" #n ")" ::: "memory"); SBAR(); } while (0)
__device__ __forceinline__ void pv_sm2(f32x16 (&o)[4], int vb, bf16x8 pa0, bf16x8 pa1, bf16x8 pa2, bf16x8 pa3, f32x16& pX0, f32x16& pX1, float& m_reg, float& alpha) {
  float mnC; s16x4 ta[8], tb[8];
  pv_reads<0>(ta, vb);
  pv_reads<1>(tb, vb); PVW(8); pv_mma(o[0], ta, pa0, pa1, pa2, pa3); float pm = sm_rowmax(pX0, pX1); asm volatile("" : "+v"(pm));
  pv_reads<2>(ta, vb); PVW(8); pv_mma(o[1], tb, pa0, pa1, pa2, pa3); sm_decide(pm, m_reg, mnC, alpha); sm_scale(pX0, mnC); asm volatile("" : "+v"(pX0));
  pv_reads<3>(tb, vb); PVW(8); pv_mma(o[2], ta, pa0, pa1, pa2, pa3); sm_scale(pX1, mnC); sm_exp<0, 8>(pX0); asm volatile("" : "+v"(pX0), "+v"(pX1));
  PVW(0); pv_mma(o[3], tb, pa0, pa1, pa2, pa3); sm_exp<8, 16>(pX0); asm volatile("" : "+v"(pX0));
}
__device__ __forceinline__ void pv_sm3(f32x16 (&o)[4], int vb, bf16x8 pa0, bf16x8 pa1, bf16x8 pa2, bf16x8 pa3, f32x16& pX0, f32x16& pX1, float& m_reg, float& alpha, s16x4 (&ta)[8]) {
  float mnC; s16x4 tb[8];
  pv_reads<1>(tb, vb); PVW(8); pv_mma(o[0], ta, pa0, pa1, pa2, pa3); float pm = sm_rowmax(pX0, pX1); asm volatile("" : "+v"(pm));
  pv_reads<2>(ta, vb); PVW(8); pv_mma(o[1], tb, pa0, pa1, pa2, pa3); sm_decide(pm, m_reg, mnC, alpha); sm_scale(pX0, mnC); asm volatile("" : "+v"(pX0));
  pv_reads<3>(tb, vb); PVW(8); pv_mma(o[2], ta, pa0, pa1, pa2, pa3); sm_scale(pX1, mnC); sm_exp<0, 8>(pX0); asm volatile("" : "+v"(pX0), "+v"(pX1));
  PVW(0); pv_mma(o[3], tb, pa0, pa1, pa2, pa3); sm_exp<8, 16>(pX0); asm volatile("" : "+v"(pX0));
}
constexpr float THRL = THR * 1.4426950408889634f;
__device__ __forceinline__ void sm_grow(float pm, f32x16& p0, f32x16& p1, float& m_reg, float& alpha, f32x16& negm) {
  const bool grow = pm > THRL;
  alpha = 1.f;
  if (__any(grow)) {
    const float dl = grow ? pm : 0.f;
#pragma unroll
    for (int r = 0; r < 16; ++r) { p0[r] -= dl; p1[r] -= dl; }
    m_reg += dl; alpha = __builtin_amdgcn_exp2f(-dl);
    const float nm = -m_reg;
#pragma unroll
    for (int r = 0; r < 16; ++r) negm[r] = nm;
  }
}
__device__ __forceinline__ void pv_sm4(f32x16 (&o)[4], int vb, bf16x8 pa0, bf16x8 pa1, bf16x8 pa2, bf16x8 pa3, f32x16& pX0, f32x16& pX1, float& m_reg, float& alpha, f32x16& negm) {
  s16x4 ta[8], tb[8];
  pv_reads<0>(ta, vb);
  pv_reads<1>(tb, vb); PVW(8); pv_mma(o[0], ta, pa0, pa1, pa2, pa3); float pm = sm_rowmax(pX0, pX1); asm volatile("" : "+v"(pm));
  pv_reads<2>(ta, vb); PVW(8); pv_mma(o[1], tb, pa0, pa1, pa2, pa3); sm_grow(pm, pX0, pX1, m_reg, alpha, negm); sm_exp<0, 6>(pX0); asm volatile("" : "+v"(pX0));
  pv_reads<3>(tb, vb); PVW(8); pv_mma(o[2], ta, pa0, pa1, pa2, pa3); sm_exp<6, 12>(pX0); asm volatile("" : "+v"(pX0));
  PVW(0); pv_mma(o[3], tb, pa0, pa1, pa2, pa3); sm_exp<12, 16>(pX0); asm volatile("" : "+v"(pX0));
}
__device__ __forceinline__ void pv_sm5(f32x16 (&o)[4], int vb, bf16x8 pa0, bf16x8 pa1, bf16x8 pa2, bf16x8 pa3, f32x16& pX0, f32x16& pX1, float& m_reg, float& alpha, f32x16& negm, s16x4 (&ta)[8]) {
  s16x4 tb[8];
  pv_reads<1>(tb, vb); PVW(8); pv_mma(o[0], ta, pa0, pa1, pa2, pa3); float pm = sm_rowmax(pX0, pX1); asm volatile("" : "+v"(pm));
  pv_reads<2>(ta, vb); PVW(8); pv_mma(o[1], tb, pa0, pa1, pa2, pa3); sm_grow(pm, pX0, pX1, m_reg, alpha, negm); sm_exp<0, 6>(pX0); asm volatile("" : "+v"(pX0));
  pv_reads<3>(tb, vb); PVW(8); pv_mma(o[2], ta, pa0, pa1, pa2, pa3); sm_exp<6, 12>(pX0); asm volatile("" : "+v"(pX0));
  PVW(0); pv_mma(o[3], tb, pa0, pa1, pa2, pa3); sm_exp<12, 16>(pX0); asm volatile("" : "+v"(pX0));
}
__device__ __forceinline__ void pv_d02(f32x16 (&o)[4], int vb, bf16x8 pa0, bf16x8 pa1, bf16x8 pa2, bf16x8 pa3) {
  s16x4 ta[8], tb[8];
  pv_reads<0>(ta, vb);
  pv_reads<1>(tb, vb); PVW(8); pv_mma(o[0], ta, pa0, pa1, pa2, pa3);
  pv_reads<2>(ta, vb); PVW(8); pv_mma(o[1], tb, pa0, pa1, pa2, pa3);
  pv_reads<3>(tb, vb); PVW(8); pv_mma(o[2], ta, pa0, pa1, pa2, pa3);
  PVW(0); pv_mma(o[3], tb, pa0, pa1, pa2, pa3);
}
__device__ __forceinline__ int krow(int j, int b) { return j < 256 ? b * SEQ + 64 * j : M_LAT + b * CTXL + 64 * (j - 256); }

__device__ __forceinline__ void attn_unit(const bf16* __restrict__ Qb, const bf16* __restrict__ KNh, const bf16* __restrict__ KPE, const bf16* __restrict__ Vh, bf16* __restrict__ Ob, int b, LAS char* lds) {
  int tid_l = threadIdx.x; asm volatile("" : "+v"(tid_l));
  const int tid = tid_l, wid = __builtin_amdgcn_readfirstlane(tid >> 6), lane = tid & 63, r32 = lane & 31, hi = lane >> 5;
  LAS char* V_lds = lds; LAS char* K_lds = lds + ATT_OFF_K;
  LAS float* wsf = (LAS float*)(lds + ATT_OFF_WS) + wid * 64; LAS float* li_l = wsf; LAS float* al_l = wsf + 32;
  LAS char* ost = lds + ATT_OFF_OST + wid * 8192;
  LAS char* qpe = lds + ATT_OFF_QPE + wid * ((12 - NQR) * 1024) + lane * 16;
  float m_reg = -1e30f, l_reg = 0; f32x16 o[4] = {}; bf16x8 qr[NQR];
  const bf16* Qw = Qb + (size_t)(wid * 32 + r32) * 3072 + hi * 8;
#pragma unroll
  for (int d0 = 0; d0 < NQR; ++d0) qr[d0] = *reinterpret_cast<const bf16x8*>(Qw + d0 * 16);
#pragma unroll
  for (int d0 = NQR; d0 < 12; ++d0) *reinterpret_cast<LAS bf16x8*>(qpe + (d0 - NQR) * 1024) = *reinterpret_cast<const bf16x8*>(Qw + d0 * 16);
  const int sr = tid >> 4, sc = (tid & 15) * 8, vst0 = v_st(sr, sc), vst1 = v_st(32 + sr, sc);
  const int khalf = lane & 1, krl = (lane >> 1) & 3, kc8 = (lane >> 3) & 7, kswz = wid & 1;
  const int krow0 = 8 * wid + krl, krow1 = krow0 + 4, kcol = kc8 * 16 + khalf * 8;
  const int kst0 = kc8 * 2048 + krow0 * 32 + ((khalf ^ kswz) * 16), kst1 = kst0 + 128;
  const int prow = 8 * wid + 4 * (lane >> 5) + krl, pcol = ((lane >> 3) & 3) * 16 + khalf * 8, kst2 = (8 + ((lane >> 3) & 3)) * 2048 + prow * 32 + ((khalf ^ kswz) * 16);
  const LAS char* krd = K_lds + r32 * 32 + ((hi ^ ((r32 >> 3) & 1)) * 16);
  const int vb0 = (int)(unsigned)(uintptr_t)V_lds + v_rd_base(lane);
  bf16x8 vs0, vs1, ks0, ks1, kp;
  const unsigned ovs0 = (unsigned)(sr * D + sc) * 2u, okn0 = (unsigned)(krow0 * D + kcol) * 2u, okp = (unsigned)(prow * 64 + pcol) * 2u;
#define SLOAD(j) do { const unsigned rb_ = (unsigned)krow((j), b), rv_ = rb_ * (unsigned)(D * 2), rp_ = rb_ * 128u; \
    vs0 = *reinterpret_cast<const bf16x8*>(reinterpret_cast<const char*>(Vh) + (size_t)(rv_ + ovs0)); vs1 = *reinterpret_cast<const bf16x8*>(reinterpret_cast<const char*>(Vh) + (size_t)(rv_ + ovs0 + 32u * D * 2u)); \
    ks0 = *reinterpret_cast<const bf16x8*>(reinterpret_cast<const char*>(KNh) + (size_t)(rv_ + okn0)); ks1 = *reinterpret_cast<const bf16x8*>(reinterpret_cast<const char*>(KNh) + (size_t)(rv_ + okn0 + 4u * D * 2u)); \
    kp = *reinterpret_cast<const bf16x8*>(reinterpret_cast<const char*>(KPE) + (size_t)(rp_ + okp)); } while (0)
#define SWRITE(bb) do { *(LAS bf16x8*)(V_lds + (bb) * ATT_SHM_V + vst0) = vs0; *(LAS bf16x8*)(V_lds + (bb) * ATT_SHM_V + vst1) = vs1; \
    *(LAS bf16x8*)(K_lds + (bb) * ATT_SHM_K + kst0) = ks0; *(LAS bf16x8*)(K_lds + (bb) * ATT_SHM_K + kst1) = ks1; *(LAS bf16x8*)(K_lds + (bb) * ATT_SHM_K + kst2) = kp; } while (0)
#define SWAIT() asm volatile("s_waitcnt vmcnt(0)" ::: "memory")
#define RESC(a) do { if (__any((a) < 1.f)) { if (hi == 0) al_l[r32] = (a); asm volatile("s_waitcnt lgkmcnt(0)" ::: "memory"); \
    _Pragma("unroll") for (int d = 0; d < 4; ++d) _Pragma("unroll") for (int r = 0; r < 16; ++r) o[d][r] *= al_l[crow(r, hi)]; } } while (0)
  f32x16 pA0, pA1, pB0, pB1; float alA, alB; bf16x8 pa0, pa1, pa2, pa3;
  SLOAD(0); SWAIT(); SWRITE(0); __syncthreads();
  qkt<NQR>(pA0, pA1, krd, qr, qpe); partialSM(pA0, pA1, m_reg, alA);
  SLOAD(1);
  SWAIT(); SWRITE(1); __syncthreads();
  for (int j = 1; j + 1 < NT; j += 2) {
    SBAR(); qkt<NQR>(pB0, pB1, krd + ATT_SHM_K, qr, qpe);
    finishSM(pA0, pA1, alA, l_reg, pa0, pa1, pa2, pa3); SBAR();
    SLOAD(j + 1); SBAR();
    pv_sm(o, vb0, pa0, pa1, pa2, pa3, pB0, pB1, m_reg, alB);
    __syncthreads(); SWAIT(); SWRITE(0);
    RESC(alB); __syncthreads();
    SBAR(); qkt<NQR>(pA0, pA1, krd, qr, qpe);
    finishSM(pB0, pB1, alB, l_reg, pa0, pa1, pa2, pa3); SBAR();
    SLOAD(j + 2); SBAR();
    pv_sm(o, vb0 + ATT_SHM_V, pa0, pa1, pa2, pa3, pA0, pA1, m_reg, alA);
    __syncthreads(); SWAIT(); SWRITE(1);
    RESC(alA); __syncthreads();
  }
  SBAR(); qkt<NQR>(pB0, pB1, krd + ATT_SHM_K, qr, qpe);
  finishSM(pA0, pA1, alA, l_reg, pa0, pa1, pa2, pa3); SBAR();
  pv_sm(o, vb0, pa0, pa1, pa2, pa3, pB0, pB1, m_reg, alB);
  __syncthreads(); RESC(alB);
  finishSM(pB0, pB1, alB, l_reg, pa0, pa1, pa2, pa3); SBAR();
  pv_d0(o, vb0 + ATT_SHM_V, pa0, pa1, pa2, pa3);
  __syncthreads();
  if (hi == 0) li_l[r32] = l_reg; asm volatile("s_waitcnt lgkmcnt(0)" ::: "memory");
#pragma unroll
  for (int r = 0; r < 16; ++r) { const int orow = crow(r, hi); const float rl = __builtin_amdgcn_rcpf(li_l[orow]);
#pragma unroll
    for (int d0 = 0; d0 < 4; ++d0) *(LAS unsigned short*)(ost + orow * 256 + (d0 * 32 + r32) * 2) = (unsigned short)f2bf(o[d0][r] * rl); }
  asm volatile("s_waitcnt lgkmcnt(0)" ::: "memory");
#pragma unroll
  for (int i = 0; i < 8; ++i) { const int gidx = i * 64 + lane, row = gidx >> 4, cg = gidx & 15;
    const v4u v = *(const LAS v4u*)(ost + row * 256 + cg * 16);
    *(GAS v4u*)(Ob + (size_t)(wid * 32 + row) * D + cg * 8) = v; }
  __syncthreads();
#undef SLOAD
#undef SWRITE
#undef SWAIT
#undef RESC
}

#ifndef ATT_KDEPTH
#define ATT_KDEPTH 2
#endif
#ifndef ATT_EARLYTR
#define ATT_EARLYTR 0
#endif
#ifndef ATT_QKPIPE
#define ATT_QKPIPE 1
#endif
#ifndef ATT_PVPIPE
#define ATT_PVPIPE 1
#endif
#if ATT_PVPIPE
#define PVSM pv_sm2
#define PVD0 pv_d02
#else
#define PVSM pv_sm
#define PVD0 pv_d0
#endif
constexpr int DBUF = 40960, DOFF_K = 16384, DOFF_WS = 3 * DBUF, DOFF_QPE = DOFF_WS + NWAVES * 256, NQD = ATT_NQD;
static_assert(DOFF_QPE + NWAVES * (12 - NQD) * 1024 <= MISC_OFF, "attention (DMA variant) LDS map");

template <int S> __device__ __forceinline__ pg8::f32x4 sub_get(const f32x16& v) { return __builtin_shufflevector(v, v, 4 * S, 4 * S + 1, 4 * S + 2, 4 * S + 3); }
template <int S> __device__ __forceinline__ void sub_put(f32x16& v, pg8::f32x4 x) {
  const f32x16 w = __builtin_shufflevector(x, x, 0, 1, 2, 3, -1, -1, -1, -1, -1, -1, -1, -1, -1, -1, -1, -1);
  if constexpr (S == 0) v = __builtin_shufflevector(v, w, 16, 17, 18, 19, 4, 5, 6, 7, 8, 9, 10, 11, 12, 13, 14, 15);
  else if constexpr (S == 1) v = __builtin_shufflevector(v, w, 0, 1, 2, 3, 16, 17, 18, 19, 8, 9, 10, 11, 12, 13, 14, 15);
  else if constexpr (S == 2) v = __builtin_shufflevector(v, w, 0, 1, 2, 3, 4, 5, 6, 7, 16, 17, 18, 19, 12, 13, 14, 15);
  else v = __builtin_shufflevector(v, w, 0, 1, 2, 3, 4, 5, 6, 7, 8, 9, 10, 11, 16, 17, 18, 19);
}
#define M16(v, S, A, B) sub_put<S>(v, __builtin_amdgcn_mfma_f32_16x16x32_bf16(A, B, sub_get<S>(v), 0, 0, 0))
#define MKREAD(a, b, d0) asm volatile("ds_read_b128 %0, %2 offset:%3\n\tds_read_b128 %1, %2 offset:%4" : "=&v"(a), "=&v"(b) : "v"(kaddr), "i"((d0) * 2048), "i"((d0) * 2048 + 1024))
#define MKWAIT(n, a, b) asm volatile("s_waitcnt lgkmcnt(" #n ")" : "+v"(a), "+v"(b))
__device__ __forceinline__ void qkt16_mock(f32x16& p0, f32x16& p1, int kaddr, const bf16x8 (&qr)[12], const f32x16& cinit) {
  p0 = cinit; p1 = cinit;
  bf16x8 ka0, ka1, kb0, kb1;
  MKREAD(ka0, ka1, 0);
#pragma unroll
  for (int d0 = 0; d0 < 12; d0 += 2) {
    MKREAD(kb0, kb1, d0 + 1); MKWAIT(2, ka0, ka1);
    M16(p0, 0, ka0, qr[d0 % 6]); M16(p0, 1, ka1, qr[d0 % 6]); M16(p1, 0, ka0, qr[(d0 + 1) % 6]); M16(p1, 1, ka1, qr[(d0 + 1) % 6]);
    if (d0 + 2 < 12) { MKREAD(ka0, ka1, d0 + 2); MKWAIT(2, kb0, kb1); } else { MKWAIT(0, kb0, kb1); }
    M16(p0, 2, kb0, qr[(d0 + 1) % 6]); M16(p0, 3, kb1, qr[(d0 + 1) % 6]); M16(p1, 2, kb0, qr[d0 % 6]); M16(p1, 3, kb1, qr[d0 % 6]);
  }
}
#undef MKREAD
#undef MKWAIT
__device__ __forceinline__ void pv_mma16_mock(f32x16& od, const s16x4 (&t)[8], bf16x8 pa0, bf16x8 pa1, bf16x8 pa2, bf16x8 pa3) {
#define PK(L, H) (bf16x8){L[0], L[1], L[2], L[3], H[0], H[1], H[2], H[3]}
  M16(od, 0, pa0, PK(t[0], t[1])); M16(od, 1, pa0, PK(t[0], t[1])); M16(od, 2, pa1, PK(t[2], t[3])); M16(od, 3, pa1, PK(t[2], t[3]));
  M16(od, 0, pa2, PK(t[4], t[5])); M16(od, 1, pa2, PK(t[4], t[5])); M16(od, 2, pa3, PK(t[6], t[7])); M16(od, 3, pa3, PK(t[6], t[7]));
#undef PK
}
#undef M16
__device__ __forceinline__ void pv_sm4_mock(f32x16 (&o)[4], int vb, bf16x8 pa0, bf16x8 pa1, bf16x8 pa2, bf16x8 pa3, f32x16& pX0, f32x16& pX1, float& m_reg, float& alpha, f32x16& negm) {
  s16x4 ta[8], tb[8];
  pv_reads<0>(ta, vb);
  pv_reads<1>(tb, vb); PVW(8); pv_mma16_mock(o[0], ta, pa0, pa1, pa2, pa3); float pm = sm_rowmax(pX0, pX1); asm volatile("" : "+v"(pm));
  pv_reads<2>(ta, vb); PVW(8); pv_mma16_mock(o[1], tb, pa0, pa1, pa2, pa3); sm_grow(pm, pX0, pX1, m_reg, alpha, negm); sm_exp<0, 6>(pX0); asm volatile("" : "+v"(pX0));
  pv_reads<3>(tb, vb); PVW(8); pv_mma16_mock(o[2], ta, pa0, pa1, pa2, pa3); sm_exp<6, 12>(pX0); asm volatile("" : "+v"(pX0));
  PVW(0); pv_mma16_mock(o[3], tb, pa0, pa1, pa2, pa3); sm_exp<12, 16>(pX0); asm volatile("" : "+v"(pX0));
}
__device__ __forceinline__ void fsm_raw(f32x16& p0, f32x16& p1, bf16x8& pa0, bf16x8& pa1, bf16x8& pa2, bf16x8& pa3) {
  v4u w0 = {__float_as_uint(p0[0]), __float_as_uint(p0[1]), __float_as_uint(p0[2]), __float_as_uint(p0[3])}, w1 = {__float_as_uint(p0[8]), __float_as_uint(p0[9]), __float_as_uint(p0[10]), __float_as_uint(p0[15])};
  v4u w2 = {__float_as_uint(p1[0]), __float_as_uint(p1[1]), __float_as_uint(p1[2]), __float_as_uint(p1[3])}, w3 = {__float_as_uint(p1[8]), __float_as_uint(p1[9]), __float_as_uint(p1[10]), __float_as_uint(p1[15])};
  pa0 = *reinterpret_cast<bf16x8*>(&w0); pa1 = *reinterpret_cast<bf16x8*>(&w1); pa2 = *reinterpret_cast<bf16x8*>(&w2); pa3 = *reinterpret_cast<bf16x8*>(&w3);
}
__device__ __forceinline__ void qkt_noread(f32x16& p0, f32x16& p1, const bf16x8 (&qr)[12], const f32x16& cinit) {
  p0 = cinit; p1 = cinit;
#pragma unroll
  for (int d0 = 0; d0 < 12; ++d0) { p0 = __builtin_amdgcn_mfma_f32_32x32x16_bf16(qr[(d0 + 1) % 12], qr[d0], p0, 0, 0, 0); p1 = __builtin_amdgcn_mfma_f32_32x32x16_bf16(qr[(d0 + 2) % 12], qr[d0], p1, 0, 0, 0); }
}
__device__ __forceinline__ void qkt_nomma(f32x16& p0, f32x16& p1, int kaddr, const bf16x8 (&qr)[12], const f32x16& cinit) {
  p0 = cinit; p1 = cinit;
#pragma unroll
  for (int d0 = 0; d0 < 12; ++d0) { bf16x8 a, b2;
    asm volatile("ds_read_b128 %0, %2 offset:%3\n\tds_read_b128 %1, %2 offset:%4\n\ts_waitcnt lgkmcnt(0)" : "=&v"(a), "=&v"(b2) : "v"(kaddr), "i"(d0 * 2048), "i"(d0 * 2048 + 1024));
    p0[d0] += (float)a[0]; p1[d0] += (float)b2[0]; }
}
__device__ __forceinline__ void pv_sm4_noread(f32x16 (&o)[4], bf16x8 pa0, bf16x8 pa1, bf16x8 pa2, bf16x8 pa3, f32x16& pX0, f32x16& pX1, float& m_reg, float& alpha, f32x16& negm) {
#define PVM(od) do { od = __builtin_amdgcn_mfma_f32_32x32x16_bf16(pa0, pa1, od, 0, 0, 0); od = __builtin_amdgcn_mfma_f32_32x32x16_bf16(pa1, pa2, od, 0, 0, 0); od = __builtin_amdgcn_mfma_f32_32x32x16_bf16(pa2, pa3, od, 0, 0, 0); od = __builtin_amdgcn_mfma_f32_32x32x16_bf16(pa3, pa0, od, 0, 0, 0); } while (0)
  PVM(o[0]); float pm = sm_rowmax(pX0, pX1); asm volatile("" : "+v"(pm));
  PVM(o[1]); sm_grow(pm, pX0, pX1, m_reg, alpha, negm); sm_exp<0, 6>(pX0); asm volatile("" : "+v"(pX0));
  PVM(o[2]); sm_exp<6, 12>(pX0); asm volatile("" : "+v"(pX0));
  PVM(o[3]); sm_exp<12, 16>(pX0); asm volatile("" : "+v"(pX0));
#undef PVM
}
template <int ABL = 0> __device__ __forceinline__ void attn_unit_dma(const bf16* __restrict__ Qb, const bf16* __restrict__ KNh, const bf16* __restrict__ KPE, const bf16* __restrict__ Vh, bf16* __restrict__ Ob, int b, LAS char* lds) {
  int tid_l = threadIdx.x; asm volatile("" : "+v"(tid_l));
  const int tid = tid_l, wid = __builtin_amdgcn_readfirstlane(tid >> 6), lane = tid & 63, r32 = lane & 31, hi = lane >> 5;
  LAS float* wsf = (LAS float*)(lds + DOFF_WS) + wid * 64; LAS float* li_l = wsf; LAS float* al_l = wsf + 32;
  LAS char* ost = lds + wid * 8192;
  LAS char* qpe = lds + DOFF_QPE + wid * ((12 - NQD) * 1024) + lane * 16;
  float m_reg = -1e30f, l_reg = 0; f32x16 o[4] = {}; bf16x8 qr[NQD];
  const bf16* Qw = Qb + (size_t)(wid * 32 + r32) * 3072 + hi * 8;
#pragma unroll
  for (int d0 = 0; d0 < NQD; ++d0) qr[d0] = *reinterpret_cast<const bf16x8*>(Qw + d0 * 16);
#pragma unroll
  for (int d0 = NQD; d0 < 12; ++d0) *reinterpret_cast<LAS bf16x8*>(qpe + (d0 - NQD) * 1024) = *reinterpret_cast<const bf16x8*>(Qw + d0 * 16);
  unsigned ovs, okn, okp;
  { const int kk = 8 * (wid >> 1) + ((lane & 31) >> 2), k = (kk & ~0xC) | ((kk & 4) << 1) | ((kk & 8) >> 1), col = 32 * (2 * (wid & 1) + (lane >> 5)) + 8 * (lane & 3);
    ovs = (unsigned)(k * D + col) * 2u;
    const int row = 32 * (wid & 1) + (lane >> 1), half = (lane & 1) ^ ((row >> 3) & 1);
    okn = (unsigned)(row * D + (wid >> 1) * 16 + half * 8) * 2u; okp = (unsigned)(row * 64 + (wid >> 1) * 16 + half * 8) * 2u; }
  const int krd0 = r32 * 32 + ((hi ^ ((r32 >> 3) & 1)) * 16) + DOFF_K;
  const int vrd0 = (int)(unsigned)(uintptr_t)lds + v_rd_base(lane);
#define DMA_TILE(j, boff) do { const unsigned rb_ = (unsigned)krow((j), b), rv_ = rb_ * (unsigned)(D * 2), rp_ = rb_ * 128u; LAS char* d_ = lds + (boff) + wid * 1024; \
    __builtin_amdgcn_global_load_lds((const unsigned*)(reinterpret_cast<const char*>(Vh) + (size_t)(rv_ + ovs)), (LAS unsigned*)d_, 16, 0, 0); \
    __builtin_amdgcn_global_load_lds((const unsigned*)(reinterpret_cast<const char*>(Vh) + (size_t)(rv_ + ovs + 32u * D * 2u)), (LAS unsigned*)(d_ + 8192), 16, 0, 0); \
    __builtin_amdgcn_global_load_lds((const unsigned*)(reinterpret_cast<const char*>(KNh) + (size_t)(rv_ + okn)), (LAS unsigned*)(d_ + DOFF_K), 16, 0, 0); \
    __builtin_amdgcn_global_load_lds((const unsigned*)(reinterpret_cast<const char*>(KNh) + (size_t)(rv_ + okn + 128u)), (LAS unsigned*)(d_ + DOFF_K + 8192), 16, 0, 0); \
    __builtin_amdgcn_global_load_lds((const unsigned*)(reinterpret_cast<const char*>(KPE) + (size_t)(rp_ + okp)), (LAS unsigned*)(d_ + DOFF_K + 16384), 16, 0, 0); } while (0)
#if ATT_QKPIPE
#define QKT(x0, x1) do { if constexpr (ABL == 7) qkt16_mock(x0, x1, (int)(unsigned)(uintptr_t)lds + o_cur + krd0, qr, negm); else if constexpr (ABL == 2) qkt_noread(x0, x1, qr, negm); else if constexpr (ABL == 6) qkt_nomma(x0, x1, (int)(unsigned)(uintptr_t)lds + o_cur + krd0, qr, negm); else qkt2(x0, x1, (int)(unsigned)(uintptr_t)lds + o_cur + krd0, qr, negm); } while (0)
#else
#define QKT(x0, x1) qkt<NQD>(x0, x1, lds + o_cur + krd0, qr, qpe)
#endif
#if ATT_EARLYTR
#define EARLY_TR() pv_reads<0>(tr0, vrd0 + o_prev)
#define PVSM3(x0, x1, al) pv_sm5(o, vrd0 + o_prev, pa0, pa1, pa2, pa3, x0, x1, m_reg, al, negm, tr0)
#else
#define EARLY_TR() do { } while (0)
#define PVSM3(x0, x1, al) do { if constexpr (ABL == 7) pv_sm4_mock(o, vrd0 + o_prev, pa0, pa1, pa2, pa3, x0, x1, m_reg, al, negm); else if constexpr (ABL == 1) { al = 1.f; pv_d02(o, vrd0 + o_prev, pa0, pa1, pa2, pa3); } else if constexpr (ABL == 2) pv_sm4_noread(o, pa0, pa1, pa2, pa3, x0, x1, m_reg, al, negm); else pv_sm4(o, vrd0 + o_prev, pa0, pa1, pa2, pa3, x0, x1, m_reg, al, negm); } while (0)
#endif
#define TILE_BAR() do { if constexpr (ABL == 4) { asm volatile("s_waitcnt lgkmcnt(0)" ::: "memory"); } else { asm volatile("s_waitcnt vmcnt(0) lgkmcnt(0)" ::: "memory"); __builtin_amdgcn_s_barrier(); asm volatile("" ::: "memory"); } } while (0)
#define RESC(a) do { if (__any((a) < 1.f)) { if (hi == 0) al_l[r32] = (a); asm volatile("s_waitcnt lgkmcnt(0)" ::: "memory"); \
    _Pragma("unroll") for (int d = 0; d < 4; ++d) _Pragma("unroll") for (int r = 0; r < 16; ++r) o[d][r] *= al_l[crow(r, hi)]; } } while (0)
#define FSM(x0, x1, al) do { if constexpr (ABL == 1) fsm_raw(x0, x1, pa0, pa1, pa2, pa3); else finishSM(x0, x1, al, l_reg, pa0, pa1, pa2, pa3); } while (0)
#define ROT() do { const int t_ = o_prev; o_prev = o_cur; o_cur = o_next; o_next = t_; } while (0)
  f32x16 pA0, pA1, pB0, pB1; float alA, alB; bf16x8 pa0, pa1, pa2, pa3; s16x4 tr0[8];
  int o_prev = 2 * DBUF, o_cur = 0, o_next = DBUF;
  DMA_TILE(0, 0); DMA_TILE(1, DBUF);
  asm volatile("s_waitcnt vmcnt(5) lgkmcnt(0)" ::: "memory"); __builtin_amdgcn_s_barrier(); asm volatile("" ::: "memory");
  f32x16 negm = {};
  QKT(pA0, pA1);
  { const float pm0 = sm_rowmax(pA0, pA1); m_reg = pm0; alA = 1.f;
#pragma unroll
    for (int r = 0; r < 16; ++r) { pA0[r] -= pm0; pA1[r] -= pm0; negm[r] = -pm0; }
    sm_exp<0, 16>(pA0); }
  TILE_BAR(); DMA_TILE(2, 2 * DBUF); ROT();
  for (int j = 1; j + 1 < NT; j += 2) {
    SBAR(); QKT(pB0, pB1); EARLY_TR();
    FSM(pA0, pA1, alA); SBAR();
    PVSM3(pB0, pB1, alB);
    TILE_BAR(); if (ABL != 4 && j + 2 < NT) DMA_TILE(j + 2, o_prev); ROT();
    RESC(alB);
    SBAR(); QKT(pA0, pA1); EARLY_TR();
    FSM(pB0, pB1, alB); SBAR();
    PVSM3(pA0, pA1, alA);
    TILE_BAR(); if (ABL != 4 && j + 3 < NT) DMA_TILE(j + 3, o_prev); ROT();
    RESC(alA);
  }
  SBAR(); QKT(pB0, pB1); EARLY_TR();
  FSM(pA0, pA1, alA); SBAR();
  PVSM3(pB0, pB1, alB);
  RESC(alB);
  FSM(pB0, pB1, alB); SBAR();
  PVD0(o, vrd0 + o_cur, pa0, pa1, pa2, pa3);
  TILE_BAR();
  if (hi == 0) li_l[r32] = l_reg; asm volatile("s_waitcnt lgkmcnt(0)" ::: "memory");
#pragma unroll
  for (int r = 0; r < 16; ++r) { const int orow = crow(r, hi); const float rl = __builtin_amdgcn_rcpf(li_l[orow]);
#pragma unroll
    for (int d0 = 0; d0 < 4; ++d0) *(LAS unsigned short*)(ost + orow * 256 + (d0 * 32 + r32) * 2) = (unsigned short)f2bf(o[d0][r] * rl); }
  asm volatile("s_waitcnt lgkmcnt(0)" ::: "memory");
#pragma unroll
  for (int i = 0; i < 8; ++i) { const int gidx = i * 64 + lane, row = gidx >> 4, cg = gidx & 15;
    const v4u v = *(const LAS v4u*)(ost + row * 256 + cg * 16);
    *(GAS v4u*)(Ob + (size_t)(wid * 32 + row) * D + cg * 8) = v; }
  TILE_BAR();
#undef DMA_TILE
#undef EARLY_TR
#undef PVSM3
#undef QKT
#undef TILE_BAR
#undef RESC
#undef ROT
#undef FSM
}

constexpr int PP_VB = 16384, PP_KB = 24576, PP_KRING = 3 * PP_VB;
static_assert(PP_KRING + 3 * PP_KB <= DOFF_WS, "attention (ping-pong variant) LDS map");
__device__ __forceinline__ void attn_unit_pp(const bf16* __restrict__ Qb, const bf16* __restrict__ KNh, const bf16* __restrict__ KPE, const bf16* __restrict__ Vh, bf16* __restrict__ Ob, int b, LAS char* lds, int hot = 0) {
  int tid_l = threadIdx.x; asm volatile("" : "+v"(tid_l));
  const int tid = tid_l, wid = __builtin_amdgcn_readfirstlane(tid >> 6), lane = tid & 63, r32 = lane & 31, hi = lane >> 5;
  const bool late = wid >= 4;
  LAS float* wsf = (LAS float*)(lds + DOFF_WS) + wid * 64; LAS float* li_l = wsf; LAS float* al_l = wsf + 32;
  LAS char* ost = lds + wid * 8192;
  float m_reg = -1e30f, l_reg = 0; f32x16 o[4] = {}; bf16x8 qr[12];
  const bf16* Qw = Qb + (size_t)(wid * 32 + r32) * 3072 + hi * 8;
#pragma unroll
  for (int d0 = 0; d0 < 12; ++d0) qr[d0] = *reinterpret_cast<const bf16x8*>(Qw + d0 * 16);
  unsigned ovs, okn, okp;
  { const int kk = 8 * (wid >> 1) + ((lane & 31) >> 2), k = (kk & ~0xC) | ((kk & 4) << 1) | ((kk & 8) >> 1), col = 32 * (2 * (wid & 1) + (lane >> 5)) + 8 * (lane & 3);
    ovs = (unsigned)(k * D + col) * 2u;
    const int row = 32 * (wid & 1) + (lane >> 1), half = (lane & 1) ^ ((row >> 3) & 1);
    okn = (unsigned)(row * D + (wid >> 1) * 16 + half * 8) * 2u; okp = (unsigned)(row * 64 + (wid >> 1) * 16 + half * 8) * 2u; }
  const int krd0 = (int)(unsigned)(uintptr_t)lds + r32 * 32 + ((hi ^ ((r32 >> 3) & 1)) * 16) + PP_KRING;
  const int vrd0 = (int)(unsigned)(uintptr_t)lds + v_rd_base(lane);
#define DMA_V(j, voff) do { const unsigned rv_ = (unsigned)krow(hot ? ((j) & 3) : (j), b) * (unsigned)(D * 2); LAS char* d_ = lds + (voff) + wid * 1024; \
    __builtin_amdgcn_global_load_lds((const unsigned*)(reinterpret_cast<const char*>(Vh) + (size_t)(rv_ + ovs)), (LAS unsigned*)d_, 16, 0, 0); \
    __builtin_amdgcn_global_load_lds((const unsigned*)(reinterpret_cast<const char*>(Vh) + (size_t)(rv_ + ovs + 32u * D * 2u)), (LAS unsigned*)(d_ + 8192), 16, 0, 0); } while (0)
#define DMA_K(j, koff) do { const unsigned rb_ = (unsigned)krow(hot ? ((j) & 3) : (j), b), rv_ = rb_ * (unsigned)(D * 2), rp_ = rb_ * 128u; LAS char* d_ = lds + PP_KRING + (koff) + wid * 1024; \
    __builtin_amdgcn_global_load_lds((const unsigned*)(reinterpret_cast<const char*>(KNh) + (size_t)(rv_ + okn)), (LAS unsigned*)d_, 16, 0, 0); \
    __builtin_amdgcn_global_load_lds((const unsigned*)(reinterpret_cast<const char*>(KNh) + (size_t)(rv_ + okn + 128u)), (LAS unsigned*)(d_ + 8192), 16, 0, 0); \
    __builtin_amdgcn_global_load_lds((const unsigned*)(reinterpret_cast<const char*>(KPE) + (size_t)(rp_ + okp)), (LAS unsigned*)(d_ + 16384), 16, 0, 0); } while (0)
#define QKT(x0, x1) qkt2(x0, x1, krd0 + k_cur, qr, negm)
#define PVSM3(x0, x1, al) pv_sm4(o, vrd0 + v_prev, pa0, pa1, pa2, pa3, x0, x1, m_reg, al, negm)
#define HBAR(n) do { asm volatile("s_waitcnt vmcnt(" #n ") lgkmcnt(0)" ::: "memory"); __builtin_amdgcn_s_barrier(); asm volatile("" ::: "memory"); } while (0)
#define RESC(a) do { if (__any((a) < 1.f)) { if (hi == 0) al_l[r32] = (a); asm volatile("s_waitcnt lgkmcnt(0)" ::: "memory"); \
    _Pragma("unroll") for (int d = 0; d < 4; ++d) _Pragma("unroll") for (int r = 0; r < 16; ++r) o[d][r] *= al_l[crow(r, hi)]; } } while (0)
#define ROTK() do { const int t_ = k_prev; k_prev = k_cur; k_cur = k_next; k_next = t_; } while (0)
#define ROTV() do { const int t_ = v_prev; v_prev = v_cur; v_cur = v_next; v_next = t_; } while (0)
  f32x16 pA0, pA1, pB0, pB1; float alA, alB; bf16x8 pa0, pa1, pa2, pa3;
  int k_prev = 2 * PP_KB, k_cur = 0, k_next = PP_KB, v_prev = 2 * PP_VB, v_cur = 0, v_next = PP_VB;
  DMA_K(0, 0); DMA_K(1, PP_KB);
  HBAR(3);
  if (late) { __builtin_amdgcn_s_barrier(); asm volatile("" ::: "memory"); }
  f32x16 negm = {};
  DMA_V(0, v_cur); DMA_K(2, k_prev); SBAR();
  QKT(pA0, pA1);
  HBAR(5); ROTK();
  { const float pm0 = sm_rowmax(pA0, pA1); m_reg = pm0; alA = 1.f;
#pragma unroll
    for (int r = 0; r < 16; ++r) { pA0[r] -= pm0; pA1[r] -= pm0; negm[r] = -pm0; }
    sm_exp<0, 16>(pA0); }
  HBAR(3); ROTV();
  for (int j = 1; j + 1 < NT; j += 2) {
    DMA_V(j, v_cur); DMA_K(j + 2 < NT ? j + 2 : NT - 1, k_prev); SBAR();
    QKT(pB0, pB1);
    finishSM(pA0, pA1, alA, l_reg, pa0, pa1, pa2, pa3); SBAR();
    HBAR(5); ROTK();
    PVSM3(pB0, pB1, alB);
    HBAR(3); ROTV();
    RESC(alB);
    DMA_V(j + 1, v_cur); DMA_K(j + 3 < NT ? j + 3 : NT - 1, k_prev); SBAR();
    QKT(pA0, pA1);
    finishSM(pB0, pB1, alB, l_reg, pa0, pa1, pa2, pa3); SBAR();
    HBAR(5); ROTK();
    PVSM3(pA0, pA1, alA);
    HBAR(3); ROTV();
    RESC(alA);
  }
  DMA_V(NT - 1, v_cur); SBAR();
  QKT(pB0, pB1);
  finishSM(pA0, pA1, alA, l_reg, pa0, pa1, pa2, pa3); SBAR();
  HBAR(0); ROTK();
  PVSM3(pB0, pB1, alB);
  HBAR(0); ROTV();
  RESC(alB);
  finishSM(pB0, pB1, alB, l_reg, pa0, pa1, pa2, pa3); SBAR();
  HBAR(0);
  pv_d02(o, vrd0 + v_prev, pa0, pa1, pa2, pa3);
  HBAR(0);
  if (!late) { __builtin_amdgcn_s_barrier(); asm volatile("" ::: "memory"); }
  if (hi == 0) li_l[r32] = l_reg; asm volatile("s_waitcnt lgkmcnt(0)" ::: "memory");
#pragma unroll
  for (int r = 0; r < 16; ++r) { const int orow = crow(r, hi); const float rl = __builtin_amdgcn_rcpf(li_l[orow]);
#pragma unroll
    for (int d0 = 0; d0 < 4; ++d0) *(LAS unsigned short*)(ost + orow * 256 + (d0 * 32 + r32) * 2) = (unsigned short)f2bf(o[d0][r] * rl); }
  asm volatile("s_waitcnt lgkmcnt(0)" ::: "memory");
#pragma unroll
  for (int i = 0; i < 8; ++i) { const int gidx = i * 64 + lane, row = gidx >> 4, cg = gidx & 15;
    const v4u v = *(const LAS v4u*)(ost + row * 256 + cg * 16);
    *(GAS v4u*)(Ob + (size_t)(wid * 32 + row) * D + cg * 8) = v; }
  HBAR(0);
#undef DMA_V
#undef DMA_K
#undef QKT
#undef PVSM3
#undef HBAR
#undef RESC
#undef ROTK
#undef ROTV
}

struct S16 { pg8::f32x4 a[4][2]; };
#define K16READ(a, b, d) asm volatile("ds_read_b128 %0, %2 offset:%3\n\tds_read_b128 %1, %2 offset:%4" : "=&v"(a), "=&v"(b) : "v"(kaddr), "i"(((d) >> 1) * 4096 + ((d) & 1) * 2048), "i"(((d) >> 1) * 4096 + ((d) & 1) * 2048 + 1024))
#define K16WAIT(n, a, b) asm volatile("s_waitcnt lgkmcnt(" #n ")" : "+v"(a), "+v"(b))
#define MF16(A, B, C) __builtin_amdgcn_mfma_f32_16x16x32_bf16(A, B, C, 0, 0, 0)
__device__ __forceinline__ void qkt16(S16& p, int kaddr, const bf16x8 (&qr)[6][2], const pg8::f32x4 (&negm)[2]) {
#pragma unroll
  for (int kb = 0; kb < 4; ++kb) { p.a[kb][0] = negm[0]; p.a[kb][1] = negm[1]; }
  bf16x8 ka0, ka1, kb0, kb1, kc0, kc1;
  K16READ(ka0, ka1, 0); K16READ(kb0, kb1, 1);
#define K16STEP(x0, x1, d) do { if ((d) + 2 < 12) { K16WAIT(4, x0, x1); } else if ((d) + 1 < 12) { K16WAIT(2, x0, x1); } else { K16WAIT(0, x0, x1); } \
    p.a[2 * ((d) & 1)][0] = MF16(x0, qr[(d) >> 1][0], p.a[2 * ((d) & 1)][0]); p.a[2 * ((d) & 1)][1] = MF16(x0, qr[(d) >> 1][1], p.a[2 * ((d) & 1)][1]); \
    p.a[2 * ((d) & 1) + 1][0] = MF16(x1, qr[(d) >> 1][0], p.a[2 * ((d) & 1) + 1][0]); p.a[2 * ((d) & 1) + 1][1] = MF16(x1, qr[(d) >> 1][1], p.a[2 * ((d) & 1) + 1][1]); } while (0)
#pragma unroll
  for (int d0 = 0; d0 < 12; d0 += 3) {
    K16READ(kc0, kc1, d0 + 2); K16STEP(ka0, ka1, d0);
    if (d0 + 3 < 12) K16READ(ka0, ka1, d0 + 3);
    K16STEP(kb0, kb1, d0 + 1);
    if (d0 + 4 < 12) K16READ(kb0, kb1, d0 + 4);
    K16STEP(kc0, kc1, d0 + 2);
  }
#undef K16STEP
}
#undef K16READ
#undef K16WAIT
__device__ __forceinline__ void sm16_pmax(const S16& p, float (&pm)[2]) {
#pragma unroll
  for (int qb = 0; qb < 2; ++qb) { float m = p.a[0][qb][0];
#pragma unroll
    for (int kb = 0; kb < 4; ++kb)
#pragma unroll
      for (int i = 0; i < 4; ++i) if (kb | i) m = fmaxf(m, p.a[kb][qb][i]);
    pm[qb] = m; }
}
__device__ __forceinline__ float rowmax4(float v) {
  auto a = __builtin_amdgcn_permlane16_swap(__float_as_uint(v), __float_as_uint(v), false, false); const float m = fmaxf(__uint_as_float(a[0]), __uint_as_float(a[1]));
  auto c = __builtin_amdgcn_permlane32_swap(__float_as_uint(m), __float_as_uint(m), false, false); return fmaxf(__uint_as_float(c[0]), __uint_as_float(c[1])); }
__device__ __forceinline__ float rowsum4(float v) {
  auto a = __builtin_amdgcn_permlane16_swap(__float_as_uint(v), __float_as_uint(v), false, false); const float m = __uint_as_float(a[0]) + __uint_as_float(a[1]);
  auto c = __builtin_amdgcn_permlane32_swap(__float_as_uint(m), __float_as_uint(m), false, false); return __uint_as_float(c[0]) + __uint_as_float(c[1]); }
__device__ __forceinline__ void sm16_grow(const float (&pm)[2], S16& p, float (&m_reg)[2], float (&alpha)[2], pg8::f32x4 (&negm)[2]) {
  alpha[0] = 1.f; alpha[1] = 1.f;
  if (__any((pm[0] > THRL) || (pm[1] > THRL))) {
#pragma unroll
    for (int qb = 0; qb < 2; ++qb) { const float r = rowmax4(pm[qb]); const float dl = (r > THRL) ? r : 0.f;
#pragma unroll
      for (int kb = 0; kb < 4; ++kb)
#pragma unroll
        for (int i = 0; i < 4; ++i) p.a[kb][qb][i] -= dl;
      m_reg[qb] += dl; alpha[qb] = __builtin_amdgcn_exp2f(-dl); const float nm = -m_reg[qb]; negm[qb] = (pg8::f32x4){nm, nm, nm, nm}; }
  }
}
template <int KB> __device__ __forceinline__ void sm16_exp(S16& p) {
#pragma unroll
  for (int qb = 0; qb < 2; ++qb)
#pragma unroll
    for (int i = 0; i < 4; ++i) p.a[KB][qb][i] = __builtin_amdgcn_exp2f(p.a[KB][qb][i]);
}
#define PIN16(p, KB) asm volatile("" : "+v"(p.a[KB][0]), "+v"(p.a[KB][1]))
__device__ __forceinline__ void finish16(S16& p, const float (&alpha)[2], float (&l_reg)[2], bf16x8 (&pa)[2][2]) {
  sm16_exp<2>(p); sm16_exp<3>(p);
#pragma unroll
  for (int qb = 0; qb < 2; ++qb) { float ps = 0;
#pragma unroll
    for (int kb = 0; kb < 4; ++kb)
#pragma unroll
      for (int i = 0; i < 4; ++i) ps += p.a[kb][qb][i];
    l_reg[qb] = l_reg[qb] * alpha[qb] + ps;
#pragma unroll
    for (int s = 0; s < 2; ++s) { const pg8::f32x4 lo = p.a[2 * s][qb], hi = p.a[2 * s + 1][qb];
      v4u w = {cvtpk(lo[0], lo[1]), cvtpk(lo[2], lo[3]), cvtpk(hi[0], hi[1]), cvtpk(hi[2], hi[3])}; pa[qb][s] = *reinterpret_cast<bf16x8*>(&w); } }
}
constexpr int v16_off(int s, int db, int hi) { return s * 8192 + hi * 4096 + db * 256; }
template <int DB> __device__ __forceinline__ void pv16_reads(s16x4 (&t)[4], int vb) {
  t[0] = tr_read<v16_off(0, DB, 0)>(vb); t[1] = tr_read<v16_off(0, DB, 1)>(vb); t[2] = tr_read<v16_off(1, DB, 0)>(vb); t[3] = tr_read<v16_off(1, DB, 1)>(vb);
}
template <int DB> __device__ __forceinline__ void pv16_mma(pg8::f32x4 (&o)[2][8], const s16x4 (&t)[4], const bf16x8 (&pa)[2][2]) {
#define PK(L, H) (bf16x8){L[0], L[1], L[2], L[3], H[0], H[1], H[2], H[3]}
  { const bf16x8 B = PK(t[0], t[1]); o[0][DB] = MF16(pa[0][0], B, o[0][DB]); o[1][DB] = MF16(pa[1][0], B, o[1][DB]); }
  { const bf16x8 B = PK(t[2], t[3]); o[0][DB] = MF16(pa[0][1], B, o[0][DB]); o[1][DB] = MF16(pa[1][1], B, o[1][DB]); }
#undef PK
}
__device__ __forceinline__ void pv16_sm(pg8::f32x4 (&o)[2][8], int vb, const bf16x8 (&pa)[2][2], S16& pX, float (&m_reg)[2], float (&alpha)[2], pg8::f32x4 (&negm)[2]) {
  s16x4 ta[4], tb[4]; float pm[2];
  pv16_reads<0>(ta, vb);
  pv16_reads<1>(tb, vb); PVW(4); pv16_mma<0>(o, ta, pa);
  pv16_reads<2>(ta, vb); PVW(4); pv16_mma<1>(o, tb, pa); sm16_pmax(pX, pm); asm volatile("" : "+v"(pm[0]), "+v"(pm[1]));
  pv16_reads<3>(tb, vb); PVW(4); pv16_mma<2>(o, ta, pa);
  pv16_reads<4>(ta, vb); PVW(4); pv16_mma<3>(o, tb, pa); sm16_grow(pm, pX, m_reg, alpha, negm); sm16_exp<0>(pX); PIN16(pX, 0);
  pv16_reads<5>(tb, vb); PVW(4); pv16_mma<4>(o, ta, pa);
  pv16_reads<6>(ta, vb); PVW(4); pv16_mma<5>(o, tb, pa); sm16_exp<1>(pX); PIN16(pX, 1);
  pv16_reads<7>(tb, vb); PVW(4); pv16_mma<6>(o, ta, pa);
  PVW(0); pv16_mma<7>(o, tb, pa);
}
__device__ __forceinline__ void pv16_d0(pg8::f32x4 (&o)[2][8], int vb, const bf16x8 (&pa)[2][2]) {
  s16x4 ta[4], tb[4];
  pv16_reads<0>(ta, vb);
  pv16_reads<1>(tb, vb); PVW(4); pv16_mma<0>(o, ta, pa);
  pv16_reads<2>(ta, vb); PVW(4); pv16_mma<1>(o, tb, pa);
  pv16_reads<3>(tb, vb); PVW(4); pv16_mma<2>(o, ta, pa);
  pv16_reads<4>(ta, vb); PVW(4); pv16_mma<3>(o, tb, pa);
  pv16_reads<5>(tb, vb); PVW(4); pv16_mma<4>(o, ta, pa);
  pv16_reads<6>(ta, vb); PVW(4); pv16_mma<5>(o, tb, pa);
  pv16_reads<7>(tb, vb); PVW(4); pv16_mma<6>(o, ta, pa);
  PVW(0); pv16_mma<7>(o, tb, pa);
}
__device__ __forceinline__ void sm16_sum(const S16& p, int qb, float alpha, float& l) { float ps = 0;
#pragma unroll
  for (int kb = 0; kb < 4; ++kb)
#pragma unroll
    for (int i = 0; i < 4; ++i) ps += p.a[kb][qb][i];
  l = l * alpha + ps; }
__device__ __forceinline__ void sm16_pack(const S16& p, bf16x8 (&pn)[2][2]) {
#pragma unroll
  for (int qb = 0; qb < 2; ++qb)
#pragma unroll
    for (int s = 0; s < 2; ++s) { const pg8::f32x4 lo = p.a[2 * s][qb], hi = p.a[2 * s + 1][qb];
      v4u w = {cvtpk(lo[0], lo[1]), cvtpk(lo[2], lo[3]), cvtpk(hi[0], hi[1]), cvtpk(hi[2], hi[3])}; pn[qb][s] = *reinterpret_cast<bf16x8*>(&w); }
}
__device__ __forceinline__ void pv16_smf(pg8::f32x4 (&o)[2][8], int vb, const bf16x8 (&pa)[2][2], S16& pX, float (&m_reg)[2], float (&alpha)[2], float (&l_reg)[2], pg8::f32x4 (&negm)[2], bf16x8 (&pn)[2][2]) {
  s16x4 ta[4], tb[4]; float pm[2];
  pv16_reads<0>(ta, vb);
  pv16_reads<1>(tb, vb); PVW(4); pv16_mma<0>(o, ta, pa); sm16_pmax(pX, pm); asm volatile("" : "+v"(pm[0]), "+v"(pm[1]));
  pv16_reads<2>(ta, vb); PVW(4); pv16_mma<1>(o, tb, pa); sm16_grow(pm, pX, m_reg, alpha, negm); sm16_exp<0>(pX); PIN16(pX, 0);
  pv16_reads<3>(tb, vb); PVW(4); pv16_mma<2>(o, ta, pa); sm16_exp<1>(pX); PIN16(pX, 1);
  pv16_reads<4>(ta, vb); PVW(4); pv16_mma<3>(o, tb, pa); sm16_exp<2>(pX); PIN16(pX, 2);
  pv16_reads<5>(tb, vb); PVW(4); pv16_mma<4>(o, ta, pa); sm16_exp<3>(pX); PIN16(pX, 3);
  pv16_reads<6>(ta, vb); PVW(4); pv16_mma<5>(o, tb, pa); sm16_sum(pX, 0, alpha[0], l_reg[0]); asm volatile("" : "+v"(l_reg[0]));
  pv16_reads<7>(tb, vb); PVW(4); pv16_mma<6>(o, ta, pa); sm16_sum(pX, 1, alpha[1], l_reg[1]); asm volatile("" : "+v"(l_reg[1]));
  PVW(0); pv16_mma<7>(o, tb, pa); sm16_pack(pX, pn);
}
#define K16R(a, b, ks, H) asm volatile("ds_read_b128 %0, %2 offset:%3\n\tds_read_b128 %1, %2 offset:%4" : "=&v"(a), "=&v"(b) : "v"(kaddr), "i"((ks) * 4096 + (H) * 2048), "i"((ks) * 4096 + (H) * 2048 + 1024))
#define K16W(n, a, b) asm volatile("s_waitcnt lgkmcnt(" #n ")" : "+v"(a), "+v"(b))
#define K16M(x0, x1, ks, H) do { p.a[2 * (H)][0] = MF16(x0, qr[ks][0], p.a[2 * (H)][0]); p.a[2 * (H)][1] = MF16(x0, qr[ks][1], p.a[2 * (H)][1]); \
    p.a[2 * (H) + 1][0] = MF16(x1, qr[ks][0], p.a[2 * (H) + 1][0]); p.a[2 * (H) + 1][1] = MF16(x1, qr[ks][1], p.a[2 * (H) + 1][1]); } while (0)
__device__ __forceinline__ float amax3(float a, float b, float c) { float r; asm("v_max3_f32 %0, %1, %2, %3" : "=v"(r) : "v"(a), "v"(b), "v"(c)); return r; }
__device__ __forceinline__ float amax2(float a, float b) { float r; asm("v_max_f32 %0, %1, %2" : "=v"(r) : "v"(a), "v"(b)); return r; }
template <int H> __device__ __forceinline__ void sm16_pmaxh(const S16& p, float (&pm)[2]) {
#pragma unroll
  for (int qb = 0; qb < 2; ++qb) { const pg8::f32x4 a = p.a[2 * H][qb], c = p.a[2 * H + 1][qb];
    float m = amax3(a[0], a[1], a[2]); m = amax3(m, a[3], c[0]); m = amax3(m, c[1], c[2]); pm[qb] = amax2(m, c[3]); }
}
__device__ __forceinline__ void sm16_grow_h0(const float (&pm)[2], S16& p, float (&m_reg)[2], float (&alpha)[2], pg8::f32x4 (&negm)[2]) {
  alpha[0] = 1.f; alpha[1] = 1.f;
  if (__any(amax2(pm[0], pm[1]) > THRL)) {
#pragma unroll
    for (int qb = 0; qb < 2; ++qb) { const float r = rowmax4(pm[qb]); const float dl = (r > THRL) ? r : 0.f;
#pragma unroll
      for (int kb = 0; kb < 4; ++kb)
#pragma unroll
        for (int i = 0; i < 4; ++i) p.a[kb][qb][i] -= dl;
      m_reg[qb] += dl; alpha[qb] = __builtin_amdgcn_exp2f(-dl); const float nm = -m_reg[qb]; negm[qb] = (pg8::f32x4){nm, nm, nm, nm}; }
  }
}
__device__ __forceinline__ void sm16_grow_h1(const float (&pm)[2], S16& p, float (&m_reg)[2], float (&alpha)[2], pg8::f32x4 (&negm)[2], float (&ps)[2]) {
  if (__any(amax2(pm[0], pm[1]) > THRL)) {
#pragma unroll
    for (int qb = 0; qb < 2; ++qb) { const float r = rowmax4(pm[qb]); const float dl = (r > THRL) ? r : 0.f; const float a2 = __builtin_amdgcn_exp2f(-dl);
#pragma unroll
      for (int i = 0; i < 4; ++i) { p.a[2][qb][i] -= dl; p.a[3][qb][i] -= dl; p.a[0][qb][i] *= a2; p.a[1][qb][i] *= a2; }
      ps[qb] *= a2; m_reg[qb] += dl; alpha[qb] *= a2; const float nm = -m_reg[qb]; negm[qb] = (pg8::f32x4){nm, nm, nm, nm}; }
  }
}
template <int H> __device__ __forceinline__ void sm16_sumh(const S16& p, float (&ps)[2]) {
#pragma unroll
  for (int qb = 0; qb < 2; ++qb)
#pragma unroll
    for (int kb = 2 * H; kb < 2 * H + 2; ++kb)
#pragma unroll
      for (int i = 0; i < 4; ++i) ps[qb] += p.a[kb][qb][i];
}
__device__ __forceinline__ void qkt16_sm(S16& p, int kaddr, const bf16x8 (&qr)[6][2], float (&m_reg)[2], float (&alpha)[2], pg8::f32x4 (&negm)[2], float (&ps)[2]) {
#pragma unroll
  for (int kb = 0; kb < 4; ++kb) { p.a[kb][0] = negm[0]; p.a[kb][1] = negm[1]; }
  bf16x8 ka0, ka1, kb0, kb1, kc0, kc1; float pm[2];
  K16R(ka0, ka1, 0, 0); K16R(kb0, kb1, 1, 0);
  K16R(kc0, kc1, 2, 0); K16W(4, ka0, ka1); K16M(ka0, ka1, 0, 0);
  K16R(ka0, ka1, 3, 0); K16W(4, kb0, kb1); K16M(kb0, kb1, 1, 0);
  K16R(kb0, kb1, 4, 0); K16W(4, kc0, kc1); K16M(kc0, kc1, 2, 0);
  K16R(kc0, kc1, 5, 0); K16W(4, ka0, ka1); K16M(ka0, ka1, 3, 0);
  K16R(ka0, ka1, 0, 1); K16W(4, kb0, kb1); K16M(kb0, kb1, 4, 0);
  K16R(kb0, kb1, 1, 1); K16W(4, kc0, kc1); K16M(kc0, kc1, 5, 0);
  K16R(kc0, kc1, 2, 1); K16W(4, ka0, ka1); K16M(ka0, ka1, 0, 1);
  K16R(ka0, ka1, 3, 1); K16W(4, kb0, kb1); K16M(kb0, kb1, 1, 1); sm16_pmaxh<0>(p, pm); asm volatile("" : "+v"(pm[0]), "+v"(pm[1]));
  K16R(kb0, kb1, 4, 1); K16W(4, kc0, kc1); K16M(kc0, kc1, 2, 1); sm16_grow_h0(pm, p, m_reg, alpha, negm); sm16_exp<0>(p); PIN16(p, 0);
  K16R(kc0, kc1, 5, 1); K16W(4, ka0, ka1); K16M(ka0, ka1, 3, 1); sm16_exp<1>(p); PIN16(p, 1);
  K16W(2, kb0, kb1); K16M(kb0, kb1, 4, 1); ps[0] = 0.f; ps[1] = 0.f; sm16_sumh<0>(p, ps); asm volatile("" : "+v"(ps[0]), "+v"(ps[1]));
  K16W(0, kc0, kc1); K16M(kc0, kc1, 5, 1);
}
#undef K16R
#undef K16W
#undef K16M
__device__ __forceinline__ void pv16_smh(pg8::f32x4 (&o)[2][8], int vb, const bf16x8 (&pa)[2][2], S16& pX, float (&m_reg)[2], float (&alpha)[2], float (&l_reg)[2], pg8::f32x4 (&negm)[2], float (&ps)[2], bf16x8 (&pn)[2][2]) {
  s16x4 ta[4], tb[4]; float pm[2];
  pv16_reads<0>(ta, vb);
  pv16_reads<1>(tb, vb); PVW(4); pv16_mma<0>(o, ta, pa); sm16_pmaxh<1>(pX, pm); asm volatile("" : "+v"(pm[0]), "+v"(pm[1]));
  pv16_reads<2>(ta, vb); PVW(4); pv16_mma<1>(o, tb, pa); sm16_grow_h1(pm, pX, m_reg, alpha, negm, ps); sm16_exp<2>(pX); PIN16(pX, 2);
  pv16_reads<3>(tb, vb); PVW(4); pv16_mma<2>(o, ta, pa); sm16_exp<3>(pX); PIN16(pX, 3);
  pv16_reads<4>(ta, vb); PVW(4); pv16_mma<3>(o, tb, pa); sm16_sumh<1>(pX, ps); l_reg[0] = l_reg[0] * alpha[0] + ps[0]; l_reg[1] = l_reg[1] * alpha[1] + ps[1]; asm volatile("" : "+v"(l_reg[0]), "+v"(l_reg[1]));
  pv16_reads<5>(tb, vb); PVW(4); pv16_mma<4>(o, ta, pa);
  pv16_reads<6>(ta, vb); PVW(4); pv16_mma<5>(o, tb, pa); sm16_pack(pX, pn); asm volatile("" : "+v"(pn[0][0]), "+v"(pn[0][1]), "+v"(pn[1][0]), "+v"(pn[1][1]));
  pv16_reads<7>(tb, vb); PVW(4); pv16_mma<6>(o, ta, pa);
  PVW(0); pv16_mma<7>(o, tb, pa);
}
__device__ __forceinline__ void attn_unit16(const bf16* __restrict__ Qb, const bf16* __restrict__ KNh, const bf16* __restrict__ KPE, const bf16* __restrict__ Vh, bf16* __restrict__ Ob, int b, LAS char* lds) {
  int tid_l = threadIdx.x; asm volatile("" : "+v"(tid_l));
  const int tid = tid_l, wid = __builtin_amdgcn_readfirstlane(tid >> 6), lane = tid & 63, i16 = lane & 15, g = lane >> 4;
  LAS float* wsf = (LAS float*)(lds + DOFF_WS) + wid * 64; LAS float* li_l = wsf; LAS float* al_l = wsf + 32;
  LAS char* ost = lds + wid * 8192;
  float m_reg[2] = {-1e30f, -1e30f}, l_reg[2] = {0.f, 0.f}; pg8::f32x4 o[2][8]; bf16x8 qr[6][2];
#pragma unroll
  for (int qb = 0; qb < 2; ++qb)
#pragma unroll
    for (int db = 0; db < 8; ++db) o[qb][db] = (pg8::f32x4){0.f, 0.f, 0.f, 0.f};
#pragma unroll
  for (int ks = 0; ks < 6; ++ks)
#pragma unroll
    for (int qb = 0; qb < 2; ++qb) qr[ks][qb] = *reinterpret_cast<const bf16x8*>(Qb + (size_t)(wid * 32 + 16 * qb + i16) * 3072 + 32 * ks + 8 * g);
  unsigned ovs, okn, okp;
  { const int key = 8 * (wid >> 1) + ((lane & 15) >> 1), col = 16 * (4 * (wid & 1) + (lane >> 4)) + 8 * (lane & 1);
    ovs = (unsigned)(key * D + col) * 2u;
    const int kin = lane >> 2, kk = 16 * (wid & 3) + kin, gg = (lane & 3) ^ (2 * ((kin >> 3) & 1));
    okn = (unsigned)(kk * D + 32 * (wid >> 2) + 8 * gg) * 2u; okp = (unsigned)(kk * 64 + 32 * (wid >> 2) + 8 * gg) * 2u; }
  const int krd0 = i16 * 64 + ((g ^ (2 * ((i16 >> 3) & 1))) * 16) + DOFF_K;
  const int vrd0 = (int)(unsigned)(uintptr_t)lds + (g >> 1) * 2048 + (4 * (g & 1) + (i16 >> 2)) * 32 + (i16 & 3) * 8;
#define DMA_TILE(j, boff) do { const unsigned rb_ = (unsigned)krow((j), b), rv_ = rb_ * (unsigned)(D * 2), rp_ = rb_ * 128u; LAS char* d_ = lds + (boff) + wid * 1024; \
    __builtin_amdgcn_global_load_lds((const unsigned*)(reinterpret_cast<const char*>(Vh) + (size_t)(rv_ + ovs)), (LAS unsigned*)d_, 16, 0, 0); \
    __builtin_amdgcn_global_load_lds((const unsigned*)(reinterpret_cast<const char*>(Vh) + (size_t)(rv_ + ovs + 32u * D * 2u)), (LAS unsigned*)(d_ + 8192), 16, 0, 0); \
    __builtin_amdgcn_global_load_lds((const unsigned*)(reinterpret_cast<const char*>(KNh) + (size_t)(rv_ + okn)), (LAS unsigned*)(d_ + DOFF_K), 16, 0, 0); \
    __builtin_amdgcn_global_load_lds((const unsigned*)(reinterpret_cast<const char*>(KNh) + (size_t)(rv_ + okn + 128u)), (LAS unsigned*)(d_ + DOFF_K + 8192), 16, 0, 0); \
    __builtin_amdgcn_global_load_lds((const unsigned*)(reinterpret_cast<const char*>(KPE) + (size_t)(rp_ + okp)), (LAS unsigned*)(d_ + DOFF_K + 16384), 16, 0, 0); } while (0)
#define QKT(x) qkt16(x, (int)(unsigned)(uintptr_t)lds + o_cur + krd0, qr, negm)
#define TILE_BAR() do { asm volatile("s_waitcnt vmcnt(0) lgkmcnt(0)" ::: "memory"); __builtin_amdgcn_s_barrier(); asm volatile("" ::: "memory"); } while (0)
#define RESC(a) do { if (__any((a[0] < 1.f) || (a[1] < 1.f))) { if (g == 0) { al_l[i16] = a[0]; al_l[16 + i16] = a[1]; } asm volatile("s_waitcnt lgkmcnt(0)" ::: "memory"); \
    _Pragma("unroll") for (int qb = 0; qb < 2; ++qb) { const pg8::f32x4 av = *(const LAS pg8::f32x4*)(al_l + 16 * qb + 4 * g); \
      _Pragma("unroll") for (int db = 0; db < 8; ++db) o[qb][db] *= av; } } } while (0)
#define ROT() do { const int t_ = o_prev; o_prev = o_cur; o_cur = o_next; o_next = t_; } while (0)
  S16 p; float al[2]; bf16x8 paA[2][2], paB[2][2];
  int o_prev = 2 * DBUF, o_cur = 0, o_next = DBUF;
  DMA_TILE(0, 0); DMA_TILE(1, DBUF);
  asm volatile("s_waitcnt vmcnt(5) lgkmcnt(0)" ::: "memory"); __builtin_amdgcn_s_barrier(); asm volatile("" ::: "memory");
  pg8::f32x4 negm[2] = {{0.f, 0.f, 0.f, 0.f}, {0.f, 0.f, 0.f, 0.f}};
  QKT(p);
  { float pm[2]; sm16_pmax(p, pm); al[0] = 1.f; al[1] = 1.f;
#pragma unroll
    for (int qb = 0; qb < 2; ++qb) { const float r = rowmax4(pm[qb]); m_reg[qb] = r; negm[qb] = (pg8::f32x4){-r, -r, -r, -r};
#pragma unroll
      for (int kb = 0; kb < 4; ++kb)
#pragma unroll
        for (int i = 0; i < 4; ++i) p.a[kb][qb][i] -= r; }
    sm16_exp<0>(p); sm16_exp<1>(p); sm16_exp<2>(p); sm16_exp<3>(p);
    sm16_sum(p, 0, 1.f, l_reg[0]); sm16_sum(p, 1, 1.f, l_reg[1]); sm16_pack(p, paA); }
  TILE_BAR(); DMA_TILE(2, 2 * DBUF); ROT();
  float ps[2];
#define QKTS() qkt16_sm(p, (int)(unsigned)(uintptr_t)lds + o_cur + krd0, qr, m_reg, al, negm, ps)
  for (int j = 1; j + 1 < NT; j += 2) {
    SBAR(); QKTS(); SBAR();
    pv16_smh(o, vrd0 + o_prev, paA, p, m_reg, al, l_reg, negm, ps, paB);
    TILE_BAR(); if (j + 2 < NT) DMA_TILE(j + 2, o_prev); ROT();
    RESC(al);
    SBAR(); QKTS(); SBAR();
    pv16_smh(o, vrd0 + o_prev, paB, p, m_reg, al, l_reg, negm, ps, paA);
    TILE_BAR(); if (j + 3 < NT) DMA_TILE(j + 3, o_prev); ROT();
    RESC(al);
  }
  SBAR(); QKTS(); SBAR();
  pv16_smh(o, vrd0 + o_prev, paA, p, m_reg, al, l_reg, negm, ps, paB);
  RESC(al);
#undef QKTS
  pv16_d0(o, vrd0 + o_cur, paB);
  TILE_BAR();
  { const float l0 = rowsum4(l_reg[0]), l1 = rowsum4(l_reg[1]); if (g == 0) { li_l[i16] = l0; li_l[16 + i16] = l1; } }
  asm volatile("s_waitcnt lgkmcnt(0)" ::: "memory");
#pragma unroll
  for (int qb = 0; qb < 2; ++qb) { const pg8::f32x4 lv = *(const LAS pg8::f32x4*)(li_l + 16 * qb + 4 * g);
#pragma unroll
    for (int i = 0; i < 4; ++i) { const float rl = __builtin_amdgcn_rcpf(lv[i]); const int orow = 16 * qb + 4 * g + i;
#pragma unroll
      for (int db = 0; db < 8; ++db) *(LAS unsigned short*)(ost + orow * 256 + (db * 16 + i16) * 2) = (unsigned short)f2bf(o[qb][db][i] * rl); } }
  asm volatile("s_waitcnt lgkmcnt(0)" ::: "memory");
#pragma unroll
  for (int i = 0; i < 8; ++i) { const int gidx = i * 64 + lane, row = gidx >> 4, cg = gidx & 15;
    const v4u v = *(const LAS v4u*)(ost + row * 256 + cg * 16);
    *(GAS v4u*)(Ob + (size_t)(wid * 32 + row) * D + cg * 8) = v; }
  TILE_BAR();
#undef DMA_TILE
#undef QKT
#undef TILE_BAR
#undef RESC
#undef ROT
}
#undef MF16
#undef PIN16
#undef SBAR
}

#ifndef MK_SPLIT
#define MK_SPLIT 0
#endif
#if MK_SPLIT
#define GRID_BAR() do { } while (0)
#else
#define GRID_BAR() xcd_barrier(bar)
#endif
#define IN(k) (lo <= (k) && (k) < hi)
#ifndef ATTN_MAIN
#define ATTN_MAIN attn_unit16
#endif
#ifndef ATTN_FN
#define ATTN_FN attn_unit_pp
#endif
#ifndef GU_WGM
#define GU_WGM 8
#endif
#ifndef DN_WGM
#define DN_WGM 4
#endif
#ifndef PROBE_PH
#define PROBE_PH (-1)
#define PROBE_N 1
#endif
#define REPEAT(k) _Pragma("unroll") for (int rep_ = 0; rep_ < ((k) == PROBE_PH ? PROBE_N : 1); ++rep_)
#define SEAM(k) do { if (IN(k) && IN((k) + 1)) GRID_BAR(); } while (0)
template <int l> __device__ __forceinline__ void layer_body(Frame& F, const Args& args, const int lo, const int hi, const XcdBarrier& bar) {
    unsigned char* ws = args.ws;
    float* X = args.out;
    float* Yc = (float*)(ws + WS_Y) - (size_t)M_LAT * D;
    float* PARTc = (float*)(ws + WS_F) - (size_t)M_LAT * D;
    const float* XinC = args.in[2] - (size_t)M_LAT * D;
    bf16* XN = (bf16*)args.out;
    bf16* XB = (bf16*)(ws + WS_XB);
    bf16* Hb = (bf16*)(ws + WS_BIG);
    const float* MOD = (const float*)(ws + WS_MOD);
    const float* ROPEt = (const float*)(ws + WS_ROPE);
    (void)XinC; (void)ROPEt;
        const int pb = l == 0 ? 2 : 12;
        const float* modl = MOD + (size_t)l * 3 * NMODV;
        const float* ng = args.in[6] + (size_t)l * 3 * D;
        if (IN(pb + 0)) { REPEAT(pb + 0) { if constexpr (l == 0) ph_norm<true>(F, args.in[0], XinC, M_ALL, ng, modl, 0, XN); else ph_norm<false, CTX_P>(F, XB, Yc, M_ALL, ng, modl, 0, XN, PARTc, Yc); } } SEAM(pb + 0);
#if defined(DRY_GU)
        if (l == 0 && IN(pb + 1)) { for (int rr = 0; rr < DRY_GU; ++rr) { pg8::Gemm g{XN, (const bf16*)(ws + WS_WGU), M_ALL, NGU, D, D}; pg8::StaticOrder S; S.init(M_ALL, NGU, F.G, (int)blockIdx.x, GU_WGM);
            EpiNull E; pg8::gemm_phase<EpiNull, pg8::StaticOrder, true, true>(F.lds + RING_OFF, g, S, E); __syncthreads(); } }
#endif
        if (IN(pb + 1)) REPEAT(pb + 1) {
            pg8::Gemm g{XN, (const bf16*)(ws + WS_WGU + (size_t)(l * 2) * SZ_WGU), M_ALL, NGU, D, D}; pg8::StaticOrder S; S.init(M_LAT, NGU, F.G, (int)blockIdx.x, GU_WGM);
            EpiSwiGLU E{Hb};
            pg8::gemm_phase<EpiSwiGLU, pg8::StaticOrder, true, true>(F.lds + RING_OFF, g, S, E);
            __syncthreads();
            ClaimOrder C{NGU / 256, 1, 0, (unsigned*)(ws + 944 * 1024 + 256 + l * 64), (volatile LAS unsigned*)(F.lds + MISC_OFF) + 40};
            pg8::gemm_phase<EpiSwiGLU, ClaimOrder, true, true>(F.lds + RING_OFF, g, C, E);
        } SEAM(pb + 1);
#if defined(DRY_DN)
        if (l == 0 && IN(pb + 2)) { for (int rr = 0; rr < DRY_DN; ++rr) { pg8::Gemm g{Hb, (const bf16*)(ws + WS_WD), M_LAT, D, FF, FF}; pg8::StaticOrder S; S.init(M_LAT, D, F.G, (int)blockIdx.x, DN_WGM);
            EpiNull E; pg8::gemm_phase<EpiNull, pg8::StaticOrder, true, true>(F.lds + RING_OFF, g, S, E); __syncthreads(); } }
#endif
        if (IN(pb + 2)) REPEAT(pb + 2) {
#ifdef CTX_CHECK
            if constexpr (l == 0) {
                const float* Ysrc = (const float*)(ws + WS_Y); float* Y2 = (float*)(ws + WS_F + 64 * MiB);
                for (size_t i = (size_t)blockIdx.x * 512 + threadIdx.x; i < (size_t)M_CTX * D; i += (size_t)F.G * 512) Y2[i] = Ysrc[i];
            }
#endif
            {   pg8::Gemm g{Hb, (const bf16*)(ws + WS_WD + (size_t)(l * 2) * SZ_WD), M_LAT, D, FF, FF}; pg8::StaticOrder S; S.init(M_LAT, D, F.G, (int)blockIdx.x, DN_WGM);
                if constexpr (l == 0) { EpiResidF32 E{args.in[0], XB, modl + 2 * D, 0.5f}; pg8::gemm_phase<EpiResidF32, pg8::StaticOrder, true, true>(F.lds + RING_OFF, g, S, E); }
                else { EpiResid E{XB, XB, modl + 2 * D, 0.5f}; pg8::gemm_phase<EpiResid, pg8::StaticOrder, true, true>(F.lds + RING_OFF, g, S, E); } }
            __syncthreads();
            {   pg8::Gemm g{Hb, (const bf16*)(ws + WS_WD + (size_t)(l * 2) * SZ_WD), M_CTX, D, FF / CTX_P, FF}; ClaimOrder S{D / 256, CTX_P, (FF / CTX_P) * 2, (unsigned*)(ws + 944 * 1024 + l * 64), (volatile LAS unsigned*)(F.lds + MISC_OFF) + 40};
                EpiPartial E{PARTc, modl + 2 * D, 0.5f, (FF / CTX_P) * 2};
                pg8::gemm_phase<EpiPartial, ClaimOrder, true, true>(F.lds + RING_OFF, g, S, E); }
#ifdef CTX_CHECK
            if constexpr (l == 0) {
                __syncthreads();
                pg8::Gemm g{Hb, (const bf16*)(ws + WS_WD + (size_t)(l * 2) * SZ_WD), M_CTX, D, FF, FF}; SplitKOrder S{D / 256, 1, 0, F.G, (int)blockIdx.x};
                EpiResidAtomic E{(float*)(ws + WS_F + 64 * MiB) - (size_t)M_LAT * D, modl + 2 * D, 0.5f};
                pg8::gemm_phase<EpiResidAtomic, SplitKOrder, true, true>(F.lds + RING_OFF, g, S, E);
            }
#endif
        } SEAM(pb + 2);
        if (IN(pb + 3)) { ph_norm<false, CTX_P>(F, XB, Yc, M_ALL, ng + D, modl, 1, XN, PARTc, Yc); } SEAM(pb + 3);
#ifdef CTX_CHECK
        if constexpr (l == 0) {
            const float* Ysrc = (const float*)(ws + WS_Y); const float* Y2 = (const float*)(ws + WS_F + 64 * MiB); float md = 0.f, mv = 0.f;
            for (size_t i = (size_t)blockIdx.x * 512 + threadIdx.x; i < (size_t)M_CTX * D; i += (size_t)F.G * 512) {
                const float a = __builtin_nontemporal_load(Ysrc + i), c = __builtin_nontemporal_load(Y2 + i); md = fmaxf(md, fabsf(a - c) / (fabsf(a) + 1.0f)); mv = fmaxf(mv, fabsf(a - args.in[2][i])); }
            atomicMax((unsigned*)(ws + 940 * 1024), __float_as_uint(md)); atomicMax((unsigned*)(ws + 940 * 1024 + 4), __float_as_uint(mv));
        }
#endif
        int pn2;
        if constexpr (l == 0) {
            bf16* Ub = (bf16*)(ws + WS_U); bf16* Vb = (bf16*)(ws + WS_V); float* stats = (float*)(ws + WS_STATS);
            if (IN(6)) {
                pg8::Gemm g{XN, (const bf16*)(ws + WS_GMIN), M_ALL, 4096, D, D}; pg8::StaticOrder S; S.init(M_LAT, 4096, F.G, (int)blockIdx.x);
                EpiGeluUV E{Ub, Vb, stats};
                pg8::gemm_phase<EpiGeluUV, pg8::StaticOrder, true, true>(F.lds + RING_OFF, g, S, E);
                __syncthreads();
                ClaimOrder C{4096 / 256, 1, 0, (unsigned*)(ws + 944 * 1024 + 448), (volatile LAS unsigned*)(F.lds + MISC_OFF) + 40};
                pg8::gemm_phase<EpiGeluUV, ClaimOrder, true, true>(F.lds + RING_OFF, g, C, E);
            } SEAM(6);
            if (IN(7)) { REPEAT(7) { ph_gm_mix(F, Ub, Vb, stats, args.in[11], args.in[12], args.in[13], args.in[14], (PROBE_PH == 7 && rep_ + 1 < PROBE_N) ? (bf16*)(ws + WS_VV) : nullptr); } } SEAM(7);
            if (IN(8)) {
                {   pg8::Gemm g{Ub, (const bf16*)(ws + WS_GMOUT), M_LAT, D, D, D}; pg8::StaticOrder S; S.init(M_LAT, D, F.G, (int)blockIdx.x);
                    EpiResid E{XB, XB, modl + 5 * D, 1.0f};
                    pg8::gemm_phase<EpiResid, pg8::StaticOrder, true, true>(F.lds + RING_OFF, g, S, E); }
                __syncthreads();
                {   pg8::Gemm g{Ub, (const bf16*)(ws + WS_GMOUT), M_CTX, D, D / 4, D}; ClaimOrder S{D / 256, 4, (D / 4) * 2, (unsigned*)(ws + 944 * 1024 + 512), (volatile LAS unsigned*)(F.lds + MISC_OFF) + 40};
                    EpiResidAtomic E{Yc, modl + 5 * D, 1.0f};
                    pg8::gemm_phase<EpiResidAtomic, ClaimOrder, true, true>(F.lds + RING_OFF, g, S, E); }
            } SEAM(8);
            pn2 = 9;
        } else {
            float* Fm = (float*)(ws + WS_F); bf16* CQ = (bf16*)(ws + WS_CQ); bf16* CKV = (bf16*)(ws + WS_CKV); bf16* KPE = (bf16*)(ws + WS_KPE);
            bf16* Qb = (bf16*)(ws + WS_Q); bf16* KN = (bf16*)(ws + WS_KN); bf16* VV = (bf16*)(ws + WS_VV); bf16* Ob = XN;
            if (IN(16)) {
                pg8::Gemm g{XN, (const bf16*)(ws + WS_WDQKV), M_ALL, NDQKV, D, D}; pg8::StaticOrder S; S.init(M_ALL, NDQKV, F.G, (int)blockIdx.x);
                EpiF32 E{Fm, NDQKV};
                pg8::gemm_phase<EpiF32, pg8::StaticOrder, true, true>(F.lds + RING_OFF, g, S, E);
            } SEAM(16);
            if (IN(17)) { ph_mla_norm(F, Fm, args.in[17], args.in[20], ROPEt, CQ, CKV, KPE); } SEAM(17);
            if (IN(18)) REPEAT(18) {
                {   pg8::Gemm g{CQ, (const bf16*)(ws + WS_WUQ), M_LAT, 3072, KQ, KQ}; pg8::StaticOrder S; S.init(M_LAT, 3072, F.G, (int)blockIdx.x);
                    EpiQRope E{Qb, ROPEt};
                    pg8::gemm_phase<EpiQRope, pg8::StaticOrder, true, true>(F.lds + RING_OFF, g, S, E); }
                __syncthreads();
                {   pg8::Gemm g{CKV, (const bf16*)(ws + WS_WUKV), M_ALL, 4096, KKV, KKV}; pg8::StaticOrder S; S.init(M_LAT, 4096, F.G, (int)blockIdx.x);
                    EpiKV E{KN, VV};
                    pg8::gemm_phase<EpiKV, pg8::StaticOrder, true, true>(F.lds + RING_OFF, g, S, E);
                    __syncthreads();
                    ClaimOrder C{4096 / 256, 1, 0, (unsigned*)(ws + 944 * 1024 + 576), (volatile LAS unsigned*)(F.lds + MISC_OFF) + 40};
                    pg8::gemm_phase<EpiKV, ClaimOrder, true, true>(F.lds + RING_OFF, g, C, E); }
            } SEAM(18);
            if (IN(19)) REPEAT(19) {
#ifdef CLK_PROBE
                const unsigned long long ct0_ = __builtin_amdgcn_s_memtime(), cr0_ = __builtin_amdgcn_s_memrealtime();
#endif
                __syncthreads();
                for (int L = F.vcu; L < NB * NHEAD * (SEQ / 256); L += F.G) {
                    const int qb = L & 63, bh = L >> 6, b = bh >> 4, h = bh & 15;
#ifdef ATT_ABL
                    if (PROBE_PH == 19 && rep_ + 1 < PROBE_N) att::attn_unit_dma<ATT_ABL>(Qb + (size_t)(b * SEQ + qb * 256) * 3072 + h * DQK, KN + h * DVH, KPE, VV + h * DVH, Ob + (size_t)(b * SEQ + qb * 256) * D + h * DVH, b, (LAS char*)F.lds);
                    else
#endif
                    att::ATTN_MAIN(Qb + (size_t)(b * SEQ + qb * 256) * 3072 + h * DQK, KN + h * DVH, KPE, VV + h * DVH, Ob + (size_t)(b * SEQ + qb * 256) * D + h * DVH, b, (LAS char*)F.lds);
                }
                __syncthreads();
#ifdef CLK_PROBE
                if (blockIdx.x == CLK_PROBE && threadIdx.x == 0) { const unsigned long long dt_ = __builtin_amdgcn_s_memtime() - ct0_, dr_ = __builtin_amdgcn_s_memrealtime() - cr0_;
                    const int q_ = (int)((dt_ + dr_ / 2) / dr_); __hip_atomic_store((int*)(args.ws + 950 * 1024), (dt_ * 10 >= dr_ * 190) ? 20000 : 10000, __ATOMIC_RELAXED, __HIP_MEMORY_SCOPE_AGENT); }
#endif
            } SEAM(19);
            if (IN(20)) {
                pg8::Gemm g{Ob, (const bf16*)(ws + WS_WO), M_LAT, D, D, D}; pg8::StaticOrder S; S.init(M_LAT, D, F.G, (int)blockIdx.x);
                EpiResid E{XB, XB, modl + 5 * D, 1.0f};
                pg8::gemm_phase<EpiResid, pg8::StaticOrder, true, true>(F.lds + RING_OFF, g, S, E);
            } SEAM(20);
            pn2 = 21;
        }
        const int M2 = l == 0 ? M_ALL : M_LAT;
        if (IN(pn2)) { ph_norm<false>(F, XB, Yc, M2, ng + 2 * D, modl, 2, XN); } SEAM(pn2);
        if (IN(pn2 + 1)) {
            pg8::Gemm g{XN, (const bf16*)(ws + WS_WGU + (size_t)(l * 2 + 1) * SZ_WGU), M2, NGU, D, D}; pg8::StaticOrder S; S.init(M_LAT, NGU, F.G, (int)blockIdx.x, GU_WGM);
            EpiSwiGLU E{Hb};
            pg8::gemm_phase<EpiSwiGLU, pg8::StaticOrder, true, true>(F.lds + RING_OFF, g, S, E);
            if constexpr (l == 0) {
                __syncthreads();
                ClaimOrder C{NGU / 256, 1, 0, (unsigned*)(ws + 944 * 1024 + 384), (volatile LAS unsigned*)(F.lds + MISC_OFF) + 40};
                pg8::gemm_phase<EpiSwiGLU, ClaimOrder, true, true>(F.lds + RING_OFF, g, C, E);
            }
        } SEAM(pn2 + 1);
        if (IN(pn2 + 2)) {
            {   pg8::Gemm g{Hb, (const bf16*)(ws + WS_WD + (size_t)(l * 2 + 1) * SZ_WD), M_LAT, D, FF, FF}; pg8::StaticOrder S; S.init(M_LAT, D, F.G, (int)blockIdx.x, DN_WGM);
                EpiResid E{XB, XB, modl + 8 * D, 0.5f};
                pg8::gemm_phase<EpiResid, pg8::StaticOrder, true, true>(F.lds + RING_OFF, g, S, E); }
            if constexpr (l == 0) {
                __syncthreads();
                pg8::Gemm g{Hb, (const bf16*)(ws + WS_WD + (size_t)(l * 2 + 1) * SZ_WD), M_CTX, D, FF / CTX_P, FF}; ClaimOrder S{D / 256, CTX_P, (FF / CTX_P) * 2, (unsigned*)(ws + 944 * 1024 + 128), (volatile LAS unsigned*)(F.lds + MISC_OFF) + 40};
                EpiPartial E{PARTc, modl + 8 * D, 0.5f, (FF / CTX_P) * 2};
                pg8::gemm_phase<EpiPartial, ClaimOrder, true, true>(F.lds + RING_OFF, g, S, E);
            }
        } SEAM(pn2 + 2);
    }

__global__ void __launch_bounds__(NWAVES * 64, 2) mk_fwd(Args args) {
    extern __shared__ __attribute__((aligned(16))) unsigned char lds[];
    Frame F;
    F.lds = (LAS unsigned char*)lds;
    F.wave = __builtin_amdgcn_readfirstlane((int)threadIdx.x >> 6);
    F.G = gridDim.x; { const int bx = blockIdx.x; F.vcu = (F.G % 8 == 0) ? (bx % 8) * (F.G / 8) + bx / 8 : bx; }
    unsigned char* ws = args.ws;
    F.ctl = (gu32*)(ws + WS_CTL);
    volatile LAS unsigned* MISC = (volatile LAS unsigned*)(F.lds + MISC_OFF);
    for (int u = threadIdx.x; u < (LDS_BYTES - MISC_OFF) / 4; u += NWAVES * 64) ((LAS unsigned*)(F.lds + MISC_OFF))[u] = 0u;
    __syncthreads();
#if MK_SPLIT
    XcdBarrier bar; bar.bar = (unsigned*)(F.ctl + CW_BAR); bar.x = 0; bar.st = nullptr;
#else
    XcdBarrier bar = xcd_barrier_post((unsigned*)(F.ctl + CW_BAR), MISC + 8);
#endif
    const int lo = args.ph_lo, hi = args.ph_hi;

    float* X = args.out;
    float* Yc = (float*)(ws + WS_Y) - (size_t)M_LAT * D;
    const float* XinC = args.in[2] - (size_t)M_LAT * D;
    bf16* XN = (bf16*)args.out;
    bf16* XB = (bf16*)(ws + WS_XB);
    bf16* Hb = (bf16*)(ws + WS_BIG);
    const float* MOD = (const float*)(ws + WS_MOD);
    const float* ROPEt = (const float*)(ws + WS_ROPE);

#ifdef CLK_PROBE0
    const unsigned long long ct00_ = __builtin_amdgcn_s_memtime(), cr00_ = __builtin_amdgcn_s_memrealtime();
#endif
    if (IN(0)) { REPEAT(0) { ph_prologue(F, args); __syncthreads(); } }
#ifdef CLK_PROBE0
    if (blockIdx.x == CLK_PROBE && threadIdx.x == 0) { const unsigned long long dt_ = __builtin_amdgcn_s_memtime() - ct00_, dr_ = __builtin_amdgcn_s_memrealtime() - cr00_;
        __hip_atomic_store((int*)(args.ws + 950 * 1024 + 64), (dt_ * 10 >= dr_ * CLK_PROBE0) ? 20000 : 10000, __ATOMIC_RELAXED, __HIP_MEMORY_SCOPE_AGENT); }
#endif
    SEAM(0);
    if (IN(1)) { ph_modreduce(F, args); } SEAM(1);

    layer_body<0>(F, args, lo, hi, bar);
    layer_body<1>(F, args, lo, hi, bar);
    if (IN(24)) { ph_final(F, (const bf16*)(ws + WS_XB), args.out, args.in[23]); }
#ifdef CTX_CHECK
    GRID_BAR();
    if (blockIdx.x == 0 && threadIdx.x == 0) {
        const float md = __uint_as_float(__hip_atomic_load((unsigned*)(args.ws + 940 * 1024), __ATOMIC_RELAXED, __HIP_MEMORY_SCOPE_AGENT));
        const float mv = __uint_as_float(__hip_atomic_load((unsigned*)(args.ws + 940 * 1024 + 4), __ATOMIC_RELAXED, __HIP_MEMORY_SCOPE_AGENT));
        args.out[7] = (md < 1e-3f) ? ((mv > 1e-2f) ? 1000.0f : 5000.0f) : 9000.0f; }
#endif
#ifdef CLK_PROBE
    GRID_BAR();
    if (blockIdx.x == 0 && threadIdx.x == 0) {
#ifdef CLK_PROBE0
        const int v = __hip_atomic_load((int*)(args.ws + 950 * 1024 + 64), __ATOMIC_RELAXED, __HIP_MEMORY_SCOPE_AGENT);
#else
        const int v = __hip_atomic_load((int*)(args.ws + 950 * 1024), __ATOMIC_RELAXED, __HIP_MEMORY_SCOPE_AGENT);
#endif
        args.out[7] = (float)v; }
#endif
#undef IN
#undef SEAM
#undef GRID_BAR
}

extern "C" void kernel_launch(void* const* d_in, const int* in_sizes, int n_in, void* d_out, int out_size, void* d_ws, size_t ws_size, hipStream_t stream) {
    static int grid = 0;
    if (grid == 0) {
        if (n_in != 24 || in_sizes[0] != M_LAT * D || out_size != M_LAT * D || ws_size < WS_END) {
            fprintf(stderr, "kernel_launch: shape mismatch: n_in %d in0 %d out %d ws %zu (need %zu)\n", n_in, n_in > 0 ? in_sizes[0] : -1, out_size, ws_size, (size_t)WS_END); grid = -1; return; }
        int dev = 0, cus = 0, per_cu = 0;
        if (hipGetDevice(&dev) != hipSuccess || hipDeviceGetAttribute(&cus, hipDeviceAttributeMultiprocessorCount, dev) != hipSuccess) { grid = -1; return; }
        if (hipFuncSetAttribute((const void*)mk_fwd, hipFuncAttributeMaxDynamicSharedMemorySize, LDS_BYTES) != hipSuccess) { fprintf(stderr, "kernel_launch: hipFuncSetAttribute failed\n"); grid = -1; return; }
        if (hipOccupancyMaxActiveBlocksPerMultiprocessor(&per_cu, (const void*)mk_fwd, NWAVES * 64, LDS_BYTES) != hipSuccess || per_cu < 1)
            fprintf(stderr, "kernel_launch: note: occupancy query reports %d workgroups per CU\n", per_cu);
        (void)hipGetLastError();
        grid = cus;
    }
    if (grid < 0) return;
    if (hipMemsetAsync((char*)d_ws + WS_CTL, 0, CTL_ZERO_BYTES, stream) != hipSuccess) { fprintf(stderr, "kernel_launch: memset failed\n"); return; }
    Args a{};
    for (int i = 0; i < 24; ++i) a.in[i] = (const float*)d_in[i];
    a.out = (float*)d_out; a.ws = (unsigned char*)d_ws;
#if MK_SPLIT
    for (int p = 0; p < N_PHASES; ++p) { a.ph_lo = p; a.ph_hi = p + 1;
        hipLaunchKernelGGL(mk_fwd, dim3(grid), dim3(NWAVES * 64), LDS_BYTES, stream, a); }
#else
    a.ph_lo = 0; a.ph_hi = N_PHASES;
    hipLaunchKernelGGL(mk_fwd, dim3(grid), dim3(NWAVES * 64), LDS_BYTES, stream, a);
#endif
    const hipError_t le = hipPeekAtLastError();
    if (le != hipSuccess) fprintf(stderr, "kernel_launch: launch failed: %s\n", hipGetErrorName(le));
}
```
